# Optimizing an MI355X kernel written in HIP

```python
import math
import jax
import jax.numpy as jnp
from jax import lax
import numpy as np

D_MODEL = 1024
BATCH = 16
SEQ = 2048
DEPTH = 2

N_EVEN = (DEPTH + 1) // 2
N_ODD = DEPTH // 2
BRANCH = D_MODEL // 2
S5_GROUP = 16
S5_GROUPS = BRANCH // S5_GROUP
S5_STATE = 64
S5_DT_MIN = 1e-3
S5_DT_MAX = 1e-1
ML_HEADS = 4
ML_HEAD_DIM = BRANCH // ML_HEADS
ML_CONV = 4
ML_CHUNK = 64
DIL_HEADS = 8
DIL_HEAD_DIM = BRANCH // DIL_HEADS
DIL_PAIRS = ((128, 1), (512, 4), (2048, 16))
DIFF_HEADS = 4
DIFF_HEAD_DIM = BRANCH // (2 * DIFF_HEADS)
Q_BLOCK = 128
ROPE_THETA = 10000.0
NORM_EPS = 1e-6
HEAD_NORM_EPS = 1e-5
F32 = jnp.float32

kernel_name = 'hybrid_s5_mlstm_dilated_diffattn'


def _rmsnorm(x, g, eps=NORM_EPS):
    xf = x.astype(F32)
    y = xf * lax.rsqrt(jnp.mean(xf * xf, axis=-1, keepdims=True) + eps)
    return (y * g.astype(F32)).astype(x.dtype)


def _rotary(x, pos):
    dh = x.shape[-1]
    L = x.shape[1]
    inv = ROPE_THETA ** (-jnp.arange(0, dh, 2, dtype=F32) / dh)
    ang = pos.astype(F32)[:, None] * inv[None, :]
    shape = (1, L) + (1,) * (x.ndim - 3) + (dh // 2,)
    cos = jnp.cos(ang).reshape(shape)
    sin = jnp.sin(ang).reshape(shape)
    xf = x.astype(F32)
    x1, x2 = xf[..., : dh // 2], xf[..., dh // 2:]
    return jnp.concatenate([x1 * cos - x2 * sin, x2 * cos + x1 * sin], axis=-1).astype(x.dtype)


def _complex_diag_scan(a_r, a_i, b_r, b_i):
    def combine(e1, e2):
        ar1, ai1, br1, bi1 = e1
        ar2, ai2, br2, bi2 = e2
        return (ar2 * ar1 - ai2 * ai1, ar2 * ai1 + ai2 * ar1,
                ar2 * br1 - ai2 * bi1 + br2, ar2 * bi1 + ai2 * br1 + bi2)
    _, _, x_r, x_i = lax.associative_scan(combine, (a_r, a_i, b_r, b_i), axis=0)
    return x_r, x_i


def _s5_branch(u, lam_re, lam_im, log_dt, b_re, b_im, c_re, c_im, d_skip, glu_w, glu_b):
    Bsz, L, _ = u.shape
    uf = u.astype(F32)
    ug = uf.reshape(Bsz, L, S5_GROUPS, S5_GROUP)
    lr, li = lam_re.astype(F32), lam_im.astype(F32)
    dt = jnp.exp(log_dt.astype(F32))[:, None]
    mag = jnp.exp(lr * dt)
    ab_r, ab_i = mag * jnp.cos(li * dt), mag * jnp.sin(li * dt)
    den = lr * lr + li * li
    f_r = ((ab_r - 1.0) * lr + ab_i * li) / den
    f_i = (ab_i * lr - (ab_r - 1.0) * li) / den
    br, bi = b_re.astype(F32), b_im.astype(F32)
    bb_r = f_r[..., None] * br - f_i[..., None] * bi
    bb_i = f_r[..., None] * bi + f_i[..., None] * br
    bu_r = jnp.einsum('blgc,gpc->blgp', ug, bb_r)
    bu_i = jnp.einsum('blgc,gpc->blgp', ug, bb_i)
    a_r = jnp.broadcast_to(ab_r, (L,) + ab_r.shape)
    a_i = jnp.broadcast_to(ab_i, (L,) + ab_i.shape)
    x_r, x_i = jax.vmap(_complex_diag_scan, in_axes=(None, None, 0, 0))(a_r, a_i, bu_r, bu_i)
    y = (jnp.einsum('blgp,gcp->blgc', x_r, c_re.astype(F32))
         - jnp.einsum('blgp,gcp->blgc', x_i, c_im.astype(F32)))
    y = y.reshape(Bsz, L, BRANCH) + d_skip.astype(F32) * uf
    g = jax.nn.gelu(y)
    out = g * jax.nn.sigmoid(g @ glu_w.astype(F32) + glu_b.astype(F32))
    return out.astype(u.dtype)


def _mlstm_chunkwise(q, k, v, log_i, log_f):
    Bsz, H, L, dh = q.shape
    nc = L // ML_CHUNK

    def chunks(t):
        t = t.reshape((Bsz, H, nc, ML_CHUNK) + t.shape[3:])
        return jnp.moveaxis(t, 2, 0)

    causal = jnp.tril(jnp.ones((ML_CHUNK, ML_CHUNK), dtype=bool))

    def step(carry, inp):
        C, n, m = carry
        qc, kc, vc, li, lf = inp
        b = jnp.cumsum(lf, axis=-1)
        logD = jnp.where(causal, b[..., :, None] - b[..., None, :] + li[..., None, :], -jnp.inf)
        inter = b + m[..., None]
        m_t = jnp.maximum(inter, jnp.max(logD, axis=-1))
        dmat = jnp.exp(logD - m_t[..., None])
        sc = jnp.exp(inter - m_t)
        s = jnp.einsum('bhtd,bhsd->bhts', qc, kc) * dmat
        num = sc[..., None] * jnp.einsum('bhtd,bhed->bhte', qc, C) + jnp.einsum('bhts,bhse->bhte', s, vc)
        dnm = sc * jnp.einsum('bhtd,bhd->bht', qc, n) + jnp.sum(s, axis=-1)
        h = num / jnp.maximum(jnp.abs(dnm), jnp.exp(-m_t))[..., None]
        b_last = b[..., -1]
        w_log = b_last[..., None] - b + li
        m_new = jnp.maximum(b_last + m, jnp.max(w_log, axis=-1))
        w = jnp.exp(w_log - m_new[..., None])
        decay = jnp.exp(b_last + m - m_new)
        C_new = decay[..., None, None] * C + jnp.einsum('bhs,bhse,bhsd->bhed', w, vc, kc)
        n_new = decay[..., None] * n + jnp.einsum('bhs,bhsd->bhd', w, kc)
        return (C_new, n_new, m_new), h

    init = (jnp.zeros((Bsz, H, dh, dh), F32), jnp.zeros((Bsz, H, dh), F32), jnp.zeros((Bsz, H), F32))
    _, h = lax.scan(step, init, tuple(map(chunks, (q, k, v, log_i, log_f))))
    return jnp.moveaxis(h, 0, 2).reshape(Bsz, H, L, dh)


def _mlstm_branch(xm, conv_w, conv_b, wq, wk, wv, gate_w, gate_b, norm_g, skip):
    Bsz, L, W = xm.shape
    xp = jnp.pad(xm, ((0, 0), (ML_CONV - 1, 0), (0, 0)))
    xc = conv_b + sum(xp[:, j:j + L] * conv_w[j] for j in range(ML_CONV))
    xc = jax.nn.silu(xc)
    xc_h = xc.reshape(Bsz, L, ML_HEADS, ML_HEAD_DIM)
    xm_h = xm.reshape(Bsz, L, ML_HEADS, ML_HEAD_DIM)
    q = jnp.einsum('blhd,hde->blhe', xc_h, wq)
    k = jnp.einsum('blhd,hde->blhe', xc_h, wk)
    v = jnp.einsum('blhd,hde->blhe', xm_h, wv)
    qkv = jnp.concatenate([q.reshape(Bsz, L, W), k.reshape(Bsz, L, W), v.reshape(Bsz, L, W)], axis=-1)
    gates = (qkv @ gate_w + gate_b).astype(F32)
    log_i = jnp.transpose(gates[..., :ML_HEADS], (0, 2, 1))
    log_f = jnp.transpose(jax.nn.log_sigmoid(gates[..., ML_HEADS:]), (0, 2, 1))

    def to_bhl(t):
        return jnp.transpose(t.astype(F32), (0, 2, 1, 3))

    h = _mlstm_chunkwise(to_bhl(q), to_bhl(k) * (ML_HEAD_DIM ** -0.5), to_bhl(v), log_i, log_f)
    mu = jnp.mean(h, axis=-1, keepdims=True)
    var = jnp.mean(jnp.square(h - mu), axis=-1, keepdims=True)
    h = (h - mu) * lax.rsqrt(var + HEAD_NORM_EPS)
    h = jnp.transpose(h, (0, 2, 1, 3)).reshape(Bsz, L, W) * norm_g.astype(F32)
    return (h + skip.astype(F32) * xc.astype(F32)).astype(xm.dtype)


def _strided_window_attention(q, k, v, window, dilation):
    Bsz, L, H, dh = q.shape
    n_back = window // dilation
    bs = n_back
    n_sub = -(-L // dilation)
    n_blk = -(-n_sub // bs)
    pad = dilation * n_blk * bs - L

    def to_blocks(t):
        t = jnp.pad(t, ((0, 0), (0, pad), (0, 0), (0, 0)))
        return t.reshape(Bsz, n_blk, bs, dilation, H, dh)

    def with_prev(t):
        prev = jnp.concatenate([jnp.zeros_like(t[:, :1]), t[:, :-1]], axis=1)
        return jnp.concatenate([prev, t], axis=2)

    qb = to_blocks(q)
    kw = with_prev(to_blocks(k))
    vw = with_prev(to_blocks(v)).astype(F32)
    s = jnp.einsum('bnirhd,bnjrhd->bnrhij', qb, kw).astype(F32) * (dh ** -0.5)
    i_rel = jnp.arange(bs)[:, None]
    j_rel = jnp.arange(2 * bs)[None, :]
    delta = bs + i_rel - j_rel
    band = (delta >= 0) & (delta <= n_back)
    valid = (jnp.arange(n_blk)[:, None, None] > 0) | (j_rel[None] >= bs)
    mask = band[None] & valid
    s = jnp.where(mask[None, :, None, None], s, -jnp.inf)
    m = jnp.max(s, axis=-1, keepdims=True)
    p = jnp.exp(s - m)
    den = jnp.sum(p, axis=-1)
    o = jnp.einsum('bnrhij,bnjrhd->bnirhd', p, vw) / jnp.transpose(den, (0, 1, 4, 2, 3))[..., None]
    lse = jnp.transpose(m[..., 0] + jnp.log(den), (0, 1, 4, 2, 3))
    o = o.reshape(Bsz, -1, H, dh)[:, :L]
    lse = lse.reshape(Bsz, -1, H)[:, :L]
    return o, lse


def _dilated_mixture(q, k, v):
    outs, lses = [], []
    for window, dilation in DIL_PAIRS:
        o, lse = _strided_window_attention(q, k, v, window, dilation)
        outs.append(o)
        lses.append(lse)
    wts = jax.nn.softmax(jnp.stack(lses, axis=0), axis=0)
    return jnp.sum(wts[..., None] * jnp.stack(outs, axis=0), axis=0)


def _diff_attention(q, k, v, lam):
    Bsz, L, H, _, dh = q.shape
    n_qb = L // Q_BLOCK
    k_pos = jnp.arange(L)
    vf = v.astype(F32)
    scale = dh ** -0.5

    def block(i):
        start = i * Q_BLOCK
        qb = lax.dynamic_slice_in_dim(q, start, Q_BLOCK, axis=1)
        s = jnp.einsum('bqhcd,bkhcd->bhcqk', qb, k).astype(F32) * scale
        q_pos = start + jnp.arange(Q_BLOCK)
        s = jnp.where(k_pos[None, :] <= q_pos[:, None], s, -jnp.inf)
        p = jax.nn.softmax(s, axis=-1)
        attn = p[:, :, 0] - lam * p[:, :, 1]
        return jnp.einsum('bhqk,bkhe->bqhe', attn, vf)

    o = lax.map(block, jnp.arange(n_qb))
    return jnp.moveaxis(o, 0, 1).reshape(Bsz, L, H, -1)


def _even_layer(z, w_in, lam_re, lam_im, log_dt, b_re, b_im, c_re, c_im, d_skip, glu_w, glu_b,
                conv_w, conv_b, wq, wk, wv, gate_w, gate_b, ml_norm, ml_skip, w_out):
    proj = z @ w_in
    s5_u, s5_z, ml_x, ml_z = jnp.split(proj, 4, axis=-1)
    a = _s5_branch(s5_u, lam_re, lam_im, log_dt, b_re, b_im, c_re, c_im, d_skip, glu_w, glu_b) * jax.nn.silu(s5_z)
    b = _mlstm_branch(ml_x, conv_w, conv_b, wq, wk, wv, gate_w, gate_b, ml_norm, ml_skip) * jax.nn.silu(ml_z)
    return jnp.concatenate([a, b], axis=-1) @ w_out


def _odd_layer(z, w_in, lq1, lk1, lq2, lk2, diff_norm, w_out, layer_idx):
    Bsz, L, _ = z.shape
    proj = z @ w_in
    cq, ck, cv, cz, dq, dk, dv, dz = jnp.split(proj, 8, axis=-1)
    pos = jnp.arange(L)

    def heads_c(t):
        return t.reshape(Bsz, L, DIL_HEADS, DIL_HEAD_DIM)

    def heads_d(t):
        return t.reshape(Bsz, L, DIFF_HEADS, 2, DIFF_HEAD_DIM)

    c_o = _dilated_mixture(_rotary(heads_c(cq), pos), _rotary(heads_c(ck), pos), heads_c(cv))
    c_out = c_o.reshape(Bsz, L, BRANCH).astype(z.dtype) * jax.nn.silu(cz)
    lam_init = 0.8 - 0.6 * math.exp(-0.3 * layer_idx)
    lam = (jnp.exp(jnp.sum(lq1.astype(F32) * lk1.astype(F32)))
           - jnp.exp(jnp.sum(lq2.astype(F32) * lk2.astype(F32))) + lam_init)
    d_o = _diff_attention(_rotary(heads_d(dq), pos), _rotary(heads_d(dk), pos),
                          dv.reshape(Bsz, L, DIFF_HEADS, 2 * DIFF_HEAD_DIM), lam)
    d_o = _rmsnorm(d_o, diff_norm, HEAD_NORM_EPS) * (1.0 - lam_init)
    d_out = d_o.reshape(Bsz, L, BRANCH).astype(z.dtype) * jax.nn.silu(dz)
    return jnp.concatenate([c_out, d_out], axis=-1) @ w_out


def setup_inputs(seed: int = 0) -> dict:
    key = jax.random.key(seed)
    ks = iter(jax.random.split(key, 40))

    def nrm(shape, std):
        return std * jax.random.normal(next(ks), shape, F32)

    G, P = S5_GROUPS, S5_STATE
    NE, NO = N_EVEN, N_ODD
    gate_b = jnp.concatenate([
        nrm((NE, ML_HEADS), 0.1),
        jnp.linspace(3.0, 6.0, ML_HEADS, dtype=F32)[None, :] + nrm((NE, ML_HEADS), 0.1)], axis=-1)
    return {
        'x': nrm((BATCH, SEQ, D_MODEL), 1.0),
        'pre_norm': 1.0 + nrm((DEPTH, D_MODEL), 0.1),
        'post_norm': 1.0 + nrm((DEPTH, D_MODEL), 0.1),
        'w_in_ab': nrm((NE, D_MODEL, 4 * BRANCH), D_MODEL ** -0.5),
        's5_lambda_re': -0.5 + nrm((NE, G, P), 0.02),
        's5_lambda_im': jnp.pi * jnp.arange(P, dtype=F32) + nrm((NE, G, P), 0.02),
        's5_log_dt': jax.random.uniform(next(ks), (NE, G), F32, math.log(S5_DT_MIN), math.log(S5_DT_MAX)),
        's5_b_re': nrm((NE, G, P, S5_GROUP), (2 * S5_GROUP) ** -0.5),
        's5_b_im': nrm((NE, G, P, S5_GROUP), (2 * S5_GROUP) ** -0.5),
        's5_c_re': nrm((NE, G, S5_GROUP, P), P ** -0.5),
        's5_c_im': nrm((NE, G, S5_GROUP, P), P ** -0.5),
        's5_d': nrm((NE, BRANCH), 1.0),
        's5_glu_w': nrm((NE, BRANCH, BRANCH), BRANCH ** -0.5),
        's5_glu_b': nrm((NE, BRANCH), 0.02),
        'ml_conv_w': nrm((NE, ML_CONV, BRANCH), ML_CONV ** -0.5),
        'ml_conv_b': nrm((NE, BRANCH), 0.02),
        'ml_wq': nrm((NE, ML_HEADS, ML_HEAD_DIM, ML_HEAD_DIM), ML_HEAD_DIM ** -0.5),
        'ml_wk': nrm((NE, ML_HEADS, ML_HEAD_DIM, ML_HEAD_DIM), ML_HEAD_DIM ** -0.5),
        'ml_wv': nrm((NE, ML_HEADS, ML_HEAD_DIM, ML_HEAD_DIM), ML_HEAD_DIM ** -0.5),
        'ml_gate_w': nrm((NE, 3 * BRANCH, 2 * ML_HEADS), 0.1 * (3 * BRANCH) ** -0.5),
        'ml_gate_b': gate_b,
        'ml_norm': 1.0 + nrm((NE, BRANCH), 0.1),
        'ml_skip': 1.0 + nrm((NE, BRANCH), 0.1),
        'w_out_ab': nrm((NE, 2 * BRANCH, D_MODEL), (2 * BRANCH) ** -0.5),
        'w_in_cd': nrm((NO, D_MODEL, 8 * BRANCH), D_MODEL ** -0.5),
        'diff_lq1': nrm((NO, DIFF_HEAD_DIM), 0.1),
        'diff_lk1': nrm((NO, DIFF_HEAD_DIM), 0.1),
        'diff_lq2': nrm((NO, DIFF_HEAD_DIM), 0.1),
        'diff_lk2': nrm((NO, DIFF_HEAD_DIM), 0.1),
        'diff_norm': 1.0 + nrm((NO, 2 * DIFF_HEAD_DIM), 0.1),
        'w_out_cd': nrm((NO, 2 * BRANCH, D_MODEL), (2 * BRANCH) ** -0.5),
    }


def reference(x, pre_norm, post_norm, w_in_ab, s5_lambda_re, s5_lambda_im, s5_log_dt, s5_b_re, s5_b_im,
              s5_c_re, s5_c_im, s5_d, s5_glu_w, s5_glu_b, ml_conv_w, ml_conv_b, ml_wq, ml_wk, ml_wv,
              ml_gate_w, ml_gate_b, ml_norm, ml_skip, w_out_ab, w_in_cd, diff_lq1, diff_lk1, diff_lq2,
              diff_lk2, diff_norm, w_out_cd):
    h = x
    for l in range(DEPTH):
        z = _rmsnorm(h, pre_norm[l])
        i = l // 2
        if l % 2 == 0:
            y = _even_layer(z, w_in_ab[i], s5_lambda_re[i], s5_lambda_im[i], s5_log_dt[i], s5_b_re[i],
                            s5_b_im[i], s5_c_re[i], s5_c_im[i], s5_d[i], s5_glu_w[i], s5_glu_b[i],
                            ml_conv_w[i], ml_conv_b[i], ml_wq[i], ml_wk[i], ml_wv[i], ml_gate_w[i],
                            ml_gate_b[i], ml_norm[i], ml_skip[i], w_out_ab[i])
        else:
            y = _odd_layer(z, w_in_cd[i], diff_lq1[i], diff_lk1[i], diff_lq2[i], diff_lk2[i],
                           diff_norm[i], w_out_cd[i], l)
        h = h + _rmsnorm(y, post_norm[l])
    return h
```

```cpp
#include <hip/hip_runtime.h>
#include <stdint.h>
#include <stdio.h>

typedef unsigned short bf16_t;
typedef short bf16x8 __attribute__((ext_vector_type(8)));
typedef short bf16x4 __attribute__((ext_vector_type(4)));
typedef float f32x4 __attribute__((ext_vector_type(4)));
typedef float f32x2 __attribute__((ext_vector_type(2)));
typedef unsigned u32x4 __attribute__((ext_vector_type(4)));
typedef unsigned u32x2 __attribute__((ext_vector_type(2)));
#define LAS __attribute__((address_space(3)))
#define DEVI __device__ __forceinline__

constexpr int NB = 16, SEQ = 2048, DM = 1024, NT = NB * SEQ;
constexpr float LOG2E = 1.4426950408889634f;
constexpr size_t MiB = 1024ull * 1024ull;

constexpr size_t WS_CTL = 0;
constexpr size_t WS_LAM = 64 * 1024;
constexpr size_t WS_ROPE_C = 128 * 1024;
constexpr size_t WS_ROPE_S = 384 * 1024;
constexpr size_t WS_GF = 640 * 1024;
constexpr size_t WS_A32 = 704 * 1024;
constexpr size_t WS_WIN0 = 1 * MiB;
constexpr size_t WS_WOUT0 = 5 * MiB;
constexpr size_t WS_WIN1 = 7 * MiB;
constexpr size_t WS_WOUT1 = 15 * MiB;
constexpr size_t WS_GLU = 17 * MiB;
constexpr size_t WS_WQK = 17 * MiB + 512 * 1024;
constexpr size_t WS_WV = 18 * MiB + 512 * 1024;
constexpr size_t WS_BT5A = 19 * MiB;
constexpr size_t WS_BT5B = 43 * MiB;
constexpr size_t WS_R1 = 52 * MiB;
constexpr size_t WS_R2 = 116 * MiB;
constexpr size_t WS_R3 = 372 * MiB;
constexpr size_t WS_R4 = 436 * MiB;
constexpr size_t WS_R5 = 500 * MiB;
constexpr size_t WS_END = 506 * MiB;
constexpr size_t WS_PZ = WS_R2;
constexpr size_t WS_U5 = WS_R2 + 96 * MiB;
constexpr size_t WS_XC = WS_R2 + 128 * MiB;
constexpr size_t WS_VTMP = WS_R2 + 160 * MiB;
constexpr size_t WS_VT0 = WS_R2 + 192 * MiB;
constexpr size_t WS_YLOC = WS_R2 + 224 * MiB;
constexpr size_t WS_CQ = WS_R2;
constexpr size_t WS_CK = WS_R2 + 32 * MiB;
constexpr size_t WS_CVTMP = WS_R2 + 64 * MiB;
constexpr size_t WS_CZ = WS_R2 + 96 * MiB;
constexpr size_t WS_DQ = WS_R2 + 128 * MiB;
constexpr size_t WS_DK = WS_R2 + 160 * MiB;
constexpr size_t WS_DVTMP = WS_R2 + 192 * MiB;
constexpr size_t WS_DZ = WS_R2 + 224 * MiB;
constexpr size_t WS_Y1 = WS_R2;
constexpr size_t WS_XN = WS_R1;
constexpr size_t WS_QK = WS_R1;
constexpr size_t WS_Y0 = WS_R1;
constexpr size_t WS_AB = WS_R3;
constexpr size_t WS_XN1 = WS_R3;
constexpr size_t WS_CD = WS_R3;
constexpr size_t WS_XLOC = WS_R4;
constexpr size_t WS_XST = WS_R4 + 16 * MiB;
constexpr size_t WS_G5 = WS_R4 + 32 * MiB;
constexpr size_t WS_CVT = WS_R4;
constexpr size_t WS_DVT = WS_R4 + 32 * MiB;
constexpr size_t WS_LI = WS_R5;
constexpr size_t WS_LF = WS_R5 + 512 * 1024;
constexpr size_t WS_BC = WS_R5 + 1024 * 1024;
constexpr size_t WS_DS = WS_R5 + 1536 * 1024;
constexpr size_t WS_SS0 = WS_R5 + 2 * MiB;
constexpr size_t WS_SS1 = WS_R5 + 4 * MiB;

DEVI unsigned cvt_pk_bf16(float lo, float hi) { unsigned r; asm("v_cvt_pk_bf16_f32 %0, %1, %2" : "=v"(r) : "v"(lo), "v"(hi)); return r; }
DEVI float bf2f(unsigned v16) { return __uint_as_float(v16 << 16); }
DEVI float bflo(unsigned w) { return __uint_as_float(w << 16); }
DEVI float bfhi(unsigned w) { return __uint_as_float(w & 0xffff0000u); }
DEVI bf16_t f2bf(float f) { return (bf16_t)(cvt_pk_bf16(f, 0.f) & 0xffffu); }
DEVI float wave_sum(float v) { v += __shfl_xor(v, 32); v += __shfl_xor(v, 16); v += __shfl_xor(v, 8); v += __shfl_xor(v, 4); v += __shfl_xor(v, 2); v += __shfl_xor(v, 1); return v; }
DEVI float fast_exp2(float x) { return __builtin_amdgcn_exp2f(x); }
DEVI float silu_f(float x) { return x / (1.0f + __expf(-x)); }
DEVI float sigmoid_f(float x) { return 1.0f / (1.0f + __expf(-x)); }
DEVI float gelu_tanh_f(float x) { const float u = 0.7978845608028654f * (x + 0.044715f * x * x * x); const float e = __expf(2.0f * u); const float th = 1.0f - 2.0f / (e + 1.0f); return 0.5f * x * (1.0f + th); }
DEVI f32x4 mfma16(bf16x8 a, bf16x8 b, f32x4 c) { return __builtin_amdgcn_mfma_f32_16x16x32_bf16(a, b, c, 0, 0, 0); }
namespace pg8 {
constexpr int BM = 256, BK = 64, HALF = 128, HTB = HALF * BK * 2  , STAGE_BYTES = 8 * HTB, NXCD = 8, WGM = 8;

__host__ __device__ __forceinline__ int lds_byte(int r, int c) { const int st = (r >> 4) * 2 + (c >> 5), rr = r & 15, cc = c & 31, ob = rr * 64 + cc * 2; return st * 1024 + (ob ^ (((ob >> 9) & 1) << 5)); }
__host__ __device__ __forceinline__ void stage_rc(int b, int& R, int& C) { const int st = b / 1024, sb = b % 1024, swz = sb ^ (((sb >> 9) & 1) << 5); R = (st >> 1) * 16 + swz / 64; C = (st & 1) * 32 + (swz % 64) / 2; }
__host__ __device__ __forceinline__ int perm32(int rho) { const int n = rho >> 4, i = rho & 15; return 8 * (i >> 2) + 4 * n + (i & 3); }

struct Unit { int pm, pn; };
struct Gemm { const bf16_t* A; const bf16_t* Bt; int M, N, K, lda, ldb, grp_shift; size_t grp_bbytes; };

struct StaticOrder {
    int nM, nN, nwg, G, c;
    __host__ __device__ void init(int M, int N, int G_, int c_) { nM = M / BM; nN = N / BM; nwg = nM * nN; G = G_; c = c_; }
    __host__ __device__ bool next(int i, Unit& u) const {
        const long L = (long)i * G + c; if (L >= nwg) return false;
        int wgid = (int)L; { const int q = nwg / NXCD, r = nwg % NXCD, xcd = wgid % NXCD, off = wgid / NXCD; wgid = (xcd < r ? xcd * (q + 1) : r * (q + 1) + (xcd - r) * q) + off; }
        const int nig = WGM * nN, gid = wgid / nig, fm = gid * WGM, gsz = (nM - fm) < WGM ? (nM - fm) : WGM;
        u.pm = fm + ((wgid % nig) % gsz); u.pn = (wgid % nig) / gsz; return true;
    }
};

template <class Epi>
__device__ __forceinline__ void gemm_phase(LAS unsigned char* lds, const Gemm g, const StaticOrder& S, const Epi& E) {
    const int tid = threadIdx.x, wid = __builtin_amdgcn_readfirstlane(tid >> 6), lane = tid & 63, wr = wid >> 2, wc = wid & 3, fr = lane & 15, fq = lane >> 4;
    int nt = g.K / BK; asm volatile("" : "+s"(nt));
    unsigned voffA[2], voffB[2];
#pragma unroll
    for (int i = 0; i < 2; ++i) { int R, C; stage_rc(tid * 16 + i * 8192, R, C); const int Rb = (R & ~31) + perm32(R & 31);
        voffA[i] = (unsigned)(R * g.lda + C) * 2u; voffB[i] = (unsigned)(Rb * g.ldb + C) * 2u; }
    const size_t kstep = (size_t)(BK * 2);
    const size_t hstepA = (size_t)HALF * g.lda * 2, hstepB = (size_t)HALF * g.ldb * 2;
    const size_t tstepA = 2 * hstepA, tstepB = 2 * hstepB;
    const unsigned ldsw = (unsigned)wid * 1024u;
    const int aoff = lds_byte(wr * 64 + fr, fq * 8), boff = lds_byte(wc * 32 + fr, fq * 8);
#define PG8_SA(b, h) (((b) * 2 + (h)) * HTB)
#define PG8_SB(b, h) ((4 + (b) * 2 + (h)) * HTB)
#define PG8_STAGE(bufoff, gbase, voff) do { _Pragma("unroll") for (int _i = 0; _i < 2; ++_i) \
        __builtin_amdgcn_global_load_lds((const unsigned*)((const char*)(gbase) + (voff)[_i]), (LAS unsigned*)(lds + (bufoff) + ldsw + _i * 8192), 16, 0, 0); } while (0)
#define PG8_LDA(dst, b, h) do { _Pragma("unroll") for (int m = 0; m < 4; ++m) _Pragma("unroll") for (int k = 0; k < 2; ++k) dst[m][k] = *(const LAS bf16x8*)(lds + PG8_SA(b, h) + aoff + m * 2048 + k * 1024); } while (0)
#define PG8_LDB(dst, b, h) do { _Pragma("unroll") for (int n = 0; n < 2; ++n) _Pragma("unroll") for (int k = 0; k < 2; ++k) dst[n][k] = *(const LAS bf16x8*)(lds + PG8_SB(b, h) + boff + n * 2048 + k * 1024); } while (0)
#define PG8_MMA(ai, bj, At, Bt) do { __builtin_amdgcn_s_setprio(1); _Pragma("unroll") for (int m = 0; m < 4; ++m) _Pragma("unroll") for (int n = 0; n < 2; ++n) _Pragma("unroll") for (int k = 0; k < 2; ++k) \
        acc[ai][bj][m][n] = __builtin_amdgcn_mfma_f32_16x16x32_bf16(Bt[n][k], At[m][k], acc[ai][bj][m][n], 0, 0, 0); __builtin_amdgcn_s_setprio(0); } while (0)
#define PG8_WAIT_V(n) asm volatile("s_waitcnt vmcnt(" #n ")" ::: "memory")
#define PG8_WAIT_L(n) asm volatile("s_waitcnt lgkmcnt(" #n ")" ::: "memory")
#define PG8_BAR __builtin_amdgcn_s_barrier()
#define PG8_SCHED __builtin_amdgcn_sched_barrier(0)
#define PG8_BBASE(u) ((const char*)g.Bt + (size_t)((u).pm >> g.grp_shift) * g.grp_bbytes + (size_t)(u).pn * tstepB)
    Unit cur, nxt; int ui = 0;
    if (!S.next(0, cur)) return;
    f32x4 acc[2][2][4][2];
#pragma unroll
    for (int a = 0; a < 2; ++a)
#pragma unroll
        for (int b = 0; b < 2; ++b)
#pragma unroll
            for (int m = 0; m < 4; ++m)
#pragma unroll
                for (int n = 0; n < 2; ++n) acc[a][b][m][n] = (f32x4){0.f, 0.f, 0.f, 0.f};
    bf16x8 At[4][2], B0[2][2], B1[2][2];
    const char* cA = (const char*)g.A + (size_t)cur.pm * tstepA; const char* cB = PG8_BBASE(cur);
    PG8_STAGE(PG8_SB(0, 0), cB, voffB); PG8_STAGE(PG8_SA(0, 0), cA, voffA); PG8_STAGE(PG8_SB(0, 1), cB + hstepB, voffB); PG8_STAGE(PG8_SA(0, 1), cA + hstepA, voffA);
    if (wr == 1) PG8_BAR;
    PG8_WAIT_V(4); PG8_BAR;
    PG8_STAGE(PG8_SB(1, 0), cB + kstep, voffB); PG8_STAGE(PG8_SA(1, 0), cA + kstep, voffA); PG8_STAGE(PG8_SB(1, 1), cB + hstepB + kstep, voffB);
    PG8_WAIT_V(6); PG8_BAR;
    for (;;) {
        const bool has_next = S.next(ui + 1, nxt);
        const char* nA = has_next ? (const char*)g.A + (size_t)nxt.pm * tstepA : cA; const char* nB = has_next ? PG8_BBASE(nxt) : cB;
        for (int t = 0; t < nt; t += 2) {
            const bool last = (t == nt - 2);
            const char* a1 = cA + (size_t)(t + 1) * kstep;
            const char* a2 = last ? nA : cA + (size_t)(t + 2) * kstep; const char* b2 = last ? nB : cB + (size_t)(t + 2) * kstep;
            const char* a3 = a2 + kstep; const char* b3 = b2 + kstep;
            PG8_LDB(B0, 0, 0); PG8_SCHED; PG8_LDA(At, 0, 0); PG8_STAGE(PG8_SA(1, 1), a1 + hstepA, voffA);
            PG8_WAIT_L(8); PG8_BAR; PG8_WAIT_L(0); PG8_MMA(0, 0, At, B0); PG8_BAR; PG8_SCHED;
            PG8_LDB(B1, 0, 1); PG8_STAGE(PG8_SB(0, 0), b2, voffB);
            PG8_BAR; PG8_WAIT_L(0); PG8_MMA(0, 1, At, B1); PG8_BAR;
            PG8_LDA(At, 0, 1); PG8_STAGE(PG8_SA(0, 0), a2, voffA);
            PG8_BAR; PG8_WAIT_L(0); PG8_MMA(1, 0, At, B0); PG8_BAR; PG8_SCHED;
            PG8_STAGE(PG8_SB(0, 1), b2 + hstepB, voffB);
            PG8_WAIT_V(6); PG8_BAR; PG8_MMA(1, 1, At, B1); PG8_BAR;
            PG8_LDB(B0, 1, 0); PG8_SCHED; PG8_LDA(At, 1, 0); PG8_STAGE(PG8_SA(0, 1), a2 + hstepA, voffA);
            PG8_WAIT_L(8); PG8_BAR; PG8_WAIT_L(0); PG8_MMA(0, 0, At, B0); PG8_BAR; PG8_SCHED;
            PG8_LDB(B1, 1, 1); PG8_STAGE(PG8_SB(1, 0), b3, voffB);
            PG8_BAR; PG8_WAIT_L(0); PG8_MMA(0, 1, At, B1); PG8_BAR;
            PG8_LDA(At, 1, 1); PG8_STAGE(PG8_SA(1, 0), a3, voffA);
            PG8_BAR; PG8_WAIT_L(0); PG8_MMA(1, 0, At, B0); PG8_BAR; PG8_SCHED;
            PG8_STAGE(PG8_SB(1, 1), b3 + hstepB, voffB);
            PG8_WAIT_V(6); PG8_BAR; PG8_MMA(1, 1, At, B1); PG8_BAR;
        }
        E(acc, cur, wr, wc, fr, fq);
        if (!has_next) break;
#pragma unroll
        for (int a = 0; a < 2; ++a)
#pragma unroll
            for (int b = 0; b < 2; ++b)
#pragma unroll
                for (int m = 0; m < 4; ++m)
#pragma unroll
                    for (int n = 0; n < 2; ++n) acc[a][b][m][n] = (f32x4){0.f, 0.f, 0.f, 0.f};
        cur = nxt; cA = nA; cB = nB; ++ui;
    }
    PG8_WAIT_V(0);
    if (wr == 0) PG8_BAR;
    PG8_BAR;
#undef PG8_SA
#undef PG8_SB
#undef PG8_STAGE
#undef PG8_LDA
#undef PG8_LDB
#undef PG8_MMA
#undef PG8_WAIT_V
#undef PG8_WAIT_L
#undef PG8_BAR
#undef PG8_SCHED
#undef PG8_BBASE
}
}
#define XB_TMO      128
#define XB_XCNT(j)  (256  + 64 * (j))
#define XB_XSUB(j)  (1280 + 64 * (j))
#define XB_XGEN(j)  (2304 + 64 * (j))
#define XB_TOP      3328
#define XB_TOPGEN   3392
#define XCD_BAR_WORDS 3456
#define XB_SPIN_CAP (1u << 22)
__device__ __forceinline__ unsigned xb_ld(unsigned* p)              { return __hip_atomic_load(p, __ATOMIC_RELAXED, __HIP_MEMORY_SCOPE_AGENT); }
__device__ __forceinline__ unsigned xb_add(unsigned* p, unsigned v) { return __hip_atomic_fetch_add(p, v, __ATOMIC_RELAXED, __HIP_MEMORY_SCOPE_AGENT); }
__device__ __forceinline__ unsigned xb_xcc_id() { return (unsigned)__builtin_amdgcn_s_getreg((3 << 11) | 20) & 0xFu; }
#define XB_SPIN(cond, bar) do { unsigned _sp = 0; while (cond) { __builtin_amdgcn_s_sleep(1); \
    if ((++_sp & 255u) == 0u) { if (xb_ld(&(bar)[XB_TMO])) break; if (_sp > XB_SPIN_CAP) { atomicAdd(&(bar)[XB_TMO], 1u); break; } } } } while (0)
struct XcdBarrier { unsigned* bar; unsigned x; volatile LAS unsigned* st; };
__device__ __forceinline__ XcdBarrier xcd_barrier_post(unsigned* bar, volatile LAS unsigned* st) {
    XcdBarrier b; b.bar = bar; b.x = xb_xcc_id(); b.st = st;
    if (threadIdx.x == 0) (void)xb_add(&bar[XB_XCNT(b.x)], 1u);
    return b;
}
__device__ __forceinline__ void xcd_barrier_complete(unsigned* bar, unsigned x, unsigned& nloc, unsigned& nx) {
    const unsigned G = gridDim.x * gridDim.y * gridDim.z;
    unsigned sum, cnt, mine, sp = 0u;
    for (;;) {
        sum = 0u; cnt = 0u; mine = 0u;
#pragma unroll
        for (unsigned j = 0; j < 16; ++j) { const unsigned c = xb_ld(&bar[XB_XCNT(j)]); sum += c; cnt += (c > 0u) ? 1u : 0u; mine = (j == x) ? c : mine; }
        if (sum == G) break;
        __builtin_amdgcn_s_sleep(1);
        if ((++sp & 255u) == 0u) { if (xb_ld(&bar[XB_TMO])) break; if (sp > XB_SPIN_CAP) { atomicAdd(&bar[XB_TMO], 1u); break; } }
    }
    nloc = mine > 0u ? mine : 1u; nx = cnt > 0u ? cnt : 1u;
}
__device__ __forceinline__ void xcd_barrier(const XcdBarrier& b) {
    asm volatile("s_waitcnt vmcnt(0)" ::: "memory");
    __syncthreads();
    if (threadIdx.x == 0) {
        unsigned* bar = b.bar;
        __builtin_amdgcn_s_waitcnt(0);
        unsigned nloc = b.st[0], nx = b.st[1];
        if (nloc == 0u) { xcd_barrier_complete(bar, b.x, nloc, nx); b.st[0] = nloc; b.st[1] = nx; }
        const unsigned old = xb_add(&bar[XB_XSUB(b.x)], 1u);
        const unsigned gen = old / nloc;
        if (old + 1u == (gen + 1u) * nloc) {
            __builtin_amdgcn_fence(__ATOMIC_RELEASE, "agent");
            asm volatile("s_waitcnt vmcnt(0)" ::: "memory");
            const unsigned og = xb_add(&bar[XB_TOP], 1u);
            const unsigned tg = og / nx;
            if (og + 1u == (tg + 1u) * nx) xb_add(&bar[XB_TOPGEN], 1u);
            else XB_SPIN(xb_ld(&bar[XB_TOPGEN]) == tg, bar);
            __builtin_amdgcn_fence(__ATOMIC_ACQUIRE, "agent");
            xb_add(&bar[XB_XGEN(b.x)], 1u);
            asm volatile("s_waitcnt vmcnt(0)" ::: "memory");
        } else {
            XB_SPIN(xb_ld(&bar[XB_XGEN(b.x)]) == gen, bar);
            __builtin_amdgcn_fence(__ATOMIC_ACQUIRE, "agent");
            asm volatile("s_waitcnt vmcnt(0)" ::: "memory");
        }
    }
    __syncthreads();
}

enum { EM_IN0 = 0, EM_PLAIN = 1, EM_S5A = 2, EM_S5B = 3, EM_GLU = 4, EM_OUT = 5, EM_IN1 = 6 };
template <int mode> struct EpiMulti {
    int ldc;
    bf16_t* o0; bf16_t* o1; float* f0;
    const bf16_t* i0; const bf16_t* i1; const float* c0; const float* c1;
    unsigned char* ws;
    __device__ __forceinline__ void operator()(const f32x4 (&acc)[2][2][4][2], const pg8::Unit& u, int wr, int wc, int fr, int fq) const {
        const int rowb = u.pm * 256 + wr * 64 + fr;
        const int colb = u.pn * 256 + wc * 32 + 8 * fq;
#pragma unroll
        for (int ai = 0; ai < 2; ++ai)
#pragma unroll
            for (int m = 0; m < 4; ++m) {
                const int row = rowb + ai * 128 + m * 16;
                float ssq = 0.f;
#pragma unroll
                for (int bj = 0; bj < 2; ++bj) {
                    const int c = colb + bj * 128;
                    f32x4 v0 = acc[ai][bj][m][0], v1 = acc[ai][bj][m][1];
                    if constexpr (mode == EM_PLAIN) {
                        u32x4 w; w.x = cvt_pk_bf16(v0[0], v0[1]); w.y = cvt_pk_bf16(v0[2], v0[3]); w.z = cvt_pk_bf16(v1[0], v1[1]); w.w = cvt_pk_bf16(v1[2], v1[3]);
                        *(u32x4*)(o0 + (size_t)row * ldc + c) = w;
                    } else if constexpr (mode == EM_IN0) {
                        u32x4 w; w.x = cvt_pk_bf16(v0[0], v0[1]); w.y = cvt_pk_bf16(v0[2], v0[3]); w.z = cvt_pk_bf16(v1[0], v1[1]); w.w = cvt_pk_bf16(v1[2], v1[3]);
                        if (c < 512) {
                            const int g = c >> 4, b = row >> 11, l = row & 2047;
                            *(u32x4*)(o1 + ((size_t)((g * 16 + b) * 2048 + l)) * 16 + (c & 15)) = w;
                        } else {
                            *(u32x4*)(o0 + (size_t)row * 1536 + (c - 512)) = w;
                        }
                    } else if constexpr (mode == EM_S5A) {
                        if (c < 512) {
                            u32x4 w; w.x = cvt_pk_bf16(v0[0], v0[1]); w.y = cvt_pk_bf16(v0[2], v0[3]); w.z = cvt_pk_bf16(v1[0], v1[1]); w.w = cvt_pk_bf16(v1[2], v1[3]);
                            *(u32x4*)(o0 + (size_t)row * 512 + c) = w;
                        } else if (c < 640) {
                            float* p = f0 + (size_t)row * 128 + (c - 512);
                            *(f32x4*)p = v0; *(f32x4*)(p + 4) = v1;
                        }
                    } else if constexpr (mode == EM_S5B) {
                        const size_t idx = (size_t)row * 512 + c;
                        const u32x4 yl = *(const u32x4*)(i0 + idx), uu = *(const u32x4*)(i1 + idx);
                        const int g = row >> 10, b = (row >> 6) & 15, ck = row & 63, t = c >> 4, ch = c & 15;
                        const f32x4 d0 = *(const f32x4*)(c0 + g * 16 + ch), d1 = *(const f32x4*)(c0 + g * 16 + ch + 4);
                        float y[8];
                        y[0] = v0[0] + bflo(yl.x) + d0[0] * bflo(uu.x); y[1] = v0[1] + bfhi(yl.x) + d0[1] * bfhi(uu.x);
                        y[2] = v0[2] + bflo(yl.y) + d0[2] * bflo(uu.y); y[3] = v0[3] + bfhi(yl.y) + d0[3] * bfhi(uu.y);
                        y[4] = v1[0] + bflo(yl.z) + d1[0] * bflo(uu.z); y[5] = v1[1] + bfhi(yl.z) + d1[1] * bfhi(uu.z);
                        y[6] = v1[2] + bflo(yl.w) + d1[2] * bflo(uu.w); y[7] = v1[3] + bfhi(yl.w) + d1[3] * bfhi(uu.w);
#pragma unroll
                        for (int j = 0; j < 8; ++j) y[j] = gelu_tanh_f(y[j]);
                        u32x4 w; w.x = cvt_pk_bf16(y[0], y[1]); w.y = cvt_pk_bf16(y[2], y[3]); w.z = cvt_pk_bf16(y[4], y[5]); w.w = cvt_pk_bf16(y[6], y[7]);
                        const size_t tok = (size_t)b * 2048 + ck * 32 + t;
                        *(u32x4*)(o0 + tok * 512 + g * 16 + ch) = w;
                        asm volatile("" ::: "memory");
                    } else if constexpr (mode == EM_GLU) {
                        const u32x4 gg = *(const u32x4*)(i0 + (size_t)row * 512 + c), zz = *(const u32x4*)(i1 + (size_t)row * 1536 + c);
                        const f32x4 b0 = *(const f32x4*)(c0 + c), b1 = *(const f32x4*)(c0 + c + 4);
                        float y[8];
                        y[0] = bflo(gg.x) * sigmoid_f(v0[0] + b0[0]) * silu_f(bflo(zz.x)); y[1] = bfhi(gg.x) * sigmoid_f(v0[1] + b0[1]) * silu_f(bfhi(zz.x));
                        y[2] = bflo(gg.y) * sigmoid_f(v0[2] + b0[2]) * silu_f(bflo(zz.y)); y[3] = bfhi(gg.y) * sigmoid_f(v0[3] + b0[3]) * silu_f(bfhi(zz.y));
                        y[4] = bflo(gg.z) * sigmoid_f(v1[0] + b1[0]) * silu_f(bflo(zz.z)); y[5] = bfhi(gg.z) * sigmoid_f(v1[1] + b1[1]) * silu_f(bfhi(zz.z));
                        y[6] = bflo(gg.w) * sigmoid_f(v1[2] + b1[2]) * silu_f(bflo(zz.w)); y[7] = bfhi(gg.w) * sigmoid_f(v1[3] + b1[3]) * silu_f(bfhi(zz.w));
                        u32x4 w; w.x = cvt_pk_bf16(y[0], y[1]); w.y = cvt_pk_bf16(y[2], y[3]); w.z = cvt_pk_bf16(y[4], y[5]); w.w = cvt_pk_bf16(y[6], y[7]);
                        *(u32x4*)(o0 + (size_t)row * 1024 + c) = w;
                    } else if constexpr (mode == EM_OUT) {
                        u32x4 w; w.x = cvt_pk_bf16(v0[0], v0[1]); w.y = cvt_pk_bf16(v0[2], v0[3]); w.z = cvt_pk_bf16(v1[0], v1[1]); w.w = cvt_pk_bf16(v1[2], v1[3]);
                        *(u32x4*)(o0 + (size_t)row * 1024 + c) = w;
                        ssq += (v0[0] * v0[0] + v0[1] * v0[1]) + (v0[2] * v0[2] + v0[3] * v0[3]) + (v1[0] * v1[0] + v1[1] * v1[1]) + (v1[2] * v1[2] + v1[3] * v1[3]);
                    } else {
                        const int blk = c >> 9, cc = c & 511, b = row >> 11, l = row & 2047;
                        if (blk == 0 || blk == 1 || blk == 4 || blk == 5) {
                            const int hh = cc >> 6, p = cc & 63, j0 = (p >> 3) * 4;
                            const f32x4 cs = *(const f32x4*)(c0 + l * 32 + j0), sn = *(const f32x4*)(c1 + l * 32 + j0);
                            f32x4 r0, r1;
#pragma unroll
                            for (int e = 0; e < 4; ++e) { r0[e] = v0[e] * cs[e] - v1[e] * sn[e]; r1[e] = v1[e] * cs[e] + v0[e] * sn[e]; }
                            u32x4 w; w.x = cvt_pk_bf16(r0[0], r0[1]); w.y = cvt_pk_bf16(r0[2], r0[3]); w.z = cvt_pk_bf16(r1[0], r1[1]); w.w = cvt_pk_bf16(r1[2], r1[3]);
                            bf16_t* base = (bf16_t*)(ws + (blk == 0 ? WS_CQ : blk == 1 ? WS_CK : blk == 4 ? WS_DQ : WS_DK));
                            size_t off;
                            if (blk < 2) off = ((size_t)(((b * 8 + hh) * 16 + (l & 15)) * 128 + (l >> 4))) * 64 + p;
                            else off = ((size_t)((b * 8 + hh) * 2048 + l)) * 64 + p;
                            *(u32x4*)(base + off) = w;
                        } else {
                            u32x4 w; w.x = cvt_pk_bf16(v0[0], v0[1]); w.y = cvt_pk_bf16(v0[2], v0[3]); w.z = cvt_pk_bf16(v1[0], v1[1]); w.w = cvt_pk_bf16(v1[2], v1[3]);
                            bf16_t* base = (bf16_t*)(ws + (blk == 2 ? WS_CVTMP : blk == 3 ? WS_CZ : blk == 6 ? WS_DVTMP : WS_DZ));
                            *(u32x4*)(base + (size_t)row * 512 + cc) = w;
                        }
                    }
                }
                if constexpr (mode == EM_OUT) {
                    ssq += __shfl_xor(ssq, 16); ssq += __shfl_xor(ssq, 32);
                    if (fq == 0) f0[(size_t)row * 16 + u.pn * 4 + wc] = ssq;
                }
                asm volatile("" ::: "memory");
            }
    }
};
struct Params { const float* in[31]; float* out; unsigned char* ws; int ph_lo, ph_hi; };
struct Ctx {
    const float* const* in; float* out; unsigned char* ws;
    LAS unsigned char* lds; int tid, lane, wid, G, bid;
};
#define WSP(T, off) ((T*)(C.ws + (off)))

DEVI void rows_pass(const Ctx& C, int mode) {
    const float* x = C.in[0];
    const float* pre = C.in[1]; const float* post = C.in[2];
    const bf16_t* Y0 = WSP(const bf16_t, WS_Y0); const bf16_t* Y1 = WSP(const bf16_t, WS_Y1);
    const float* SS0 = WSP(const float, WS_SS0); const float* SS1 = WSP(const float, WS_SS1);
    bf16_t* XN = (mode == 0) ? WSP(bf16_t, WS_XN) : WSP(bf16_t, WS_XN1);
    const int gw = C.bid * 8 + C.wid, nw = C.G * 8, lane = C.lane;
    for (int r = gw; r < NT; r += nw) {
        f32x4 v[4];
#pragma unroll
        for (int i = 0; i < 4; ++i) v[i] = *(const f32x4*)(x + (size_t)r * 1024 + i * 256 + lane * 4);
        if (mode >= 1) {
            float s0 = (lane < 16) ? SS0[(size_t)r * 16 + lane] : 0.f; s0 = wave_sum(s0);
            const float rs0 = rsqrtf(s0 * (1.0f / 1024.0f) + 1e-6f);
#pragma unroll
            for (int i = 0; i < 4; ++i) {
                const u32x2 y = *(const u32x2*)(Y0 + (size_t)r * 1024 + i * 256 + lane * 4);
                const f32x4 gp = *(const f32x4*)(post + i * 256 + lane * 4);
                v[i][0] += bflo(y.x) * rs0 * gp[0]; v[i][1] += bfhi(y.x) * rs0 * gp[1]; v[i][2] += bflo(y.y) * rs0 * gp[2]; v[i][3] += bfhi(y.y) * rs0 * gp[3];
            }
        }
        if (mode == 2) {
            float s1 = (lane < 16) ? SS1[(size_t)r * 16 + lane] : 0.f; s1 = wave_sum(s1);
            const float rs1 = rsqrtf(s1 * (1.0f / 1024.0f) + 1e-6f);
#pragma unroll
            for (int i = 0; i < 4; ++i) {
                const u32x2 y = *(const u32x2*)(Y1 + (size_t)r * 1024 + i * 256 + lane * 4);
                const f32x4 gp = *(const f32x4*)(post + 1024 + i * 256 + lane * 4);
                f32x4 o = v[i];
                o[0] += bflo(y.x) * rs1 * gp[0]; o[1] += bfhi(y.x) * rs1 * gp[1]; o[2] += bflo(y.y) * rs1 * gp[2]; o[3] += bfhi(y.y) * rs1 * gp[3];
                *(f32x4*)(C.out + (size_t)r * 1024 + i * 256 + lane * 4) = o;
            }
        } else {
            float ss = 0.f;
#pragma unroll
            for (int i = 0; i < 4; ++i) ss += (v[i][0] * v[i][0] + v[i][1] * v[i][1]) + (v[i][2] * v[i][2] + v[i][3] * v[i][3]);
            ss = wave_sum(ss);
            const float rs = rsqrtf(ss * (1.0f / 1024.0f) + 1e-6f);
            const float* gpre = pre + (mode == 0 ? 0 : 1024);
#pragma unroll
            for (int i = 0; i < 4; ++i) {
                const f32x4 gp = *(const f32x4*)(gpre + i * 256 + lane * 4);
                u32x2 w; w.x = cvt_pk_bf16(v[i][0] * rs * gp[0], v[i][1] * rs * gp[1]); w.y = cvt_pk_bf16(v[i][2] * rs * gp[2], v[i][3] * rs * gp[3]);
                *(u32x2*)(XN + (size_t)r * 1024 + i * 256 + lane * 4) = w;
            }
        }
    }
}

DEVI int rope_dim(int p) { return ((p & 7) < 4) ? (4 * (p >> 3) + (p & 7)) : (32 + 4 * (p >> 3) + ((p & 7) - 4)); }
DEVI void wt_tile(const Ctx& C, const float* W, int K, int N, bf16_t* Wt, int tile, bool rope_perm) {
    LAS float* T = (LAS float*)C.lds;
    const int ntn = N / 64, tk = tile / ntn, tn = tile % ntn, k0 = tk * 64, n0 = tn * 64, tid = C.tid;
    __syncthreads();
#pragma unroll
    for (int i = 0; i < 2; ++i) { const int e = tid + i * 512, r = e >> 4, c4 = (e & 15) * 4;
        const f32x4 v = *(const f32x4*)(W + (size_t)(k0 + r) * N + n0 + c4);
        T[r * 65 + c4 + 0] = v[0]; T[r * 65 + c4 + 1] = v[1]; T[r * 65 + c4 + 2] = v[2]; T[r * 65 + c4 + 3] = v[3]; }
    __syncthreads();
    const int nn = tid >> 3, kc = (tid & 7) * 8;
    bool perm = false;
    if (rope_perm) { const int blk = n0 >> 9; perm = (blk == 0 || blk == 1 || blk == 4 || blk == 5); }
    const int src = perm ? rope_dim(nn) : nn;
    float f[8];
#pragma unroll
    for (int j = 0; j < 8; ++j) f[j] = T[(kc + j) * 65 + src];
    u32x4 w; w.x = cvt_pk_bf16(f[0], f[1]); w.y = cvt_pk_bf16(f[2], f[3]); w.z = cvt_pk_bf16(f[4], f[5]); w.w = cvt_pk_bf16(f[6], f[7]);
    *(u32x4*)(Wt + (size_t)(n0 + nn) * K + k0 + kc) = w;
}

DEVI void s5_tables(const Ctx& C, int g, int part) {
    LAS float* APr = (LAS float*)C.lds;
    LAS float* APi = APr + 64 * 33;
    LAS float* BBr = APi + 64 * 33;
    LAS float* BBi = BBr + 1024;
    LAS float* Cr = BBi + 1024;
    LAS float* Ci = Cr + 1024;
    LAS float* KL = Ci + 1024;
    const int tid = C.tid;
    const float* lre = C.in[4]; const float* lim = C.in[5]; const float* ldt = C.in[6];
    const float* bre = C.in[7]; const float* bim = C.in[8]; const float* cre = C.in[9]; const float* cim = C.in[10];
    __syncthreads();
    if (tid < 64) {
        const int p = tid;
        const float lr = lre[g * 64 + p], li = lim[g * 64 + p], dt = expf(ldt[g]);
        const float mag = expf(lr * dt);
        const float ar = mag * cosf(li * dt), ai = mag * sinf(li * dt);
        const float den = lr * lr + li * li;
        const float fr = ((ar - 1.0f) * lr + ai * li) / den, fi = (ai * lr - (ar - 1.0f) * li) / den;
        double pr = 1.0, pi = 0.0;
        for (int k = 0; k <= 32; ++k) { APr[p * 33 + k] = (float)pr; APi[p * 33 + k] = (float)pi; const double nr = pr * (double)ar - pi * (double)ai, ni = pr * (double)ai + pi * (double)ar; pr = nr; pi = ni; }
        for (int c = 0; c < 16; ++c) { const float br = bre[(g * 64 + p) * 16 + c], bi = bim[(g * 64 + p) * 16 + c]; BBr[p * 16 + c] = fr * br - fi * bi; BBi[p * 16 + c] = fr * bi + fi * br; }
    }
    for (int e = tid; e < 1024; e += 512) { Cr[e] = cre[g * 1024 + e]; Ci[e] = cim[g * 1024 + e]; }
    __syncthreads();
    for (int e = tid; e < 8192; e += 512) {
        const int k = e >> 8, c = (e >> 4) & 15, cp = e & 15; float s = 0.f;
        for (int p = 0; p < 64; ++p) { const float a_r = APr[p * 33 + k], a_i = APi[p * 33 + k], c_r = Cr[c * 64 + p], c_i = Ci[c * 64 + p];
            const float car = c_r * a_r - c_i * a_i, cai = c_r * a_i + c_i * a_r; s += car * BBr[p * 16 + cp] - cai * BBi[p * 16 + cp]; }
        KL[e] = s;
    }
    __syncthreads();
    bf16_t* A5 = WSP(bf16_t, WS_BT5A) + (size_t)g * 768 * 512;
    bf16_t* B5 = WSP(bf16_t, WS_BT5B) + (size_t)g * 512 * 256;
    for (int e = tid; e < 96 * 64; e += 512) {
        const int R = part * 96 + (e >> 6), col0 = (e & 63) * 8; float f[8];
        if (R < 512) { const int t = R >> 4, c = R & 15, s = col0 >> 4, cp0 = col0 & 15;
#pragma unroll
            for (int j = 0; j < 8; ++j) f[j] = (s <= t) ? KL[(t - s) * 256 + c * 16 + cp0 + j] : 0.f;
        } else if (R < 640) { const int pp = R - 512, p = pp >> 1, ri = pp & 1, s = col0 >> 4, cp0 = col0 & 15;
            const float a_r = APr[p * 33 + (31 - s)], a_i = APi[p * 33 + (31 - s)];
#pragma unroll
            for (int j = 0; j < 8; ++j) { const float b_r = BBr[p * 16 + cp0 + j], b_i = BBi[p * 16 + cp0 + j]; f[j] = ri ? (a_r * b_i + a_i * b_r) : (a_r * b_r - a_i * b_i); }
        } else {
#pragma unroll
            for (int j = 0; j < 8; ++j) f[j] = 0.f;
        }
        u32x4 w; w.x = cvt_pk_bf16(f[0], f[1]); w.y = cvt_pk_bf16(f[2], f[3]); w.z = cvt_pk_bf16(f[4], f[5]); w.w = cvt_pk_bf16(f[6], f[7]);
        *(u32x4*)(A5 + (size_t)R * 512 + col0) = w;
    }
    for (int e = tid; e < 64 * 32; e += 512) {
        const int R = part * 64 + (e >> 5), col0 = (e & 31) * 8, t = R >> 4, c = R & 15; float f[8];
        if (col0 < 128) {
#pragma unroll
            for (int j = 0; j < 4; ++j) { const int p = (col0 >> 1) + j; const float a_r = APr[p * 33 + t + 1], a_i = APi[p * 33 + t + 1], c_r = Cr[c * 64 + p], c_i = Ci[c * 64 + p];
                f[2 * j] = c_r * a_r - c_i * a_i; f[2 * j + 1] = -(c_r * a_i + c_i * a_r); }
        } else {
#pragma unroll
            for (int j = 0; j < 8; ++j) f[j] = 0.f;
        }
        u32x4 w; w.x = cvt_pk_bf16(f[0], f[1]); w.y = cvt_pk_bf16(f[2], f[3]); w.z = cvt_pk_bf16(f[4], f[5]); w.w = cvt_pk_bf16(f[6], f[7]);
        *(u32x4*)(B5 + (size_t)R * 256 + col0) = w;
    }
    if (part == 0 && tid < 64) { f32x2 a; a.x = APr[tid * 33 + 32]; a.y = APi[tid * 33 + 32]; WSP(f32x2, WS_A32)[g * 64 + tid] = a; }
}

DEVI void phase_prologue(const Ctx& C) {
    const int tid = C.tid, G = C.G, bid = C.bid;
    {
        const int t0 = 16 * 32, t1 = t0 + 16 * 16, t2 = t1 + 16 * 64, t3 = t2 + 16 * 16, t4 = t3 + 8 * 8;
        for (int j = bid; j < t4; j += G) {
            if (j < t0) wt_tile(C, C.in[3], 1024, 2048, WSP(bf16_t, WS_WIN0), j, false);
            else if (j < t1) wt_tile(C, C.in[23], 1024, 1024, WSP(bf16_t, WS_WOUT0), j - t0, false);
            else if (j < t2) wt_tile(C, C.in[24], 1024, 4096, WSP(bf16_t, WS_WIN1), j - t1, true);
            else if (j < t3) wt_tile(C, C.in[30], 1024, 1024, WSP(bf16_t, WS_WOUT1), j - t2, false);
            else wt_tile(C, C.in[12], 512, 512, WSP(bf16_t, WS_GLU), j - t3, false);
        }
    }
    for (int j = bid; j < 256; j += G) s5_tables(C, j >> 3, j & 7);
    const int gt = bid * 512 + tid, ngt = G * 512;
    {
        const float* wq = C.in[16]; const float* wk = C.in[17]; const float* wv = C.in[18];
        bf16_t* WQK = WSP(bf16_t, WS_WQK); bf16_t* WV = WSP(bf16_t, WS_WV);
        for (int e = gt; e < 1536 * 512; e += ngt) {
            const int n = e >> 9, k = e & 511; const int nn = n & 511, h = nn >> 7, ee = nn & 127; float v = 0.f;
            if ((k >> 7) == h) { const int d = k & 127; const size_t wi = ((size_t)h * 128 + d) * 128 + ee;
                v = (n < 512) ? wq[wi] : (n < 1024) ? wk[wi] * 0.08838834764831845f : wv[wi]; }
            if (n < 1024) WQK[(size_t)n * 512 + k] = f2bf(v); else WV[(size_t)(n - 1024) * 512 + k] = f2bf(v);
        }
        const float* gw = C.in[19]; float* GF = WSP(float, WS_GF);
        for (int e = gt; e < 1024 * 8; e += ngt) {
            const int rr = e >> 3, j = e & 7, ch = rr & 511, h = ch >> 7, d = ch & 127; float s = 0.f;
            if (rr < 512) { for (int ee = 0; ee < 128; ++ee) { const size_t wi = ((size_t)h * 128 + d) * 128 + ee; s += wq[wi] * gw[(size_t)(h * 128 + ee) * 8 + j] + wk[wi] * gw[(size_t)(512 + h * 128 + ee) * 8 + j]; } }
            else { for (int ee = 0; ee < 128; ++ee) { const size_t wi = ((size_t)h * 128 + d) * 128 + ee; s += wv[wi] * gw[(size_t)(1024 + h * 128 + ee) * 8 + j]; } }
            GF[e] = s;
        }
    }
    {
        float* RC = WSP(float, WS_ROPE_C); float* RS = WSP(float, WS_ROPE_S);
        for (int e = gt; e < 2048 * 32; e += ngt) { const int pos = e >> 5, j = e & 31; const float inv = powf(10000.0f, -(float)(2 * j) / 64.0f); const float ang = (float)pos * inv; RC[e] = cosf(ang); RS[e] = sinf(ang); }
    }
    if (bid == 0 && tid == 0) {
        float s1 = 0.f, s2 = 0.f; for (int j = 0; j < 64; ++j) { s1 += C.in[25][j] * C.in[26][j]; s2 += C.in[27][j] * C.in[28][j]; }
        WSP(float, WS_LAM)[0] = expf(s1) - expf(s2) + (0.8f - 0.6f * expf(-0.3f));
    }
    rows_pass(C, 0);
}

DEVI void phase_conv_gates(const Ctx& C) {
    const bf16_t* PZ = WSP(const bf16_t, WS_PZ); bf16_t* XC = WSP(bf16_t, WS_XC);
    float* LI = WSP(float, WS_LI); float* LF = WSP(float, WS_LF);
    const float* cw = C.in[14]; const float* cb = C.in[15]; const float* gb = C.in[20];
    LAS float* GFs = (LAS float*)C.lds;
    __syncthreads();
    for (int e = C.tid; e < 8192; e += 512) GFs[e] = WSP(const float, WS_GF)[e];
    __syncthreads();
    const int lane = C.lane, ch0 = lane * 8;
    float w[4][8], bb[8];
#pragma unroll
    for (int j = 0; j < 4; ++j)
#pragma unroll
        for (int i = 0; i < 8; ++i) w[j][i] = cw[j * 512 + ch0 + i];
#pragma unroll
    for (int i = 0; i < 8; ++i) bb[i] = cb[ch0 + i];
    const int gw = C.bid * 8 + C.wid, nw = C.G * 8;
    for (int r = gw; r < NT; r += nw) {
        const int l = r & 2047;
        float xs[4][8];
#pragma unroll
        for (int j = 0; j < 4; ++j) {
            const int dl = 3 - j;
            if (l - dl >= 0) { const u32x4 q = *(const u32x4*)(PZ + (size_t)(r - dl) * 1536 + 512 + ch0);
                xs[j][0] = bflo(q.x); xs[j][1] = bfhi(q.x); xs[j][2] = bflo(q.y); xs[j][3] = bfhi(q.y); xs[j][4] = bflo(q.z); xs[j][5] = bfhi(q.z); xs[j][6] = bflo(q.w); xs[j][7] = bfhi(q.w); }
            else {
#pragma unroll
                for (int i = 0; i < 8; ++i) xs[j][i] = 0.f; }
        }
        float xc[8];
#pragma unroll
        for (int i = 0; i < 8; ++i) { const float a = bb[i] + xs[0][i] * w[0][i] + xs[1][i] * w[1][i] + xs[2][i] * w[2][i] + xs[3][i] * w[3][i]; xc[i] = silu_f(a); }
        u32x4 o; o.x = cvt_pk_bf16(xc[0], xc[1]); o.y = cvt_pk_bf16(xc[2], xc[3]); o.z = cvt_pk_bf16(xc[4], xc[5]); o.w = cvt_pk_bf16(xc[6], xc[7]);
        *(u32x4*)(XC + (size_t)r * 512 + ch0) = o;
        float gt8[8];
#pragma unroll
        for (int j = 0; j < 8; ++j) gt8[j] = 0.f;
#pragma unroll
        for (int i = 0; i < 8; ++i) {
            const f32x4 a0 = *(const LAS f32x4*)(GFs + (ch0 + i) * 8), a1 = *(const LAS f32x4*)(GFs + (ch0 + i) * 8 + 4);
            const f32x4 b0 = *(const LAS f32x4*)(GFs + (512 + ch0 + i) * 8), b1 = *(const LAS f32x4*)(GFs + (512 + ch0 + i) * 8 + 4);
            const float xcv = xc[i], xmv = xs[3][i];
            gt8[0] += xcv * a0[0] + xmv * b0[0]; gt8[1] += xcv * a0[1] + xmv * b0[1]; gt8[2] += xcv * a0[2] + xmv * b0[2]; gt8[3] += xcv * a0[3] + xmv * b0[3];
            gt8[4] += xcv * a1[0] + xmv * b1[0]; gt8[5] += xcv * a1[1] + xmv * b1[1]; gt8[6] += xcv * a1[2] + xmv * b1[2]; gt8[7] += xcv * a1[3] + xmv * b1[3];
        }
#pragma unroll
        for (int j = 0; j < 8; ++j) gt8[j] = wave_sum(gt8[j]);
        if (lane < 8) {
            float gsel = gt8[0];
#pragma unroll
            for (int j = 1; j < 8; ++j) gsel = (lane == j) ? gt8[j] : gsel;
            gsel += gb[lane];
            const int b = r >> 11;
            if (lane < 4) LI[(size_t)(b * 4 + lane) * 2048 + l] = gsel;
            else { const float ax = fabsf(gsel); const float ls = fminf(gsel, 0.f) - log1pf(expf(-ax)); LF[(size_t)(b * 4 + lane - 4) * 2048 + l] = ls; }
        }
    }
}

DEVI void transpose_tok(const Ctx& C, const bf16_t* src, bf16_t* dst, int mode) {
    LAS unsigned* T = (LAS unsigned*)C.lds;
    LAS bf16_t* Ts = (LAS bf16_t*)C.lds;
    const int tid = C.tid;
    for (int tile = C.bid; tile < (NT / 64) * 8; tile += C.G) {
        const int tt = tile >> 3, cblk = tile & 7, tok0 = tt * 64, ch0 = cblk * 64;
        __syncthreads();
        { const int r = tid >> 3, cc = (tid & 7) * 8;
          const u32x4 q = *(const u32x4*)(src + (size_t)(tok0 + r) * 512 + ch0 + cc);
          const unsigned wv[4] = {q.x, q.y, q.z, q.w};
#pragma unroll
          for (int j = 0; j < 4; ++j) { Ts[(cc + 2 * j) * 66 + r] = (bf16_t)(wv[j] & 0xffffu); Ts[(cc + 2 * j + 1) * 66 + r] = (bf16_t)(wv[j] >> 16); } }
        __syncthreads();
        { const int c = tid >> 3, tc = (tid & 7) * 8;
          const int ch = ch0 + c, b = tok0 >> 11, l0 = (tok0 & 2047) + tc;
          if (mode == 0) {
              u32x4 w; w.x = T[c * 33 + (tc >> 1)]; w.y = T[c * 33 + (tc >> 1) + 1]; w.z = T[c * 33 + (tc >> 1) + 2]; w.w = T[c * 33 + (tc >> 1) + 3];
              const int h = ch >> 7, dv = ch & 127;
              *(u32x4*)(dst + ((size_t)((b * 4 + h) * 128 + dv)) * 2048 + l0) = w;
          } else {
              const int h = ch >> 6, dv = ch & 63;
#pragma unroll
              for (int j = 0; j < 8; ++j) { const int l = l0 + j; dst[((size_t)(((b * 8 + h) * 64 + dv) * 16 + (l & 15))) * 128 + (l >> 4)] = Ts[c * 66 + tc + j]; }
          } }
    }
}

DEVI void phase_mid0(const Ctx& C) {
    transpose_tok(C, WSP(const bf16_t, WS_VTMP), WSP(bf16_t, WS_VT0), 0);
    const int gw = C.bid * 8 + C.wid, lane = C.lane;
    if (gw < 64) {
        const float* LF = WSP(const float, WS_LF) + (size_t)gw * 2048; const float* LI = WSP(const float, WS_LI) + (size_t)gw * 2048;
        float* BC = WSP(float, WS_BC) + (size_t)gw * 2048; float* DS = WSP(float, WS_DS) + (size_t)gw * 2048;
        float tot = 0.f;
        for (int j = 0; j < 32; ++j) tot += LF[lane * 32 + j];
        float inc = tot;
#pragma unroll
        for (int d = 1; d < 64; d <<= 1) { const float o = __shfl_up(inc, d); if (lane >= d) inc += o; }
        float run = inc - tot;
        for (int j = 0; j < 32; ++j) { run += LF[lane * 32 + j]; BC[lane * 32 + j] = run; DS[lane * 32 + j] = LI[lane * 32 + j] - run; }
    }
    {
        const float* XLOC = WSP(const float, WS_XLOC); bf16_t* XST = WSP(bf16_t, WS_XST); const f32x2* A32 = WSP(const f32x2, WS_A32);
        for (int e = C.bid * 512 + C.tid; e < 32 * 16 * 64; e += C.G * 512) {
            const int p = e & 63, gb = e >> 6, g = gb >> 4;
            const f32x2 a = A32[g * 64 + p]; float xr = 0.f, xi = 0.f;
            for (int i = 0; i < 64; ++i) {
                const size_t n = (size_t)gb * 64 + i;
                *(unsigned*)(XST + n * 256 + 2 * p) = cvt_pk_bf16(xr, xi);
                *(unsigned*)(XST + n * 256 + 128 + 2 * p) = 0u;
                const f32x2 lc = *(const f32x2*)(XLOC + n * 128 + 2 * p);
                const float nr = a.x * xr - a.y * xi + lc.x, ni = a.x * xi + a.y * xr + lc.y; xr = nr; xi = ni;
            }
        }
    }
}
constexpr float NEG_INF = -__builtin_inff();

template <int NDT>
DEVI void osm_update(float (&s)[8], float& m, float& l, f32x4 (&o)[NDT], bf16x8& pf) {
    float mx = fmaxf(fmaxf(fmaxf(s[0], s[1]), fmaxf(s[2], s[3])), fmaxf(fmaxf(s[4], s[5]), fmaxf(s[6], s[7])));
    mx = fmaxf(mx, __shfl_xor(mx, 16)); mx = fmaxf(mx, __shfl_xor(mx, 32));
    const float mn = fmaxf(m, mx);
    const float mref = (mn == NEG_INF) ? 0.f : mn;
    const float alpha = fast_exp2(m - mref);
    float p[8]; float ps = 0.f;
#pragma unroll
    for (int i = 0; i < 8; ++i) { p[i] = fast_exp2(s[i] - mref); ps += p[i]; }
    l = l * alpha + ps; m = mn;
#pragma unroll
    for (int d = 0; d < NDT; ++d) o[d] *= alpha;
    u32x4 w; w.x = cvt_pk_bf16(p[0], p[1]); w.y = cvt_pk_bf16(p[2], p[3]); w.z = cvt_pk_bf16(p[4], p[5]); w.w = cvt_pk_bf16(p[6], p[7]);
    pf = __builtin_bit_cast(bf16x8, w);
}

DEVI bf16x8 ld_vt(const bf16_t* lo, const bf16_t* hi) {
    const u32x2 a = *(const u32x2*)lo, b = *(const u32x2*)hi; u32x4 w; w.x = a.x; w.y = a.y; w.z = b.x; w.w = b.y; return __builtin_bit_cast(bf16x8, w);
}

DEVI void phase_mlstm(const Ctx& C) {
    const bf16_t* QK = WSP(const bf16_t, WS_QK); const bf16_t* VT = WSP(const bf16_t, WS_VT0);
    const float* BC = WSP(const float, WS_BC); const float* DS = WSP(const float, WS_DS);
    const bf16_t* XC = WSP(const bf16_t, WS_XC); const bf16_t* PZ = WSP(const bf16_t, WS_PZ);
    bf16_t* AB = WSP(bf16_t, WS_AB);
    const float* ng = C.in[21]; const float* sk = C.in[22];
    const int lane = C.lane, r = lane & 15, g4 = lane >> 4;
    const int gw = C.bid * 8 + C.wid, nw = C.G * 8;
    for (int task = gw; task < 64 * 128; task += nw) {
        const int seq = task & 63, x = (task >> 6) & 31, q = task >> 11;
        const int rt = (q == 0) ? 127 - x : (q == 1) ? x : (q == 2) ? 95 - x : 32 + x;
        const int b = seq >> 2, h = seq & 3;
        const int t = 16 * rt + r; const size_t row = (size_t)b * 2048 + t;
        bf16x8 qf[4];
#pragma unroll
        for (int ks = 0; ks < 4; ++ks) qf[ks] = *(const bf16x8*)(QK + row * 1024 + h * 128 + 32 * ks + 8 * g4);
        const bf16_t* Kb = QK + (size_t)b * 2048 * 1024 + 512 + h * 128 + 8 * g4;
        const bf16_t* Vb = VT + ((size_t)(seq * 128 + r)) * 2048 + 4 * g4;
        const float* BCs = BC + (size_t)seq * 2048; const float* DSs = DS + (size_t)seq * 2048;
        const float bct = BCs[t];
        f32x4 o[8];
#pragma unroll
        for (int d = 0; d < 8; ++d) o[d] = (f32x4){0.f, 0.f, 0.f, 0.f};
        float dsum = 0.f;
        const int nseg = rt / 2 + 1;
        for (int sg = 0; sg < nseg; ++sg) {
            const int s0 = 32 * sg;
            f32x4 st[2];
#pragma unroll
            for (int kt = 0; kt < 2; ++kt) { st[kt] = (f32x4){0.f, 0.f, 0.f, 0.f}; const bf16_t* kp = Kb + (size_t)(s0 + 16 * kt + r) * 1024;
#pragma unroll
                for (int ks = 0; ks < 4; ++ks) st[kt] = mfma16(*(const bf16x8*)(kp + 32 * ks), qf[ks], st[kt]); }
            const float bref = BCs[s0];
            const float rowf = fast_exp2((bct - bref) * LOG2E);
            const f32x4 d0 = *(const f32x4*)(DSs + s0 + 4 * g4), d1 = *(const f32x4*)(DSs + s0 + 16 + 4 * g4);
            float p[8];
#pragma unroll
            for (int j = 0; j < 4; ++j) {
                const int k0 = s0 + 4 * g4 + j, k1 = k0 + 16;
                const float c0 = fast_exp2((bref + d0[j]) * LOG2E), c1 = fast_exp2((bref + d1[j]) * LOG2E);
                p[j] = (k0 <= t) ? st[0][j] * rowf * c0 : 0.f; p[4 + j] = (k1 <= t) ? st[1][j] * rowf * c1 : 0.f;
            }
            dsum += (p[0] + p[1]) + (p[2] + p[3]) + (p[4] + p[5]) + (p[6] + p[7]);
            u32x4 w; w.x = cvt_pk_bf16(p[0], p[1]); w.y = cvt_pk_bf16(p[2], p[3]); w.z = cvt_pk_bf16(p[4], p[5]); w.w = cvt_pk_bf16(p[6], p[7]);
            const bf16x8 pf = __builtin_bit_cast(bf16x8, w);
#pragma unroll
            for (int d = 0; d < 8; ++d) { const bf16_t* vp = Vb + (size_t)(16 * d) * 2048 + s0; o[d] = mfma16(ld_vt(vp, vp + 16), pf, o[d]); }
        }
        dsum += __shfl_xor(dsum, 16); dsum += __shfl_xor(dsum, 32);
        const float rden = 1.0f / fmaxf(fabsf(dsum), 1.0f);
        float su = 0.f;
#pragma unroll
        for (int d = 0; d < 8; ++d) { o[d] *= rden; su += (o[d][0] + o[d][1]) + (o[d][2] + o[d][3]); }
        su += __shfl_xor(su, 16); su += __shfl_xor(su, 32);
        const float mu = su * (1.0f / 128.0f);
        float sv = 0.f;
#pragma unroll
        for (int d = 0; d < 8; ++d) { const f32x4 dd = o[d] - mu; sv += (dd[0] * dd[0] + dd[1] * dd[1]) + (dd[2] * dd[2] + dd[3] * dd[3]); }
        sv += __shfl_xor(sv, 16); sv += __shfl_xor(sv, 32);
        const float rstd = rsqrtf(sv * (1.0f / 128.0f) + 1e-5f);
#pragma unroll
        for (int d = 0; d < 8; ++d) {
            const int ch = h * 128 + 16 * d + 4 * g4;
            const f32x4 gg = *(const f32x4*)(ng + ch), ss = *(const f32x4*)(sk + ch);
            const u32x2 xc = *(const u32x2*)(XC + row * 512 + ch), zz = *(const u32x2*)(PZ + row * 1536 + 1024 + ch);
            const float xcv[4] = {bflo(xc.x), bfhi(xc.x), bflo(xc.y), bfhi(xc.y)}, zv[4] = {bflo(zz.x), bfhi(zz.x), bflo(zz.y), bfhi(zz.y)};
            float y[4];
#pragma unroll
            for (int j = 0; j < 4; ++j) y[j] = ((o[d][j] - mu) * rstd * gg[j] + ss[j] * xcv[j]) * silu_f(zv[j]);
            u32x2 w; w.x = cvt_pk_bf16(y[0], y[1]); w.y = cvt_pk_bf16(y[2], y[3]);
            *(u32x2*)(AB + row * 1024 + 512 + ch) = w;
        }
    }
}

DEVI void phase_diff(const Ctx& C) {
    const bf16_t* DQ = WSP(const bf16_t, WS_DQ); const bf16_t* DK = WSP(const bf16_t, WS_DK); const bf16_t* VT = WSP(const bf16_t, WS_DVT);
    const bf16_t* DZ = WSP(const bf16_t, WS_DZ); bf16_t* CD = WSP(bf16_t, WS_CD);
    const float* dn = C.in[29];
    const float lam = WSP(const float, WS_LAM)[0];
    const float lam_init = 0.8f - 0.6f * 0.7408182206817179f;
    const int lane = C.lane, r = lane & 15, g4 = lane >> 4;
    const int gw = C.bid * 8 + C.wid, nw = C.G * 8;
    const float sc = 0.125f * LOG2E;
    for (int task = gw; task < 64 * 128; task += nw) {
        const int seq = task & 63, x = (task >> 6) & 31, q = task >> 11;
        const int rt = (q == 0) ? 127 - x : (q == 1) ? x : (q == 2) ? 95 - x : 32 + x;
        const int b = seq >> 2, h = seq & 3;
        const int t = 16 * rt + r; const size_t row = (size_t)b * 2048 + t;
        const bf16_t* Vb = VT + ((size_t)(seq * 128 + r)) * 2048 + 4 * g4;
        const int nseg = rt / 2 + 1;
        f32x4 res[8];
#pragma unroll
        for (int comp = 0; comp < 2; ++comp) {
            const size_t hb = ((size_t)(b * 8 + 2 * h + comp)) * 2048;
            bf16x8 qf[2];
#pragma unroll
            for (int ks = 0; ks < 2; ++ks) qf[ks] = *(const bf16x8*)(DQ + (hb + t) * 64 + 32 * ks + 8 * g4);
            const bf16_t* Kb = DK + hb * 64 + 8 * g4;
            f32x4 o[8];
#pragma unroll
            for (int d = 0; d < 8; ++d) o[d] = (f32x4){0.f, 0.f, 0.f, 0.f};
            float m = NEG_INF, l = 0.f;
            for (int sg = 0; sg < nseg; ++sg) {
                const int s0 = 32 * sg;
                f32x4 st[2];
#pragma unroll
                for (int kt = 0; kt < 2; ++kt) { st[kt] = (f32x4){0.f, 0.f, 0.f, 0.f}; const bf16_t* kp = Kb + (size_t)(s0 + 16 * kt + r) * 64;
#pragma unroll
                    for (int ks = 0; ks < 2; ++ks) st[kt] = mfma16(*(const bf16x8*)(kp + 32 * ks), qf[ks], st[kt]); }
                float s[8];
#pragma unroll
                for (int j = 0; j < 4; ++j) { const int k0 = s0 + 4 * g4 + j, k1 = k0 + 16; s[j] = (k0 <= t) ? st[0][j] * sc : NEG_INF; s[4 + j] = (k1 <= t) ? st[1][j] * sc : NEG_INF; }
                bf16x8 pf; osm_update<8>(s, m, l, o, pf);
#pragma unroll
                for (int d = 0; d < 8; ++d) { const bf16_t* vp = Vb + (size_t)(16 * d) * 2048 + s0; o[d] = mfma16(ld_vt(vp, vp + 16), pf, o[d]); }
            }
            l += __shfl_xor(l, 16); l += __shfl_xor(l, 32);
            const float rl = 1.0f / l;
            if (comp == 0) {
#pragma unroll
                for (int d = 0; d < 8; ++d) res[d] = o[d] * rl;
            } else {
#pragma unroll
                for (int d = 0; d < 8; ++d) res[d] -= o[d] * (rl * lam);
            }
        }
        float ss = 0.f;
#pragma unroll
        for (int d = 0; d < 8; ++d) ss += (res[d][0] * res[d][0] + res[d][1] * res[d][1]) + (res[d][2] * res[d][2] + res[d][3] * res[d][3]);
        ss += __shfl_xor(ss, 16); ss += __shfl_xor(ss, 32);
        const float rn = rsqrtf(ss * (1.0f / 128.0f) + 1e-5f) * (1.0f - lam_init);
#pragma unroll
        for (int d = 0; d < 8; ++d) {
            const int dv = 16 * d + 4 * g4, ch = h * 128 + dv;
            const f32x4 gg = *(const f32x4*)(dn + dv);
            const u32x2 zz = *(const u32x2*)(DZ + row * 512 + ch);
            const float zv[4] = {bflo(zz.x), bfhi(zz.x), bflo(zz.y), bfhi(zz.y)};
            float y[4];
#pragma unroll
            for (int j = 0; j < 4; ++j) y[j] = res[d][j] * rn * gg[j] * silu_f(zv[j]);
            u32x2 w; w.x = cvt_pk_bf16(y[0], y[1]); w.y = cvt_pk_bf16(y[2], y[3]);
            *(u32x2*)(CD + row * 1024 + 512 + ch) = w;
        }
    }
}

DEVI void dil_seg(const bf16_t* Kc  , const bf16_t* Vc  , int cc, int is0, int W, int tq, int r, int g4, float sc,
                  const bf16x8 (&qf)[2], f32x4 (&o)[4], float& m, float& l) {
    f32x4 st[2];
#pragma unroll
    for (int kt = 0; kt < 2; ++kt) { int ik = is0 + 16 * kt + r; ik = ik < 0 ? 0 : ik; st[kt] = (f32x4){0.f, 0.f, 0.f, 0.f}; const bf16_t* kp = Kc + (size_t)ik * 64;
#pragma unroll
        for (int ks = 0; ks < 2; ++ks) st[kt] = mfma16(*(const bf16x8*)(kp + 32 * ks), qf[ks], st[kt]); }
    float s[8];
#pragma unroll
    for (int j = 0; j < 4; ++j) {
        const int i0 = is0 + 4 * g4 + j, i1 = i0 + 16;
        const int d0 = tq - (16 * i0 + cc), d1 = tq - (16 * i1 + cc);
        s[j] = (i0 >= 0 && d0 >= 0 && d0 <= W) ? st[0][j] * sc : NEG_INF;
        s[4 + j] = (i1 >= 0 && d1 >= 0 && d1 <= W) ? st[1][j] * sc : NEG_INF;
    }
    bf16x8 pf; osm_update<4>(s, m, l, o, pf);
    int ilo = is0 + 4 * g4, ihi = ilo + 16; ilo = ilo < 0 ? 0 : ilo; ihi = ihi < 0 ? 0 : ihi;
#pragma unroll
    for (int d = 0; d < 4; ++d) { const bf16_t* vb = Vc + (size_t)(16 * d + r) * 2048; o[d] = mfma16(ld_vt(vb + ilo, vb + ihi), pf, o[d]); }
}

DEVI void phase_dilated(const Ctx& C) {
    const bf16_t* CQ = WSP(const bf16_t, WS_CQ); const bf16_t* CK = WSP(const bf16_t, WS_CK); const bf16_t* CVT = WSP(const bf16_t, WS_CVT);
    const bf16_t* CZ = WSP(const bf16_t, WS_CZ); bf16_t* CD = WSP(bf16_t, WS_CD);
    const int lane = C.lane, r = lane & 15, g4 = lane >> 4;
    const int gw = C.bid * 8 + C.wid, nw = C.G * 8;
    const float sc = 0.125f * LOG2E;
    for (int task = gw; task < 16 * 8 * 16 * 8; task += nw) {
        const int it = task & 7, c = (task >> 3) & 15, h = (task >> 7) & 7, b = task >> 10;
        const size_t bh = (size_t)(b * 8 + h);
        const int iq = 16 * it + r, tq = 16 * iq + c;
        bf16x8 qf[2];
#pragma unroll
        for (int ks = 0; ks < 2; ++ks) qf[ks] = *(const bf16x8*)(CQ + ((bh * 16 + c) * 128 + iq) * 64 + 32 * ks + 8 * g4);
        const bf16_t* Kbh = CK + bh * 16 * 128 * 64 + 8 * g4;
        const bf16_t* Vbh = CVT + bh * 64 * 2048;
        f32x4 o[4];
#pragma unroll
        for (int d = 0; d < 4; ++d) o[d] = (f32x4){0.f, 0.f, 0.f, 0.f};
        float m = NEG_INF, l = 0.f;
        for (int cc = 0; cc < 16; ++cc) dil_seg(Kbh + (size_t)cc * 128 * 64, Vbh + cc * 128, cc, 16 * it - 16, 128, tq, r, g4, sc, qf, o, m, l);
        for (int k = 0; k < 4; ++k) { const int cc = (c & 3) + 4 * k;
            if (it > 0) dil_seg(Kbh + (size_t)cc * 128 * 64, Vbh + cc * 128, cc, 16 * it - 48, 512, tq, r, g4, sc, qf, o, m, l);
            dil_seg(Kbh + (size_t)cc * 128 * 64, Vbh + cc * 128, cc, 16 * it - 16, 512, tq, r, g4, sc, qf, o, m, l); }
        for (int is0 = 0; is0 <= 16 * it + 15; is0 += 32) dil_seg(Kbh + (size_t)c * 128 * 64, Vbh + c * 128, c, is0, 4096, tq, r, g4, sc, qf, o, m, l);
        l += __shfl_xor(l, 16); l += __shfl_xor(l, 32);
        const float rl = 1.0f / l;
        const size_t row = (size_t)b * 2048 + tq;
#pragma unroll
        for (int d = 0; d < 4; ++d) {
            const int ch = h * 64 + 16 * d + 4 * g4;
            const u32x2 zz = *(const u32x2*)(CZ + row * 512 + ch);
            const float zv[4] = {bflo(zz.x), bfhi(zz.x), bflo(zz.y), bfhi(zz.y)};
            float y[4];
#pragma unroll
            for (int j = 0; j < 4; ++j) y[j] = o[d][j] * rl * silu_f(zv[j]);
            u32x2 w; w.x = cvt_pk_bf16(y[0], y[1]); w.y = cvt_pk_bf16(y[2], y[3]);
            *(u32x2*)(CD + row * 1024 + ch) = w;
        }
    }
}
constexpr int N_STEPS = 17;
constexpr int LDS_BYTES = pg8::STAGE_BYTES + 256;

template <int MODE>
DEVI void run_gemm(const Ctx& C, const EpiMulti<MODE>& E, const bf16_t* A, int lda, const bf16_t* Bt, int ldb, int N, int K, int grp_shift, size_t grp_bbytes) {
    pg8::Gemm g; g.A = A; g.Bt = Bt; g.M = NT; g.N = N; g.K = K; g.lda = lda; g.ldb = ldb; g.grp_shift = grp_shift; g.grp_bbytes = grp_bbytes;
    pg8::StaticOrder S; S.init(NT, N, C.G, C.bid);
    pg8::gemm_phase<EpiMulti<MODE>>(C.lds, g, S, E);
}
template <int MODE> DEVI EpiMulti<MODE> mk_epi(const Ctx& C) { EpiMulti<MODE> E; E.ldc = 0; E.o0 = nullptr; E.o1 = nullptr; E.f0 = nullptr; E.i0 = nullptr; E.i1 = nullptr; E.c0 = nullptr; E.c1 = nullptr; E.ws = C.ws; return E; }

__global__ void __launch_bounds__(512, 2) mega_fwd(Params P) {
    extern __shared__ __attribute__((aligned(16))) unsigned char lds_raw[];
    Ctx C;
    C.in = P.in;
    C.out = P.out; C.ws = P.ws; C.lds = (LAS unsigned char*)lds_raw;
    C.tid = threadIdx.x; C.lane = C.tid & 63; C.wid = __builtin_amdgcn_readfirstlane(C.tid >> 6); C.G = gridDim.x; C.bid = blockIdx.x;
    volatile LAS unsigned* bst = (volatile LAS unsigned*)(C.lds + pg8::STAGE_BYTES);
    if (C.tid < 4) bst[C.tid] = 0u;
    __syncthreads();
    XcdBarrier bar = xcd_barrier_post((unsigned*)(C.ws + WS_CTL), bst);
#ifdef ONLY_PHASE
#define ON(k) ((k) == ONLY_PHASE)
#else
#define ON(k) (P.ph_lo <= (k) && (k) < P.ph_hi)
#endif
#define BAR(k) do { if (ON(k) && (k) + 1 < P.ph_hi) xcd_barrier(bar); } while (0)
    if (ON(0)) phase_prologue(C);
    BAR(0);
    if (ON(1)) { auto E = mk_epi<EM_IN0>(C); E.o0 = WSP(bf16_t, WS_PZ); E.o1 = WSP(bf16_t, WS_U5);
        run_gemm(C, E, WSP(const bf16_t, WS_XN), 1024, WSP(const bf16_t, WS_WIN0), 1024, 2048, 1024, 0, 0); }
    BAR(1);
    if (ON(2)) phase_conv_gates(C);
    BAR(2);
    if (ON(3)) { auto E = mk_epi<EM_PLAIN>(C); E.o0 = WSP(bf16_t, WS_QK); E.ldc = 1024;
        run_gemm(C, E, WSP(const bf16_t, WS_XC), 512, WSP(const bf16_t, WS_WQK), 512, 1024, 512, 0, 0); }
    if (ON(4)) { auto E = mk_epi<EM_PLAIN>(C); E.o0 = WSP(bf16_t, WS_VTMP); E.ldc = 512;
        run_gemm(C, E, WSP(const bf16_t, WS_PZ) + 512, 1536, WSP(const bf16_t, WS_WV), 512, 512, 512, 0, 0); }
    if (ON(5)) { auto E = mk_epi<EM_S5A>(C); E.o0 = WSP(bf16_t, WS_YLOC); E.f0 = WSP(float, WS_XLOC);
        run_gemm(C, E, WSP(const bf16_t, WS_U5), 512, WSP(const bf16_t, WS_BT5A), 512, 768, 512, 2, (size_t)768 * 512 * 2); }
    BAR(5);
    if (ON(6)) phase_mid0(C);
    BAR(6);
    if (ON(7)) phase_mlstm(C);
    if (ON(8)) { auto E = mk_epi<EM_S5B>(C); E.o0 = WSP(bf16_t, WS_G5); E.i0 = WSP(const bf16_t, WS_YLOC); E.i1 = WSP(const bf16_t, WS_U5); E.c0 = C.in[11];
        run_gemm(C, E, WSP(const bf16_t, WS_XST), 256, WSP(const bf16_t, WS_BT5B), 256, 512, 256, 2, (size_t)512 * 256 * 2); }
    BAR(8);
    if (ON(9)) { auto E = mk_epi<EM_GLU>(C); E.o0 = WSP(bf16_t, WS_AB); E.i0 = WSP(const bf16_t, WS_G5); E.i1 = WSP(const bf16_t, WS_PZ); E.c0 = C.in[13];
        run_gemm(C, E, WSP(const bf16_t, WS_G5), 512, WSP(const bf16_t, WS_GLU), 512, 512, 512, 0, 0); }
    BAR(9);
    if (ON(10)) { auto E = mk_epi<EM_OUT>(C); E.o0 = WSP(bf16_t, WS_Y0); E.f0 = WSP(float, WS_SS0);
        run_gemm(C, E, WSP(const bf16_t, WS_AB), 1024, WSP(const bf16_t, WS_WOUT0), 1024, 1024, 1024, 0, 0); }
    BAR(10);
    if (ON(11)) rows_pass(C, 1);
    BAR(11);
    if (ON(12)) { auto E = mk_epi<EM_IN1>(C); E.c0 = WSP(const float, WS_ROPE_C); E.c1 = WSP(const float, WS_ROPE_S);
        run_gemm(C, E, WSP(const bf16_t, WS_XN1), 1024, WSP(const bf16_t, WS_WIN1), 1024, 4096, 1024, 0, 0); }
    BAR(12);
    if (ON(13)) { transpose_tok(C, WSP(const bf16_t, WS_CVTMP), WSP(bf16_t, WS_CVT), 1); transpose_tok(C, WSP(const bf16_t, WS_DVTMP), WSP(bf16_t, WS_DVT), 0); }
    BAR(13);
    if (ON(14)) { phase_diff(C); phase_dilated(C); }
    BAR(14);
    if (ON(15)) { auto E = mk_epi<EM_OUT>(C); E.o0 = WSP(bf16_t, WS_Y1); E.f0 = WSP(float, WS_SS1);
        run_gemm(C, E, WSP(const bf16_t, WS_CD), 1024, WSP(const bf16_t, WS_WOUT1), 1024, 1024, 1024, 0, 0); }
    BAR(15);
    if (ON(16)) rows_pass(C, 2);
#undef ON
#undef BAR
}

#ifndef MK_SPLIT
#define MK_SPLIT 1
#endif
extern "C" void kernel_launch(void* const* d_in, const int* in_sizes, int n_in, void* d_out, int out_size, void* d_ws, size_t ws_size, hipStream_t stream) {
    static int grid = 0;
    if (grid == 0) {
        int dev = 0, cus = 0, per_cu = 0;
        (void)hipGetDevice(&dev);
        (void)hipDeviceGetAttribute(&cus, hipDeviceAttributeMultiprocessorCount, dev);
        (void)hipFuncSetAttribute((const void*)mega_fwd, hipFuncAttributeMaxDynamicSharedMemorySize, LDS_BYTES);
        (void)hipOccupancyMaxActiveBlocksPerMultiprocessor(&per_cu, (const void*)mega_fwd, 512, LDS_BYTES);
        if (per_cu < 1) per_cu = 1;
        if (per_cu > 1) per_cu = 1;
        grid = cus * per_cu;
        if (n_in != 31 || ws_size < WS_END) { fprintf(stderr, "kernel_launch: unexpected n_in %d or ws_size %zu (< %zu)\n", n_in, ws_size, (size_t)WS_END); }
        (void)hipGetLastError();
    }
    (void)hipMemsetAsync((char*)d_ws + WS_CTL, 0, 16384, stream);
    Params p{};
    for (int i = 0; i < 31; ++i) p.in[i] = (const float*)d_in[i];
    p.out = (float*)d_out; p.ws = (unsigned char*)d_ws;
#if MK_SPLIT
    for (int st = 0; st < N_STEPS; ++st) {
        p.ph_lo = st; p.ph_hi = st + 1;
        hipLaunchKernelGGL(mega_fwd, dim3(grid), dim3(512), LDS_BYTES, stream, p);
    }
#else
    p.ph_lo = 0; p.ph_hi = N_STEPS;
    void* args[] = {&p};
    hipError_t e = hipLaunchCooperativeKernel((const void*)mega_fwd, dim3(grid), dim3(512), args, LDS_BYTES, stream);
    if (e != hipSuccess) fprintf(stderr, "cooperative launch failed: %s (grid %d)\n", hipGetErrorString(e), grid);
#endif
}
```

```cpp
#include <hip/hip_runtime.h>
#include <stdint.h>
#include <stdio.h>

typedef unsigned short bf16_t;
typedef short bf16x8 __attribute__((ext_vector_type(8)));
typedef short bf16x4 __attribute__((ext_vector_type(4)));
typedef float f32x4 __attribute__((ext_vector_type(4)));
typedef float f32x2 __attribute__((ext_vector_type(2)));
typedef unsigned u32x4 __attribute__((ext_vector_type(4)));
typedef unsigned u32x2 __attribute__((ext_vector_type(2)));
#define LAS __attribute__((address_space(3)))
#define DEVI __device__ __forceinline__

constexpr int NB = 16, SEQ = 2048, DM = 1024, NT = NB * SEQ;
constexpr float LOG2E = 1.4426950408889634f;
constexpr size_t MiB = 1024ull * 1024ull;

constexpr size_t WS_CTL = 0;
constexpr size_t WS_LAM = 64 * 1024;
constexpr size_t WS_ROPE_C = 128 * 1024;
constexpr size_t WS_ROPE_S = 384 * 1024;
constexpr size_t WS_GF = 640 * 1024;
constexpr size_t WS_A32 = 704 * 1024;
constexpr size_t WS_WIN0 = 1 * MiB;
constexpr size_t WS_WOUT0 = 5 * MiB;
constexpr size_t WS_WIN1 = 7 * MiB;
constexpr size_t WS_WOUT1 = 15 * MiB;
constexpr size_t WS_GLU = 17 * MiB;
constexpr size_t WS_WQK = 17 * MiB + 512 * 1024;
constexpr size_t WS_WV = 18 * MiB + 512 * 1024;
constexpr size_t WS_BT5A = 19 * MiB;
constexpr size_t WS_BT5B = 43 * MiB;
constexpr size_t WS_R1 = 52 * MiB;
constexpr size_t WS_R2 = 116 * MiB;
constexpr size_t WS_R3 = 372 * MiB;
constexpr size_t WS_R4 = 436 * MiB;
constexpr size_t WS_R5 = 500 * MiB;
constexpr size_t WS_END = 506 * MiB;
constexpr size_t WS_PZ = WS_R2;
constexpr size_t WS_U5 = WS_R2 + 96 * MiB;
constexpr size_t WS_XC = WS_R2 + 128 * MiB;
constexpr size_t WS_VTMP = WS_R2 + 160 * MiB;
constexpr size_t WS_VT0 = WS_R2 + 192 * MiB;
constexpr size_t WS_YLOC = WS_R2 + 224 * MiB;
constexpr size_t WS_CQ = WS_R2;
constexpr size_t WS_CK = WS_R2 + 32 * MiB;
constexpr size_t WS_CVTMP = WS_R2 + 64 * MiB;
constexpr size_t WS_CZ = WS_R2 + 96 * MiB;
constexpr size_t WS_DQ = WS_R2 + 128 * MiB;
constexpr size_t WS_DK = WS_R2 + 160 * MiB;
constexpr size_t WS_DVTMP = WS_R2 + 192 * MiB;
constexpr size_t WS_DZ = WS_R2 + 224 * MiB;
constexpr size_t WS_Y1 = WS_R2;
constexpr size_t WS_XN = WS_R1;
constexpr size_t WS_QK = WS_R1;
constexpr size_t WS_Y0 = WS_R1;
constexpr size_t WS_AB = WS_R3;
constexpr size_t WS_XN1 = WS_R3;
constexpr size_t WS_CD = WS_R3;
constexpr size_t WS_XLOC = WS_R4;
constexpr size_t WS_XST = WS_R4 + 16 * MiB;
constexpr size_t WS_G5 = WS_R4 + 32 * MiB;
constexpr size_t WS_CVT = WS_R4;
constexpr size_t WS_DVT = WS_R4 + 32 * MiB;
constexpr size_t WS_LI = WS_R5;
constexpr size_t WS_LF = WS_R5 + 512 * 1024;
constexpr size_t WS_BC = WS_R5 + 1024 * 1024;
constexpr size_t WS_DS = WS_R5 + 1536 * 1024;
constexpr size_t WS_SS0 = WS_R5 + 2 * MiB;
constexpr size_t WS_SS1 = WS_R5 + 4 * MiB;

DEVI unsigned cvt_pk_bf16(float lo, float hi) { unsigned r; asm("v_cvt_pk_bf16_f32 %0, %1, %2" : "=v"(r) : "v"(lo), "v"(hi)); return r; }
DEVI float bf2f(unsigned v16) { return __uint_as_float(v16 << 16); }
DEVI float bflo(unsigned w) { return __uint_as_float(w << 16); }
DEVI float bfhi(unsigned w) { return __uint_as_float(w & 0xffff0000u); }
DEVI bf16_t f2bf(float f) { return (bf16_t)(cvt_pk_bf16(f, 0.f) & 0xffffu); }
DEVI float wave_sum(float v) { v += __shfl_xor(v, 32); v += __shfl_xor(v, 16); v += __shfl_xor(v, 8); v += __shfl_xor(v, 4); v += __shfl_xor(v, 2); v += __shfl_xor(v, 1); return v; }
DEVI float fast_exp2(float x) { return __builtin_amdgcn_exp2f(x); }
DEVI float silu_f(float x) { return x / (1.0f + __expf(-x)); }
DEVI float sigmoid_f(float x) { return 1.0f / (1.0f + __expf(-x)); }
DEVI float gelu_tanh_f(float x) { const float u = 0.7978845608028654f * (x + 0.044715f * x * x * x); const float e = __expf(2.0f * u); const float th = 1.0f - 2.0f / (e + 1.0f); return 0.5f * x * (1.0f + th); }
DEVI f32x4 mfma16(bf16x8 a, bf16x8 b, f32x4 c) { return __builtin_amdgcn_mfma_f32_16x16x32_bf16(a, b, c, 0, 0, 0); }
namespace pg8 {
constexpr int BM = 256, BK = 64, HALF = 128, HTB = HALF * BK * 2  , STAGE_BYTES = 8 * HTB, NXCD = 8, WGM = 8;

__host__ __device__ __forceinline__ int lds_byte(int r, int c) { const int st = (r >> 4) * 2 + (c >> 5), rr = r & 15, cc = c & 31, ob = rr * 64 + cc * 2; return st * 1024 + (ob ^ (((ob >> 9) & 1) << 5)); }
__host__ __device__ __forceinline__ void stage_rc(int b, int& R, int& C) { const int st = b / 1024, sb = b % 1024, swz = sb ^ (((sb >> 9) & 1) << 5); R = (st >> 1) * 16 + swz / 64; C = (st & 1) * 32 + (swz % 64) / 2; }
__host__ __device__ __forceinline__ int perm32(int rho) { const int n = rho >> 4, i = rho & 15; return 8 * (i >> 2) + 4 * n + (i & 3); }

struct Unit { int pm, pn; };
struct Gemm { const bf16_t* A; const bf16_t* Bt; int M, N, K, lda, ldb, grp_shift; size_t grp_bbytes; };

struct StaticOrder {
    int nM, nN, nwg, G, c;
    __host__ __device__ void init(int M, int N, int G_, int c_) { nM = M / BM; nN = N / BM; nwg = nM * nN; G = G_; c = c_; }
    __host__ __device__ bool next(int i, Unit& u) const {
        const long L = (long)i * G + c; if (L >= nwg) return false;
        int wgid = (int)L; { const int q = nwg / NXCD, r = nwg % NXCD, xcd = wgid % NXCD, off = wgid / NXCD; wgid = (xcd < r ? xcd * (q + 1) : r * (q + 1) + (xcd - r) * q) + off; }
        const int nig = WGM * nN, gid = wgid / nig, fm = gid * WGM, gsz = (nM - fm) < WGM ? (nM - fm) : WGM;
        u.pm = fm + ((wgid % nig) % gsz); u.pn = (wgid % nig) / gsz; return true;
    }
};

template <class Epi>
__device__ __forceinline__ void gemm_phase(LAS unsigned char* lds, const Gemm g, const StaticOrder& S, const Epi& E) {
    const int tid = threadIdx.x, wid = __builtin_amdgcn_readfirstlane(tid >> 6), lane = tid & 63, wr = wid >> 2, wc = wid & 3, fr = lane & 15, fq = lane >> 4;
    int nt = g.K / BK; asm volatile("" : "+s"(nt));
    unsigned voffA[2], voffB[2];
#pragma unroll
    for (int i = 0; i < 2; ++i) { int R, C; stage_rc(tid * 16 + i * 8192, R, C); const int Rb = (R & ~31) + perm32(R & 31);
        voffA[i] = (unsigned)(R * g.lda + C) * 2u; voffB[i] = (unsigned)(Rb * g.ldb + C) * 2u; }
    const size_t kstep = (size_t)(BK * 2);
    const size_t hstepA = (size_t)HALF * g.lda * 2, hstepB = (size_t)HALF * g.ldb * 2;
    const size_t tstepA = 2 * hstepA, tstepB = 2 * hstepB;
    const unsigned ldsw = (unsigned)wid * 1024u;
    const int aoff = lds_byte(wr * 64 + fr, fq * 8), boff = lds_byte(wc * 32 + fr, fq * 8);
#define PG8_SA(b, h) (((b) * 2 + (h)) * HTB)
#define PG8_SB(b, h) ((4 + (b) * 2 + (h)) * HTB)
#define PG8_STAGE(bufoff, gbase, voff) do { _Pragma("unroll") for (int _i = 0; _i < 2; ++_i) \
        __builtin_amdgcn_global_load_lds((const unsigned*)((const char*)(gbase) + (voff)[_i]), (LAS unsigned*)(lds + (bufoff) + ldsw + _i * 8192), 16, 0, 0); } while (0)
#define PG8_LDA(dst, b, h) do { _Pragma("unroll") for (int m = 0; m < 4; ++m) _Pragma("unroll") for (int k = 0; k < 2; ++k) dst[m][k] = *(const LAS bf16x8*)(lds + PG8_SA(b, h) + aoff + m * 2048 + k * 1024); } while (0)
#define PG8_LDB(dst, b, h) do { _Pragma("unroll") for (int n = 0; n < 2; ++n) _Pragma("unroll") for (int k = 0; k < 2; ++k) dst[n][k] = *(const LAS bf16x8*)(lds + PG8_SB(b, h) + boff + n * 2048 + k * 1024); } while (0)
#define PG8_MMA(ai, bj, At, Bt) do { __builtin_amdgcn_s_setprio(1); _Pragma("unroll") for (int m = 0; m < 4; ++m) _Pragma("unroll") for (int n = 0; n < 2; ++n) _Pragma("unroll") for (int k = 0; k < 2; ++k) \
        acc[ai][bj][m][n] = __builtin_amdgcn_mfma_f32_16x16x32_bf16(Bt[n][k], At[m][k], acc[ai][bj][m][n], 0, 0, 0); __builtin_amdgcn_s_setprio(0); } while (0)
#define PG8_WAIT_V(n) asm volatile("s_waitcnt vmcnt(" #n ")" ::: "memory")
#define PG8_WAIT_L(n) asm volatile("s_waitcnt lgkmcnt(" #n ")" ::: "memory")
#define PG8_BAR __builtin_amdgcn_s_barrier()
#define PG8_SCHED __builtin_amdgcn_sched_barrier(0)
#define PG8_BBASE(u) ((const char*)g.Bt + (size_t)((u).pm >> g.grp_shift) * g.grp_bbytes + (size_t)(u).pn * tstepB)
    Unit cur, nxt; int ui = 0;
    if (!S.next(0, cur)) return;
    f32x4 acc[2][2][4][2];
#pragma unroll
    for (int a = 0; a < 2; ++a)
#pragma unroll
        for (int b = 0; b < 2; ++b)
#pragma unroll
            for (int m = 0; m < 4; ++m)
#pragma unroll
                for (int n = 0; n < 2; ++n) acc[a][b][m][n] = (f32x4){0.f, 0.f, 0.f, 0.f};
    bf16x8 At[4][2], B0[2][2], B1[2][2];
    const char* cA = (const char*)g.A + (size_t)cur.pm * tstepA; const char* cB = PG8_BBASE(cur);
    PG8_STAGE(PG8_SB(0, 0), cB, voffB); PG8_STAGE(PG8_SA(0, 0), cA, voffA); PG8_STAGE(PG8_SB(0, 1), cB + hstepB, voffB); PG8_STAGE(PG8_SA(0, 1), cA + hstepA, voffA);
    if (wr == 1) PG8_BAR;
    PG8_WAIT_V(4); PG8_BAR;
    PG8_STAGE(PG8_SB(1, 0), cB + kstep, voffB); PG8_STAGE(PG8_SA(1, 0), cA + kstep, voffA); PG8_STAGE(PG8_SB(1, 1), cB + hstepB + kstep, voffB);
    PG8_WAIT_V(6); PG8_BAR;
    for (;;) {
        const bool has_next = S.next(ui + 1, nxt);
        const char* nA = has_next ? (const char*)g.A + (size_t)nxt.pm * tstepA : cA; const char* nB = has_next ? PG8_BBASE(nxt) : cB;
        for (int t = 0; t < nt; t += 2) {
            const bool last = (t == nt - 2);
            const char* a1 = cA + (size_t)(t + 1) * kstep;
            const char* a2 = last ? nA : cA + (size_t)(t + 2) * kstep; const char* b2 = last ? nB : cB + (size_t)(t + 2) * kstep;
            const char* a3 = a2 + kstep; const char* b3 = b2 + kstep;
            PG8_LDB(B0, 0, 0); PG8_SCHED; PG8_LDA(At, 0, 0); PG8_STAGE(PG8_SA(1, 1), a1 + hstepA, voffA);
            PG8_WAIT_L(8); PG8_BAR; PG8_WAIT_L(0); PG8_MMA(0, 0, At, B0); PG8_BAR; PG8_SCHED;
            PG8_LDB(B1, 0, 1); PG8_STAGE(PG8_SB(0, 0), b2, voffB);
            PG8_BAR; PG8_WAIT_L(0); PG8_MMA(0, 1, At, B1); PG8_BAR;
            PG8_LDA(At, 0, 1); PG8_STAGE(PG8_SA(0, 0), a2, voffA);
            PG8_BAR; PG8_WAIT_L(0); PG8_MMA(1, 0, At, B0); PG8_BAR; PG8_SCHED;
            PG8_STAGE(PG8_SB(0, 1), b2 + hstepB, voffB);
            PG8_WAIT_V(6); PG8_BAR; PG8_MMA(1, 1, At, B1); PG8_BAR;
            PG8_LDB(B0, 1, 0); PG8_SCHED; PG8_LDA(At, 1, 0); PG8_STAGE(PG8_SA(0, 1), a2 + hstepA, voffA);
            PG8_WAIT_L(8); PG8_BAR; PG8_WAIT_L(0); PG8_MMA(0, 0, At, B0); PG8_BAR; PG8_SCHED;
            PG8_LDB(B1, 1, 1); PG8_STAGE(PG8_SB(1, 0), b3, voffB);
            PG8_BAR; PG8_WAIT_L(0); PG8_MMA(0, 1, At, B1); PG8_BAR;
            PG8_LDA(At, 1, 1); PG8_STAGE(PG8_SA(1, 0), a3, voffA);
            PG8_BAR; PG8_WAIT_L(0); PG8_MMA(1, 0, At, B0); PG8_BAR; PG8_SCHED;
            PG8_STAGE(PG8_SB(1, 1), b3 + hstepB, voffB);
            PG8_WAIT_V(6); PG8_BAR; PG8_MMA(1, 1, At, B1); PG8_BAR;
        }
        E(acc, cur, wr, wc, fr, fq);
        if (!has_next) break;
#pragma unroll
        for (int a = 0; a < 2; ++a)
#pragma unroll
            for (int b = 0; b < 2; ++b)
#pragma unroll
                for (int m = 0; m < 4; ++m)
#pragma unroll
                    for (int n = 0; n < 2; ++n) acc[a][b][m][n] = (f32x4){0.f, 0.f, 0.f, 0.f};
        cur = nxt; cA = nA; cB = nB; ++ui;
    }
    PG8_WAIT_V(0);
    if (wr == 0) PG8_BAR;
    PG8_BAR;
#undef PG8_SA
#undef PG8_SB
#undef PG8_STAGE
#undef PG8_LDA
#undef PG8_LDB
#undef PG8_MMA
#undef PG8_WAIT_V
#undef PG8_WAIT_L
#undef PG8_BAR
#undef PG8_SCHED
#undef PG8_BBASE
}
}
#define XB_TMO      128
#define XB_XCNT(j)  (256  + 64 * (j))
#define XB_XSUB(j)  (1280 + 64 * (j))
#define XB_XGEN(j)  (2304 + 64 * (j))
#define XB_TOP      3328
#define XB_TOPGEN   3392
#define XCD_BAR_WORDS 3456
#define XB_SPIN_CAP (1u << 22)
__device__ __forceinline__ unsigned xb_ld(unsigned* p)              { return __hip_atomic_load(p, __ATOMIC_RELAXED, __HIP_MEMORY_SCOPE_AGENT); }
__device__ __forceinline__ unsigned xb_add(unsigned* p, unsigned v) { return __hip_atomic_fetch_add(p, v, __ATOMIC_RELAXED, __HIP_MEMORY_SCOPE_AGENT); }
__device__ __forceinline__ unsigned xb_xcc_id() { return (unsigned)__builtin_amdgcn_s_getreg((3 << 11) | 20) & 0xFu; }
#define XB_SPIN(cond, bar) do { unsigned _sp = 0; while (cond) { __builtin_amdgcn_s_sleep(1); \
    if ((++_sp & 255u) == 0u) { if (xb_ld(&(bar)[XB_TMO])) break; if (_sp > XB_SPIN_CAP) { atomicAdd(&(bar)[XB_TMO], 1u); break; } } } } while (0)
struct XcdBarrier { unsigned* bar; unsigned x; volatile LAS unsigned* st; };
__device__ __forceinline__ XcdBarrier xcd_barrier_post(unsigned* bar, volatile LAS unsigned* st) {
    XcdBarrier b; b.bar = bar; b.x = xb_xcc_id(); b.st = st;
    if (threadIdx.x == 0) (void)xb_add(&bar[XB_XCNT(b.x)], 1u);
    return b;
}
__device__ __forceinline__ void xcd_barrier_complete(unsigned* bar, unsigned x, unsigned& nloc, unsigned& nx) {
    const unsigned G = gridDim.x * gridDim.y * gridDim.z;
    unsigned sum, cnt, mine, sp = 0u;
    for (;;) {
        sum = 0u; cnt = 0u; mine = 0u;
#pragma unroll
        for (unsigned j = 0; j < 16; ++j) { const unsigned c = xb_ld(&bar[XB_XCNT(j)]); sum += c; cnt += (c > 0u) ? 1u : 0u; mine = (j == x) ? c : mine; }
        if (sum == G) break;
        __builtin_amdgcn_s_sleep(1);
        if ((++sp & 255u) == 0u) { if (xb_ld(&bar[XB_TMO])) break; if (sp > XB_SPIN_CAP) { atomicAdd(&bar[XB_TMO], 1u); break; } }
    }
    nloc = mine > 0u ? mine : 1u; nx = cnt > 0u ? cnt : 1u;
}
__device__ __forceinline__ void xcd_barrier(const XcdBarrier& b) {
    asm volatile("s_waitcnt vmcnt(0)" ::: "memory");
    __syncthreads();
    if (threadIdx.x == 0) {
        unsigned* bar = b.bar;
        __builtin_amdgcn_s_waitcnt(0);
        unsigned nloc = b.st[0], nx = b.st[1];
        if (nloc == 0u) { xcd_barrier_complete(bar, b.x, nloc, nx); b.st[0] = nloc; b.st[1] = nx; }
        const unsigned old = xb_add(&bar[XB_XSUB(b.x)], 1u);
        const unsigned gen = old / nloc;
        if (old + 1u == (gen + 1u) * nloc) {
            __builtin_amdgcn_fence(__ATOMIC_RELEASE, "agent");
            asm volatile("s_waitcnt vmcnt(0)" ::: "memory");
            const unsigned og = xb_add(&bar[XB_TOP], 1u);
            const unsigned tg = og / nx;
            if (og + 1u == (tg + 1u) * nx) xb_add(&bar[XB_TOPGEN], 1u);
            else XB_SPIN(xb_ld(&bar[XB_TOPGEN]) == tg, bar);
            __builtin_amdgcn_fence(__ATOMIC_ACQUIRE, "agent");
            xb_add(&bar[XB_XGEN(b.x)], 1u);
            asm volatile("s_waitcnt vmcnt(0)" ::: "memory");
        } else {
            XB_SPIN(xb_ld(&bar[XB_XGEN(b.x)]) == gen, bar);
            __builtin_amdgcn_fence(__ATOMIC_ACQUIRE, "agent");
            asm volatile("s_waitcnt vmcnt(0)" ::: "memory");
        }
    }
    __syncthreads();
}

enum { EM_IN0 = 0, EM_PLAIN = 1, EM_S5A = 2, EM_S5B = 3, EM_GLU = 4, EM_OUT = 5, EM_IN1 = 6 };
template <int mode> struct EpiMulti {
    int ldc;
    bf16_t* o0; bf16_t* o1; float* f0;
    const bf16_t* i0; const bf16_t* i1; const float* c0; const float* c1;
    unsigned char* ws;
    __device__ __forceinline__ void operator()(const f32x4 (&acc)[2][2][4][2], const pg8::Unit& u, int wr, int wc, int fr, int fq) const {
        const int rowb = u.pm * 256 + wr * 64 + fr;
        const int colb = u.pn * 256 + wc * 32 + 8 * fq;
#pragma unroll
        for (int ai = 0; ai < 2; ++ai)
#pragma unroll
            for (int m = 0; m < 4; ++m) {
                const int row = rowb + ai * 128 + m * 16;
                float ssq = 0.f;
#pragma unroll
                for (int bj = 0; bj < 2; ++bj) {
                    const int c = colb + bj * 128;
                    f32x4 v0 = acc[ai][bj][m][0], v1 = acc[ai][bj][m][1];
                    if constexpr (mode == EM_PLAIN) {
                        u32x4 w; w.x = cvt_pk_bf16(v0[0], v0[1]); w.y = cvt_pk_bf16(v0[2], v0[3]); w.z = cvt_pk_bf16(v1[0], v1[1]); w.w = cvt_pk_bf16(v1[2], v1[3]);
                        *(u32x4*)(o0 + (size_t)row * ldc + c) = w;
                    } else if constexpr (mode == EM_IN0) {
                        u32x4 w; w.x = cvt_pk_bf16(v0[0], v0[1]); w.y = cvt_pk_bf16(v0[2], v0[3]); w.z = cvt_pk_bf16(v1[0], v1[1]); w.w = cvt_pk_bf16(v1[2], v1[3]);
                        if (c < 512) {
                            const int g = c >> 4, b = row >> 11, l = row & 2047;
                            *(u32x4*)(o1 + ((size_t)((g * 16 + b) * 2048 + l)) * 16 + (c & 15)) = w;
                        } else {
                            *(u32x4*)(o0 + (size_t)row * 1536 + (c - 512)) = w;
                        }
                    } else if constexpr (mode == EM_S5A) {
                        if (c < 512) {
                            u32x4 w; w.x = cvt_pk_bf16(v0[0], v0[1]); w.y = cvt_pk_bf16(v0[2], v0[3]); w.z = cvt_pk_bf16(v1[0], v1[1]); w.w = cvt_pk_bf16(v1[2], v1[3]);
                            *(u32x4*)(o0 + (size_t)row * 512 + c) = w;
                        } else if (c < 640) {
                            float* p = f0 + (size_t)row * 128 + (c - 512);
                            *(f32x4*)p = v0; *(f32x4*)(p + 4) = v1;
                        }
                    } else if constexpr (mode == EM_S5B) {
                        const size_t idx = (size_t)row * 512 + c;
                        const u32x4 yl = *(const u32x4*)(i0 + idx), uu = *(const u32x4*)(i1 + idx);
                        const int g = row >> 10, b = (row >> 6) & 15, ck = row & 63, t = c >> 4, ch = c & 15;
                        const f32x4 d0 = *(const f32x4*)(c0 + g * 16 + ch), d1 = *(const f32x4*)(c0 + g * 16 + ch + 4);
                        float y[8];
                        y[0] = v0[0] + bflo(yl.x) + d0[0] * bflo(uu.x); y[1] = v0[1] + bfhi(yl.x) + d0[1] * bfhi(uu.x);
                        y[2] = v0[2] + bflo(yl.y) + d0[2] * bflo(uu.y); y[3] = v0[3] + bfhi(yl.y) + d0[3] * bfhi(uu.y);
                        y[4] = v1[0] + bflo(yl.z) + d1[0] * bflo(uu.z); y[5] = v1[1] + bfhi(yl.z) + d1[1] * bfhi(uu.z);
                        y[6] = v1[2] + bflo(yl.w) + d1[2] * bflo(uu.w); y[7] = v1[3] + bfhi(yl.w) + d1[3] * bfhi(uu.w);
#pragma unroll
                        for (int j = 0; j < 8; ++j) y[j] = gelu_tanh_f(y[j]);
                        u32x4 w; w.x = cvt_pk_bf16(y[0], y[1]); w.y = cvt_pk_bf16(y[2], y[3]); w.z = cvt_pk_bf16(y[4], y[5]); w.w = cvt_pk_bf16(y[6], y[7]);
                        const size_t tok = (size_t)b * 2048 + ck * 32 + t;
                        *(u32x4*)(o0 + tok * 512 + g * 16 + ch) = w;
                        asm volatile("" ::: "memory");
                    } else if constexpr (mode == EM_GLU) {
                        const u32x4 gg = *(const u32x4*)(i0 + (size_t)row * 512 + c), zz = *(const u32x4*)(i1 + (size_t)row * 1536 + c);
                        const f32x4 b0 = *(const f32x4*)(c0 + c), b1 = *(const f32x4*)(c0 + c + 4);
                        float y[8];
                        y[0] = bflo(gg.x) * sigmoid_f(v0[0] + b0[0]) * silu_f(bflo(zz.x)); y[1] = bfhi(gg.x) * sigmoid_f(v0[1] + b0[1]) * silu_f(bfhi(zz.x));
                        y[2] = bflo(gg.y) * sigmoid_f(v0[2] + b0[2]) * silu_f(bflo(zz.y)); y[3] = bfhi(gg.y) * sigmoid_f(v0[3] + b0[3]) * silu_f(bfhi(zz.y));
                        y[4] = bflo(gg.z) * sigmoid_f(v1[0] + b1[0]) * silu_f(bflo(zz.z)); y[5] = bfhi(gg.z) * sigmoid_f(v1[1] + b1[1]) * silu_f(bfhi(zz.z));
                        y[6] = bflo(gg.w) * sigmoid_f(v1[2] + b1[2]) * silu_f(bflo(zz.w)); y[7] = bfhi(gg.w) * sigmoid_f(v1[3] + b1[3]) * silu_f(bfhi(zz.w));
                        u32x4 w; w.x = cvt_pk_bf16(y[0], y[1]); w.y = cvt_pk_bf16(y[2], y[3]); w.z = cvt_pk_bf16(y[4], y[5]); w.w = cvt_pk_bf16(y[6], y[7]);
                        *(u32x4*)(o0 + (size_t)row * 1024 + c) = w;
                    } else if constexpr (mode == EM_OUT) {
                        u32x4 w; w.x = cvt_pk_bf16(v0[0], v0[1]); w.y = cvt_pk_bf16(v0[2], v0[3]); w.z = cvt_pk_bf16(v1[0], v1[1]); w.w = cvt_pk_bf16(v1[2], v1[3]);
                        *(u32x4*)(o0 + (size_t)row * 1024 + c) = w;
                        ssq += (v0[0] * v0[0] + v0[1] * v0[1]) + (v0[2] * v0[2] + v0[3] * v0[3]) + (v1[0] * v1[0] + v1[1] * v1[1]) + (v1[2] * v1[2] + v1[3] * v1[3]);
                    } else {
                        const int blk = c >> 9, cc = c & 511, b = row >> 11, l = row & 2047;
                        if (blk == 0 || blk == 1 || blk == 4 || blk == 5) {
                            const int hh = cc >> 6, p = cc & 63, j0 = (p >> 3) * 4;
                            const f32x4 cs = *(const f32x4*)(c0 + l * 32 + j0), sn = *(const f32x4*)(c1 + l * 32 + j0);
                            f32x4 r0, r1;
#pragma unroll
                            for (int e = 0; e < 4; ++e) { r0[e] = v0[e] * cs[e] - v1[e] * sn[e]; r1[e] = v1[e] * cs[e] + v0[e] * sn[e]; }
                            u32x4 w; w.x = cvt_pk_bf16(r0[0], r0[1]); w.y = cvt_pk_bf16(r0[2], r0[3]); w.z = cvt_pk_bf16(r1[0], r1[1]); w.w = cvt_pk_bf16(r1[2], r1[3]);
                            bf16_t* base = (bf16_t*)(ws + (blk == 0 ? WS_CQ : blk == 1 ? WS_CK : blk == 4 ? WS_DQ : WS_DK));
                            size_t off;
                            if (blk < 2) off = ((size_t)(((b * 8 + hh) * 16 + (l & 15)) * 128 + (l >> 4))) * 64 + p;
                            else off = ((size_t)((b * 8 + hh) * 2048 + l)) * 64 + p;
                            *(u32x4*)(base + off) = w;
                        } else {
                            u32x4 w; w.x = cvt_pk_bf16(v0[0], v0[1]); w.y = cvt_pk_bf16(v0[2], v0[3]); w.z = cvt_pk_bf16(v1[0], v1[1]); w.w = cvt_pk_bf16(v1[2], v1[3]);
                            bf16_t* base = (bf16_t*)(ws + (blk == 2 ? WS_CVTMP : blk == 3 ? WS_CZ : blk == 6 ? WS_DVTMP : WS_DZ));
                            *(u32x4*)(base + (size_t)row * 512 + cc) = w;
                        }
                    }
                }
                if constexpr (mode == EM_OUT) {
                    ssq += __shfl_xor(ssq, 16); ssq += __shfl_xor(ssq, 32);
                    if (fq == 0) f0[(size_t)row * 16 + u.pn * 4 + wc] = ssq;
                }
                asm volatile("" ::: "memory");
            }
    }
};
struct Params { const float* in[31]; float* out; unsigned char* ws; int ph_lo, ph_hi; };
struct Ctx {
    const float* const* in; float* out; unsigned char* ws;
    LAS unsigned char* lds; int tid, lane, wid, G, bid;
};
#define WSP(T, off) ((T*)(C.ws + (off)))

DEVI void rows_pass(const Ctx& C, int mode) {
    const float* x = C.in[0];
    const float* pre = C.in[1]; const float* post = C.in[2];
    const bf16_t* Y0 = WSP(const bf16_t, WS_Y0); const bf16_t* Y1 = WSP(const bf16_t, WS_Y1);
    const float* SS0 = WSP(const float, WS_SS0); const float* SS1 = WSP(const float, WS_SS1);
    bf16_t* XN = (mode == 0) ? WSP(bf16_t, WS_XN) : WSP(bf16_t, WS_XN1);
    const int gw = C.bid * 8 + C.wid, nw = C.G * 8, lane = C.lane;
    for (int r = gw; r < NT; r += nw) {
        f32x4 v[4];
#pragma unroll
        for (int i = 0; i < 4; ++i) v[i] = *(const f32x4*)(x + (size_t)r * 1024 + i * 256 + lane * 4);
        if (mode >= 1) {
            float s0 = (lane < 16) ? SS0[(size_t)r * 16 + lane] : 0.f; s0 = wave_sum(s0);
            const float rs0 = rsqrtf(s0 * (1.0f / 1024.0f) + 1e-6f);
#pragma unroll
            for (int i = 0; i < 4; ++i) {
                const u32x2 y = *(const u32x2*)(Y0 + (size_t)r * 1024 + i * 256 + lane * 4);
                const f32x4 gp = *(const f32x4*)(post + i * 256 + lane * 4);
                v[i][0] += bflo(y.x) * rs0 * gp[0]; v[i][1] += bfhi(y.x) * rs0 * gp[1]; v[i][2] += bflo(y.y) * rs0 * gp[2]; v[i][3] += bfhi(y.y) * rs0 * gp[3];
            }
        }
        if (mode == 2) {
            float s1 = (lane < 16) ? SS1[(size_t)r * 16 + lane] : 0.f; s1 = wave_sum(s1);
            const float rs1 = rsqrtf(s1 * (1.0f / 1024.0f) + 1e-6f);
#pragma unroll
            for (int i = 0; i < 4; ++i) {
                const u32x2 y = *(const u32x2*)(Y1 + (size_t)r * 1024 + i * 256 + lane * 4);
                const f32x4 gp = *(const f32x4*)(post + 1024 + i * 256 + lane * 4);
                f32x4 o = v[i];
                o[0] += bflo(y.x) * rs1 * gp[0]; o[1] += bfhi(y.x) * rs1 * gp[1]; o[2] += bflo(y.y) * rs1 * gp[2]; o[3] += bfhi(y.y) * rs1 * gp[3];
                *(f32x4*)(C.out + (size_t)r * 1024 + i * 256 + lane * 4) = o;
            }
        } else {
            float ss = 0.f;
#pragma unroll
            for (int i = 0; i < 4; ++i) ss += (v[i][0] * v[i][0] + v[i][1] * v[i][1]) + (v[i][2] * v[i][2] + v[i][3] * v[i][3]);
            ss = wave_sum(ss);
            const float rs = rsqrtf(ss * (1.0f / 1024.0f) + 1e-6f);
            const float* gpre = pre + (mode == 0 ? 0 : 1024);
#pragma unroll
            for (int i = 0; i < 4; ++i) {
                const f32x4 gp = *(const f32x4*)(gpre + i * 256 + lane * 4);
                u32x2 w; w.x = cvt_pk_bf16(v[i][0] * rs * gp[0], v[i][1] * rs * gp[1]); w.y = cvt_pk_bf16(v[i][2] * rs * gp[2], v[i][3] * rs * gp[3]);
                *(u32x2*)(XN + (size_t)r * 1024 + i * 256 + lane * 4) = w;
            }
        }
    }
}

DEVI int rope_dim(int p) { return ((p & 7) < 4) ? (4 * (p >> 3) + (p & 7)) : (32 + 4 * (p >> 3) + ((p & 7) - 4)); }
DEVI void wt_tile(const Ctx& C, const float* W, int K, int N, bf16_t* Wt, int tile, bool rope_perm) {
    LAS float* T = (LAS float*)C.lds;
    const int ntn = N / 64, tk = tile / ntn, tn = tile % ntn, k0 = tk * 64, n0 = tn * 64, tid = C.tid;
    __syncthreads();
#pragma unroll
    for (int i = 0; i < 2; ++i) { const int e = tid + i * 512, r = e >> 4, c4 = (e & 15) * 4;
        const f32x4 v = *(const f32x4*)(W + (size_t)(k0 + r) * N + n0 + c4);
        T[r * 65 + c4 + 0] = v[0]; T[r * 65 + c4 + 1] = v[1]; T[r * 65 + c4 + 2] = v[2]; T[r * 65 + c4 + 3] = v[3]; }
    __syncthreads();
    const int nn = tid >> 3, kc = (tid & 7) * 8;
    bool perm = false;
    if (rope_perm) { const int blk = n0 >> 9; perm = (blk == 0 || blk == 1 || blk == 4 || blk == 5); }
    const int src = perm ? rope_dim(nn) : nn;
    float f[8];
#pragma unroll
    for (int j = 0; j < 8; ++j) f[j] = T[(kc + j) * 65 + src];
    u32x4 w; w.x = cvt_pk_bf16(f[0], f[1]); w.y = cvt_pk_bf16(f[2], f[3]); w.z = cvt_pk_bf16(f[4], f[5]); w.w = cvt_pk_bf16(f[6], f[7]);
    *(u32x4*)(Wt + (size_t)(n0 + nn) * K + k0 + kc) = w;
}

DEVI void s5_tables(const Ctx& C, int g, int part) {
    LAS float* APr = (LAS float*)C.lds;
    LAS float* APi = APr + 64 * 33;
    LAS float* BBr = APi + 64 * 33;
    LAS float* BBi = BBr + 1024;
    LAS float* Cr = BBi + 1024;
    LAS float* Ci = Cr + 1024;
    LAS float* KL = Ci + 1024;
    const int tid = C.tid;
    const float* lre = C.in[4]; const float* lim = C.in[5]; const float* ldt = C.in[6];
    const float* bre = C.in[7]; const float* bim = C.in[8]; const float* cre = C.in[9]; const float* cim = C.in[10];
    __syncthreads();
    if (tid < 64) {
        const int p = tid;
        const float lr = lre[g * 64 + p], li = lim[g * 64 + p], dt = expf(ldt[g]);
        const float mag = expf(lr * dt);
        const float ar = mag * cosf(li * dt), ai = mag * sinf(li * dt);
        const float den = lr * lr + li * li;
        const float fr = ((ar - 1.0f) * lr + ai * li) / den, fi = (ai * lr - (ar - 1.0f) * li) / den;
        double pr = 1.0, pi = 0.0;
        for (int k = 0; k <= 32; ++k) { APr[p * 33 + k] = (float)pr; APi[p * 33 + k] = (float)pi; const double nr = pr * (double)ar - pi * (double)ai, ni = pr * (double)ai + pi * (double)ar; pr = nr; pi = ni; }
        for (int c = 0; c < 16; ++c) { const float br = bre[(g * 64 + p) * 16 + c], bi = bim[(g * 64 + p) * 16 + c]; BBr[p * 16 + c] = fr * br - fi * bi; BBi[p * 16 + c] = fr * bi + fi * br; }
    }
    for (int e = tid; e < 1024; e += 512) { Cr[e] = cre[g * 1024 + e]; Ci[e] = cim[g * 1024 + e]; }
    __syncthreads();
    for (int e = tid; e < 8192; e += 512) {
        const int k = e >> 8, c = (e >> 4) & 15, cp = e & 15; float s = 0.f;
        for (int p = 0; p < 64; ++p) { const float a_r = APr[p * 33 + k], a_i = APi[p * 33 + k], c_r = Cr[c * 64 + p], c_i = Ci[c * 64 + p];
            const float car = c_r * a_r - c_i * a_i, cai = c_r * a_i + c_i * a_r; s += car * BBr[p * 16 + cp] - cai * BBi[p * 16 + cp]; }
        KL[e] = s;
    }
    __syncthreads();
    bf16_t* A5 = WSP(bf16_t, WS_BT5A) + (size_t)g * 768 * 512;
    bf16_t* B5 = WSP(bf16_t, WS_BT5B) + (size_t)g * 512 * 256;
    for (int e = tid; e < 96 * 64; e += 512) {
        const int R = part * 96 + (e >> 6), col0 = (e & 63) * 8; float f[8];
        if (R < 512) { const int t = R >> 4, c = R & 15, s = col0 >> 4, cp0 = col0 & 15;
#pragma unroll
            for (int j = 0; j < 8; ++j) f[j] = (s <= t) ? KL[(t - s) * 256 + c * 16 + cp0 + j] : 0.f;
        } else if (R < 640) { const int pp = R - 512, p = pp >> 1, ri = pp & 1, s = col0 >> 4, cp0 = col0 & 15;
            const float a_r = APr[p * 33 + (31 - s)], a_i = APi[p * 33 + (31 - s)];
#pragma unroll
            for (int j = 0; j < 8; ++j) { const float b_r = BBr[p * 16 + cp0 + j], b_i = BBi[p * 16 + cp0 + j]; f[j] = ri ? (a_r * b_i + a_i * b_r) : (a_r * b_r - a_i * b_i); }
        } else {
#pragma unroll
            for (int j = 0; j < 8; ++j) f[j] = 0.f;
        }
        u32x4 w; w.x = cvt_pk_bf16(f[0], f[1]); w.y = cvt_pk_bf16(f[2], f[3]); w.z = cvt_pk_bf16(f[4], f[5]); w.w = cvt_pk_bf16(f[6], f[7]);
        *(u32x4*)(A5 + (size_t)R * 512 + col0) = w;
    }
    for (int e = tid; e < 64 * 32; e += 512) {
        const int R = part * 64 + (e >> 5), col0 = (e & 31) * 8, t = R >> 4, c = R & 15; float f[8];
        if (col0 < 128) {
#pragma unroll
            for (int j = 0; j < 4; ++j) { const int p = (col0 >> 1) + j; const float a_r = APr[p * 33 + t + 1], a_i = APi[p * 33 + t + 1], c_r = Cr[c * 64 + p], c_i = Ci[c * 64 + p];
                f[2 * j] = c_r * a_r - c_i * a_i; f[2 * j + 1] = -(c_r * a_i + c_i * a_r); }
        } else {
#pragma unroll
            for (int j = 0; j < 8; ++j) f[j] = 0.f;
        }
        u32x4 w; w.x = cvt_pk_bf16(f[0], f[1]); w.y = cvt_pk_bf16(f[2], f[3]); w.z = cvt_pk_bf16(f[4], f[5]); w.w = cvt_pk_bf16(f[6], f[7]);
        *(u32x4*)(B5 + (size_t)R * 256 + col0) = w;
    }
    if (part == 0 && tid < 64) { f32x2 a; a.x = APr[tid * 33 + 32]; a.y = APi[tid * 33 + 32]; WSP(f32x2, WS_A32)[g * 64 + tid] = a; }
}

DEVI void phase_prologue(const Ctx& C) {
    const int tid = C.tid, G = C.G, bid = C.bid;
    {
        const int t0 = 16 * 32, t1 = t0 + 16 * 16, t2 = t1 + 16 * 64, t3 = t2 + 16 * 16, t4 = t3 + 8 * 8;
        for (int j = bid; j < t4; j += G) {
            if (j < t0) wt_tile(C, C.in[3], 1024, 2048, WSP(bf16_t, WS_WIN0), j, false);
            else if (j < t1) wt_tile(C, C.in[23], 1024, 1024, WSP(bf16_t, WS_WOUT0), j - t0, false);
            else if (j < t2) wt_tile(C, C.in[24], 1024, 4096, WSP(bf16_t, WS_WIN1), j - t1, true);
            else if (j < t3) wt_tile(C, C.in[30], 1024, 1024, WSP(bf16_t, WS_WOUT1), j - t2, false);
            else wt_tile(C, C.in[12], 512, 512, WSP(bf16_t, WS_GLU), j - t3, false);
        }
    }
    for (int j = bid; j < 256; j += G) s5_tables(C, j >> 3, j & 7);
    const int gt = bid * 512 + tid, ngt = G * 512;
    {
        const float* wq = C.in[16]; const float* wk = C.in[17]; const float* wv = C.in[18];
        bf16_t* WQK = WSP(bf16_t, WS_WQK); bf16_t* WV = WSP(bf16_t, WS_WV);
        for (int e = gt; e < 1536 * 512; e += ngt) {
            const int n = e >> 9, k = e & 511; const int nn = n & 511, h = nn >> 7, ee = nn & 127; float v = 0.f;
            if ((k >> 7) == h) { const int d = k & 127; const size_t wi = ((size_t)h * 128 + d) * 128 + ee;
                v = (n < 512) ? wq[wi] : (n < 1024) ? wk[wi] * 0.08838834764831845f : wv[wi]; }
            if (n < 1024) WQK[(size_t)n * 512 + k] = f2bf(v); else WV[(size_t)(n - 1024) * 512 + k] = f2bf(v);
        }
        const float* gw = C.in[19]; float* GF = WSP(float, WS_GF);
        for (int e = gt; e < 1024 * 8; e += ngt) {
            const int rr = e >> 3, j = e & 7, ch = rr & 511, h = ch >> 7, d = ch & 127; float s = 0.f;
            if (rr < 512) { for (int ee = 0; ee < 128; ++ee) { const size_t wi = ((size_t)h * 128 + d) * 128 + ee; s += wq[wi] * gw[(size_t)(h * 128 + ee) * 8 + j] + wk[wi] * gw[(size_t)(512 + h * 128 + ee) * 8 + j]; } }
            else { for (int ee = 0; ee < 128; ++ee) { const size_t wi = ((size_t)h * 128 + d) * 128 + ee; s += wv[wi] * gw[(size_t)(1024 + h * 128 + ee) * 8 + j]; } }
            GF[e] = s;
        }
    }
    {
        float* RC = WSP(float, WS_ROPE_C); float* RS = WSP(float, WS_ROPE_S);
        for (int e = gt; e < 2048 * 32; e += ngt) { const int pos = e >> 5, j = e & 31; const float inv = powf(10000.0f, -(float)(2 * j) / 64.0f); const float ang = (float)pos * inv; RC[e] = cosf(ang); RS[e] = sinf(ang); }
    }
    if (bid == 0 && tid == 0) {
        float s1 = 0.f, s2 = 0.f; for (int j = 0; j < 64; ++j) { s1 += C.in[25][j] * C.in[26][j]; s2 += C.in[27][j] * C.in[28][j]; }
        WSP(float, WS_LAM)[0] = expf(s1) - expf(s2) + (0.8f - 0.6f * expf(-0.3f));
    }
    rows_pass(C, 0);
}

DEVI void phase_conv_gates(const Ctx& C) {
    const bf16_t* PZ = WSP(const bf16_t, WS_PZ); bf16_t* XC = WSP(bf16_t, WS_XC);
    float* LI = WSP(float, WS_LI); float* LF = WSP(float, WS_LF);
    const float* cw = C.in[14]; const float* cb = C.in[15]; const float* gb = C.in[20];
    LAS float* GFs = (LAS float*)C.lds;
    __syncthreads();
    for (int e = C.tid; e < 8192; e += 512) GFs[e] = WSP(const float, WS_GF)[e];
    __syncthreads();
    const int lane = C.lane, ch0 = lane * 8;
    float w[4][8], bb[8];
#pragma unroll
    for (int j = 0; j < 4; ++j)
#pragma unroll
        for (int i = 0; i < 8; ++i) w[j][i] = cw[j * 512 + ch0 + i];
#pragma unroll
    for (int i = 0; i < 8; ++i) bb[i] = cb[ch0 + i];
    const int gw = C.bid * 8 + C.wid, nw = C.G * 8;
    for (int r = gw; r < NT; r += nw) {
        const int l = r & 2047;
        float xs[4][8];
#pragma unroll
        for (int j = 0; j < 4; ++j) {
            const int dl = 3 - j;
            if (l - dl >= 0) { const u32x4 q = *(const u32x4*)(PZ + (size_t)(r - dl) * 1536 + 512 + ch0);
                xs[j][0] = bflo(q.x); xs[j][1] = bfhi(q.x); xs[j][2] = bflo(q.y); xs[j][3] = bfhi(q.y); xs[j][4] = bflo(q.z); xs[j][5] = bfhi(q.z); xs[j][6] = bflo(q.w); xs[j][7] = bfhi(q.w); }
            else {
#pragma unroll
                for (int i = 0; i < 8; ++i) xs[j][i] = 0.f; }
        }
        float xc[8];
#pragma unroll
        for (int i = 0; i < 8; ++i) { const float a = bb[i] + xs[0][i] * w[0][i] + xs[1][i] * w[1][i] + xs[2][i] * w[2][i] + xs[3][i] * w[3][i]; xc[i] = silu_f(a); }
        u32x4 o; o.x = cvt_pk_bf16(xc[0], xc[1]); o.y = cvt_pk_bf16(xc[2], xc[3]); o.z = cvt_pk_bf16(xc[4], xc[5]); o.w = cvt_pk_bf16(xc[6], xc[7]);
        *(u32x4*)(XC + (size_t)r * 512 + ch0) = o;
        float gt8[8];
#pragma unroll
        for (int j = 0; j < 8; ++j) gt8[j] = 0.f;
#pragma unroll
        for (int i = 0; i < 8; ++i) {
            const f32x4 a0 = *(const LAS f32x4*)(GFs + (ch0 + i) * 8), a1 = *(const LAS f32x4*)(GFs + (ch0 + i) * 8 + 4);
            const f32x4 b0 = *(const LAS f32x4*)(GFs + (512 + ch0 + i) * 8), b1 = *(const LAS f32x4*)(GFs + (512 + ch0 + i) * 8 + 4);
            const float xcv = xc[i], xmv = xs[3][i];
            gt8[0] += xcv * a0[0] + xmv * b0[0]; gt8[1] += xcv * a0[1] + xmv * b0[1]; gt8[2] += xcv * a0[2] + xmv * b0[2]; gt8[3] += xcv * a0[3] + xmv * b0[3];
            gt8[4] += xcv * a1[0] + xmv * b1[0]; gt8[5] += xcv * a1[1] + xmv * b1[1]; gt8[6] += xcv * a1[2] + xmv * b1[2]; gt8[7] += xcv * a1[3] + xmv * b1[3];
        }
#pragma unroll
        for (int j = 0; j < 8; ++j) gt8[j] = wave_sum(gt8[j]);
        if (lane < 8) {
            float gsel = gt8[0];
#pragma unroll
            for (int j = 1; j < 8; ++j) gsel = (lane == j) ? gt8[j] : gsel;
            gsel += gb[lane];
            const int b = r >> 11;
            if (lane < 4) LI[(size_t)(b * 4 + lane) * 2048 + l] = gsel;
            else { const float ax = fabsf(gsel); const float ls = fminf(gsel, 0.f) - log1pf(expf(-ax)); LF[(size_t)(b * 4 + lane - 4) * 2048 + l] = ls; }
        }
    }
}

DEVI void transpose_tok(const Ctx& C, const bf16_t* src, bf16_t* dst, int mode) {
    LAS unsigned* T = (LAS unsigned*)C.lds;
    LAS bf16_t* Ts = (LAS bf16_t*)C.lds;
    const int tid = C.tid;
    for (int tile = C.bid; tile < (NT / 64) * 8; tile += C.G) {
        const int tt = tile >> 3, cblk = tile & 7, tok0 = tt * 64, ch0 = cblk * 64;
        __syncthreads();
        { const int r = tid >> 3, cc = (tid & 7) * 8;
          const u32x4 q = *(const u32x4*)(src + (size_t)(tok0 + r) * 512 + ch0 + cc);
          const unsigned wv[4] = {q.x, q.y, q.z, q.w};
#pragma unroll
          for (int j = 0; j < 4; ++j) { Ts[(cc + 2 * j) * 66 + r] = (bf16_t)(wv[j] & 0xffffu); Ts[(cc + 2 * j + 1) * 66 + r] = (bf16_t)(wv[j] >> 16); } }
        __syncthreads();
        { const int c = tid >> 3, tc = (tid & 7) * 8;
          const int ch = ch0 + c, b = tok0 >> 11, l0 = (tok0 & 2047) + tc;
          if (mode == 0) {
              u32x4 w; w.x = T[c * 33 + (tc >> 1)]; w.y = T[c * 33 + (tc >> 1) + 1]; w.z = T[c * 33 + (tc >> 1) + 2]; w.w = T[c * 33 + (tc >> 1) + 3];
              const int h = ch >> 7, dv = ch & 127;
              *(u32x4*)(dst + ((size_t)((b * 4 + h) * 128 + dv)) * 2048 + l0) = w;
          } else {
              const int h = ch >> 6, dv = ch & 63;
#pragma unroll
              for (int j = 0; j < 8; ++j) { const int l = l0 + j; dst[((size_t)(((b * 8 + h) * 64 + dv) * 16 + (l & 15))) * 128 + (l >> 4)] = Ts[c * 66 + tc + j]; }
          } }
    }
}

DEVI void phase_mid0(const Ctx& C) {
    transpose_tok(C, WSP(const bf16_t, WS_VTMP), WSP(bf16_t, WS_VT0), 0);
    const int gw = C.bid * 8 + C.wid, lane = C.lane;
    if (gw < 64) {
        const float* LF = WSP(const float, WS_LF) + (size_t)gw * 2048; const float* LI = WSP(const float, WS_LI) + (size_t)gw * 2048;
        float* BC = WSP(float, WS_BC) + (size_t)gw * 2048; float* DS = WSP(float, WS_DS) + (size_t)gw * 2048;
        float tot = 0.f;
        for (int j = 0; j < 32; ++j) tot += LF[lane * 32 + j];
        float inc = tot;
#pragma unroll
        for (int d = 1; d < 64; d <<= 1) { const float o = __shfl_up(inc, d); if (lane >= d) inc += o; }
        float run = inc - tot;
        for (int j = 0; j < 32; ++j) { run += LF[lane * 32 + j]; BC[lane * 32 + j] = run; DS[lane * 32 + j] = LI[lane * 32 + j] - run; }
    }
    {
        const float* XLOC = WSP(const float, WS_XLOC); bf16_t* XST = WSP(bf16_t, WS_XST); const f32x2* A32 = WSP(const f32x2, WS_A32);
        for (int e = C.bid * 512 + C.tid; e < 32 * 16 * 64; e += C.G * 512) {
            const int p = e & 63, gb = e >> 6, g = gb >> 4;
            const f32x2 a = A32[g * 64 + p]; float xr = 0.f, xi = 0.f;
            for (int i = 0; i < 64; ++i) {
                const size_t n = (size_t)gb * 64 + i;
                *(unsigned*)(XST + n * 256 + 2 * p) = cvt_pk_bf16(xr, xi);
                *(unsigned*)(XST + n * 256 + 128 + 2 * p) = 0u;
                const f32x2 lc = *(const f32x2*)(XLOC + n * 128 + 2 * p);
                const float nr = a.x * xr - a.y * xi + lc.x, ni = a.x * xi + a.y * xr + lc.y; xr = nr; xi = ni;
            }
        }
    }
}
constexpr float NEG_INF = -__builtin_inff();

template <int NDT>
DEVI void osm_update(float (&s)[8], float& m, float& l, f32x4 (&o)[NDT], bf16x8& pf) {
    float mx = fmaxf(fmaxf(fmaxf(s[0], s[1]), fmaxf(s[2], s[3])), fmaxf(fmaxf(s[4], s[5]), fmaxf(s[6], s[7])));
    mx = fmaxf(mx, __shfl_xor(mx, 16)); mx = fmaxf(mx, __shfl_xor(mx, 32));
    const float mn = fmaxf(m, mx);
    const float mref = (mn == NEG_INF) ? 0.f : mn;
    const float alpha = fast_exp2(m - mref);
    float p[8]; float ps = 0.f;
#pragma unroll
    for (int i = 0; i < 8; ++i) { p[i] = fast_exp2(s[i] - mref); ps += p[i]; }
    l = l * alpha + ps; m = mn;
#pragma unroll
    for (int d = 0; d < NDT; ++d) o[d] *= alpha;
    u32x4 w; w.x = cvt_pk_bf16(p[0], p[1]); w.y = cvt_pk_bf16(p[2], p[3]); w.z = cvt_pk_bf16(p[4], p[5]); w.w = cvt_pk_bf16(p[6], p[7]);
    pf = __builtin_bit_cast(bf16x8, w);
}

DEVI bf16x8 ld_vt(const bf16_t* lo, const bf16_t* hi) {
    const u32x2 a = *(const u32x2*)lo, b = *(const u32x2*)hi; u32x4 w; w.x = a.x; w.y = a.y; w.z = b.x; w.w = b.y; return __builtin_bit_cast(bf16x8, w);
}

DEVI void phase_mlstm(const Ctx& C) {
    const bf16_t* QK = WSP(const bf16_t, WS_QK); const bf16_t* VT = WSP(const bf16_t, WS_VT0);
    const float* BC = WSP(const float, WS_BC); const float* DS = WSP(const float, WS_DS);
    const bf16_t* XC = WSP(const bf16_t, WS_XC); const bf16_t* PZ = WSP(const bf16_t, WS_PZ);
    bf16_t* AB = WSP(bf16_t, WS_AB);
    const float* ng = C.in[21]; const float* sk = C.in[22];
    const int lane = C.lane, r = lane & 15, g4 = lane >> 4;
    const int gw = C.bid * 8 + C.wid, nw = C.G * 8;
    for (int task = gw; task < 64 * 128; task += nw) {
        const int seq = task & 63, x = (task >> 6) & 31, q = task >> 11;
        const int rt = (q == 0) ? 127 - x : (q == 1) ? x : (q == 2) ? 95 - x : 32 + x;
        const int b = seq >> 2, h = seq & 3;
        const int t = 16 * rt + r; const size_t row = (size_t)b * 2048 + t;
        bf16x8 qf[4];
#pragma unroll
        for (int ks = 0; ks < 4; ++ks) qf[ks] = *(const bf16x8*)(QK + row * 1024 + h * 128 + 32 * ks + 8 * g4);
        const bf16_t* Kb = QK + (size_t)b * 2048 * 1024 + 512 + h * 128 + 8 * g4;
        const bf16_t* Vb = VT + ((size_t)(seq * 128 + r)) * 2048 + 4 * g4;
        const float* BCs = BC + (size_t)seq * 2048; const float* DSs = DS + (size_t)seq * 2048;
        const float bct = BCs[t];
        f32x4 o[8];
#pragma unroll
        for (int d = 0; d < 8; ++d) o[d] = (f32x4){0.f, 0.f, 0.f, 0.f};
        float dsum = 0.f;
        const int nseg = rt / 2 + 1;
        for (int sg = 0; sg < nseg; ++sg) {
            const int s0 = 32 * sg;
            f32x4 st[2];
#pragma unroll
            for (int kt = 0; kt < 2; ++kt) { st[kt] = (f32x4){0.f, 0.f, 0.f, 0.f}; const bf16_t* kp = Kb + (size_t)(s0 + 16 * kt + r) * 1024;
#pragma unroll
                for (int ks = 0; ks < 4; ++ks) st[kt] = mfma16(*(const bf16x8*)(kp + 32 * ks), qf[ks], st[kt]); }
            const float bref = BCs[s0];
            const float rowf = fast_exp2((bct - bref) * LOG2E);
            const f32x4 d0 = *(const f32x4*)(DSs + s0 + 4 * g4), d1 = *(const f32x4*)(DSs + s0 + 16 + 4 * g4);
            float p[8];
#pragma unroll
            for (int j = 0; j < 4; ++j) {
                const int k0 = s0 + 4 * g4 + j, k1 = k0 + 16;
                const float c0 = fast_exp2((bref + d0[j]) * LOG2E), c1 = fast_exp2((bref + d1[j]) * LOG2E);
                p[j] = (k0 <= t) ? st[0][j] * rowf * c0 : 0.f; p[4 + j] = (k1 <= t) ? st[1][j] * rowf * c1 : 0.f;
            }
            dsum += (p[0] + p[1]) + (p[2] + p[3]) + (p[4] + p[5]) + (p[6] + p[7]);
            u32x4 w; w.x = cvt_pk_bf16(p[0], p[1]); w.y = cvt_pk_bf16(p[2], p[3]); w.z = cvt_pk_bf16(p[4], p[5]); w.w = cvt_pk_bf16(p[6], p[7]);
            const bf16x8 pf = __builtin_bit_cast(bf16x8, w);
#pragma unroll
            for (int d = 0; d < 8; ++d) { const bf16_t* vp = Vb + (size_t)(16 * d) * 2048 + s0; o[d] = mfma16(ld_vt(vp, vp + 16), pf, o[d]); }
        }
        dsum += __shfl_xor(dsum, 16); dsum += __shfl_xor(dsum, 32);
        const float rden = 1.0f / fmaxf(fabsf(dsum), 1.0f);
        float su = 0.f;
#pragma unroll
        for (int d = 0; d < 8; ++d) { o[d] *= rden; su += (o[d][0] + o[d][1]) + (o[d][2] + o[d][3]); }
        su += __shfl_xor(su, 16); su += __shfl_xor(su, 32);
        const float mu = su * (1.0f / 128.0f);
        float sv = 0.f;
#pragma unroll
        for (int d = 0; d < 8; ++d) { const f32x4 dd = o[d] - mu; sv += (dd[0] * dd[0] + dd[1] * dd[1]) + (dd[2] * dd[2] + dd[3] * dd[3]); }
        sv += __shfl_xor(sv, 16); sv += __shfl_xor(sv, 32);
        const float rstd = rsqrtf(sv * (1.0f / 128.0f) + 1e-5f);
#pragma unroll
        for (int d = 0; d < 8; ++d) {
            const int ch = h * 128 + 16 * d + 4 * g4;
            const f32x4 gg = *(const f32x4*)(ng + ch), ss = *(const f32x4*)(sk + ch);
            const u32x2 xc = *(const u32x2*)(XC + row * 512 + ch), zz = *(const u32x2*)(PZ + row * 1536 + 1024 + ch);
            const float xcv[4] = {bflo(xc.x), bfhi(xc.x), bflo(xc.y), bfhi(xc.y)}, zv[4] = {bflo(zz.x), bfhi(zz.x), bflo(zz.y), bfhi(zz.y)};
            float y[4];
#pragma unroll
            for (int j = 0; j < 4; ++j) y[j] = ((o[d][j] - mu) * rstd * gg[j] + ss[j] * xcv[j]) * silu_f(zv[j]);
            u32x2 w; w.x = cvt_pk_bf16(y[0], y[1]); w.y = cvt_pk_bf16(y[2], y[3]);
            *(u32x2*)(AB + row * 1024 + 512 + ch) = w;
        }
    }
}

DEVI void phase_diff(const Ctx& C) {
    const bf16_t* DQ = WSP(const bf16_t, WS_DQ); const bf16_t* DK = WSP(const bf16_t, WS_DK); const bf16_t* VT = WSP(const bf16_t, WS_DVT);
    const bf16_t* DZ = WSP(const bf16_t, WS_DZ); bf16_t* CD = WSP(bf16_t, WS_CD);
    const float* dn = C.in[29];
    const float lam = WSP(const float, WS_LAM)[0];
    const float lam_init = 0.8f - 0.6f * 0.7408182206817179f;
    const int lane = C.lane, r = lane & 15, g4 = lane >> 4;
    const int gw = C.bid * 8 + C.wid, nw = C.G * 8;
    const float sc = 0.125f * LOG2E;
    for (int task = gw; task < 64 * 128; task += nw) {
        const int seq = task & 63, x = (task >> 6) & 31, q = task >> 11;
        const int rt = (q == 0) ? 127 - x : (q == 1) ? x : (q == 2) ? 95 - x : 32 + x;
        const int b = seq >> 2, h = seq & 3;
        const int t = 16 * rt + r; const size_t row = (size_t)b * 2048 + t;
        const bf16_t* Vb = VT + ((size_t)(seq * 128 + r)) * 2048 + 4 * g4;
        const int nseg = rt / 2 + 1;
        f32x4 res[8];
#pragma unroll
        for (int comp = 0; comp < 2; ++comp) {
            const size_t hb = ((size_t)(b * 8 + 2 * h + comp)) * 2048;
            bf16x8 qf[2];
#pragma unroll
            for (int ks = 0; ks < 2; ++ks) qf[ks] = *(const bf16x8*)(DQ + (hb + t) * 64 + 32 * ks + 8 * g4);
            const bf16_t* Kb = DK + hb * 64 + 8 * g4;
            f32x4 o[8];
#pragma unroll
            for (int d = 0; d < 8; ++d) o[d] = (f32x4){0.f, 0.f, 0.f, 0.f};
            float m = NEG_INF, l = 0.f;
            for (int sg = 0; sg < nseg; ++sg) {
                const int s0 = 32 * sg;
                f32x4 st[2];
#pragma unroll
                for (int kt = 0; kt < 2; ++kt) { st[kt] = (f32x4){0.f, 0.f, 0.f, 0.f}; const bf16_t* kp = Kb + (size_t)(s0 + 16 * kt + r) * 64;
#pragma unroll
                    for (int ks = 0; ks < 2; ++ks) st[kt] = mfma16(*(const bf16x8*)(kp + 32 * ks), qf[ks], st[kt]); }
                float s[8];
#pragma unroll
                for (int j = 0; j < 4; ++j) { const int k0 = s0 + 4 * g4 + j, k1 = k0 + 16; s[j] = (k0 <= t) ? st[0][j] * sc : NEG_INF; s[4 + j] = (k1 <= t) ? st[1][j] * sc : NEG_INF; }
                bf16x8 pf; osm_update<8>(s, m, l, o, pf);
#pragma unroll
                for (int d = 0; d < 8; ++d) { const bf16_t* vp = Vb + (size_t)(16 * d) * 2048 + s0; o[d] = mfma16(ld_vt(vp, vp + 16), pf, o[d]); }
            }
            l += __shfl_xor(l, 16); l += __shfl_xor(l, 32);
            const float rl = 1.0f / l;
            if (comp == 0) {
#pragma unroll
                for (int d = 0; d < 8; ++d) res[d] = o[d] * rl;
            } else {
#pragma unroll
                for (int d = 0; d < 8; ++d) res[d] -= o[d] * (rl * lam);
            }
        }
        float ss = 0.f;
#pragma unroll
        for (int d = 0; d < 8; ++d) ss += (res[d][0] * res[d][0] + res[d][1] * res[d][1]) + (res[d][2] * res[d][2] + res[d][3] * res[d][3]);
        ss += __shfl_xor(ss, 16); ss += __shfl_xor(ss, 32);
        const float rn = rsqrtf(ss * (1.0f / 128.0f) + 1e-5f) * (1.0f - lam_init);
#pragma unroll
        for (int d = 0; d < 8; ++d) {
            const int dv = 16 * d + 4 * g4, ch = h * 128 + dv;
            const f32x4 gg = *(const f32x4*)(dn + dv);
            const u32x2 zz = *(const u32x2*)(DZ + row * 512 + ch);
            const float zv[4] = {bflo(zz.x), bfhi(zz.x), bflo(zz.y), bfhi(zz.y)};
            float y[4];
#pragma unroll
            for (int j = 0; j < 4; ++j) y[j] = res[d][j] * rn * gg[j] * silu_f(zv[j]);
            u32x2 w; w.x = cvt_pk_bf16(y[0], y[1]); w.y = cvt_pk_bf16(y[2], y[3]);
            *(u32x2*)(CD + row * 1024 + 512 + ch) = w;
        }
    }
}

DEVI void dil_seg(const bf16_t* Kc  , const bf16_t* Vc  , int cc, int is0, int W, int tq, int r, int g4, float sc,
                  const bf16x8 (&qf)[2], f32x4 (&o)[4], float& m, float& l) {
    f32x4 st[2];
#pragma unroll
    for (int kt = 0; kt < 2; ++kt) { int ik = is0 + 16 * kt + r; ik = ik < 0 ? 0 : ik; st[kt] = (f32x4){0.f, 0.f, 0.f, 0.f}; const bf16_t* kp = Kc + (size_t)ik * 64;
#pragma unroll
        for (int ks = 0; ks < 2; ++ks) st[kt] = mfma16(*(const bf16x8*)(kp + 32 * ks), qf[ks], st[kt]); }
    float s[8];
#pragma unroll
    for (int j = 0; j < 4; ++j) {
        const int i0 = is0 + 4 * g4 + j, i1 = i0 + 16;
        const int d0 = tq - (16 * i0 + cc), d1 = tq - (16 * i1 + cc);
        s[j] = (i0 >= 0 && d0 >= 0 && d0 <= W) ? st[0][j] * sc : NEG_INF;
        s[4 + j] = (i1 >= 0 && d1 >= 0 && d1 <= W) ? st[1][j] * sc : NEG_INF;
    }
    bf16x8 pf; osm_update<4>(s, m, l, o, pf);
    int ilo = is0 + 4 * g4, ihi = ilo + 16; ilo = ilo < 0 ? 0 : ilo; ihi = ihi < 0 ? 0 : ihi;
#pragma unroll
    for (int d = 0; d < 4; ++d) { const bf16_t* vb = Vc + (size_t)(16 * d + r) * 2048; o[d] = mfma16(ld_vt(vb + ilo, vb + ihi), pf, o[d]); }
}

DEVI void phase_dilated(const Ctx& C) {
    const bf16_t* CQ = WSP(const bf16_t, WS_CQ); const bf16_t* CK = WSP(const bf16_t, WS_CK); const bf16_t* CVT = WSP(const bf16_t, WS_CVT);
    const bf16_t* CZ = WSP(const bf16_t, WS_CZ); bf16_t* CD = WSP(bf16_t, WS_CD);
    const int lane = C.lane, r = lane & 15, g4 = lane >> 4;
    const int gw = C.bid * 8 + C.wid, nw = C.G * 8;
    const float sc = 0.125f * LOG2E;
    for (int task = gw; task < 16 * 8 * 16 * 8; task += nw) {
        const int it = task & 7, c = (task >> 3) & 15, h = (task >> 7) & 7, b = task >> 10;
        const size_t bh = (size_t)(b * 8 + h);
        const int iq = 16 * it + r, tq = 16 * iq + c;
        bf16x8 qf[2];
#pragma unroll
        for (int ks = 0; ks < 2; ++ks) qf[ks] = *(const bf16x8*)(CQ + ((bh * 16 + c) * 128 + iq) * 64 + 32 * ks + 8 * g4);
        const bf16_t* Kbh = CK + bh * 16 * 128 * 64 + 8 * g4;
        const bf16_t* Vbh = CVT + bh * 64 * 2048;
        f32x4 o[4];
#pragma unroll
        for (int d = 0; d < 4; ++d) o[d] = (f32x4){0.f, 0.f, 0.f, 0.f};
        float m = NEG_INF, l = 0.f;
        for (int cc = 0; cc < 16; ++cc) dil_seg(Kbh + (size_t)cc * 128 * 64, Vbh + cc * 128, cc, 16 * it - 16, 128, tq, r, g4, sc, qf, o, m, l);
        for (int k = 0; k < 4; ++k) { const int cc = (c & 3) + 4 * k;
            if (it > 0) dil_seg(Kbh + (size_t)cc * 128 * 64, Vbh + cc * 128, cc, 16 * it - 48, 512, tq, r, g4, sc, qf, o, m, l);
            dil_seg(Kbh + (size_t)cc * 128 * 64, Vbh + cc * 128, cc, 16 * it - 16, 512, tq, r, g4, sc, qf, o, m, l); }
        for (int is0 = 0; is0 <= 16 * it + 15; is0 += 32) dil_seg(Kbh + (size_t)c * 128 * 64, Vbh + c * 128, c, is0, 4096, tq, r, g4, sc, qf, o, m, l);
        l += __shfl_xor(l, 16); l += __shfl_xor(l, 32);
        const float rl = 1.0f / l;
        const size_t row = (size_t)b * 2048 + tq;
#pragma unroll
        for (int d = 0; d < 4; ++d) {
            const int ch = h * 64 + 16 * d + 4 * g4;
            const u32x2 zz = *(const u32x2*)(CZ + row * 512 + ch);
            const float zv[4] = {bflo(zz.x), bfhi(zz.x), bflo(zz.y), bfhi(zz.y)};
            float y[4];
#pragma unroll
            for (int j = 0; j < 4; ++j) y[j] = o[d][j] * rl * silu_f(zv[j]);
            u32x2 w; w.x = cvt_pk_bf16(y[0], y[1]); w.y = cvt_pk_bf16(y[2], y[3]);
            *(u32x2*)(CD + row * 1024 + ch) = w;
        }
    }
}
constexpr int N_STEPS = 17;
constexpr int LDS_BYTES = pg8::STAGE_BYTES + 256;

template <int MODE>
DEVI void run_gemm(const Ctx& C, const EpiMulti<MODE>& E, const bf16_t* A, int lda, const bf16_t* Bt, int ldb, int N, int K, int grp_shift, size_t grp_bbytes) {
    pg8::Gemm g; g.A = A; g.Bt = Bt; g.M = NT; g.N = N; g.K = K; g.lda = lda; g.ldb = ldb; g.grp_shift = grp_shift; g.grp_bbytes = grp_bbytes;
    pg8::StaticOrder S; S.init(NT, N, C.G, C.bid);
    pg8::gemm_phase<EpiMulti<MODE>>(C.lds, g, S, E);
}
template <int MODE> DEVI EpiMulti<MODE> mk_epi(const Ctx& C) { EpiMulti<MODE> E; E.ldc = 0; E.o0 = nullptr; E.o1 = nullptr; E.f0 = nullptr; E.i0 = nullptr; E.i1 = nullptr; E.c0 = nullptr; E.c1 = nullptr; E.ws = C.ws; return E; }

__global__ void __launch_bounds__(512, 2) mega_fwd(Params P) {
    extern __shared__ __attribute__((aligned(16))) unsigned char lds_raw[];
    Ctx C;
    C.in = P.in;
    C.out = P.out; C.ws = P.ws; C.lds = (LAS unsigned char*)lds_raw;
    C.tid = threadIdx.x; C.lane = C.tid & 63; C.wid = __builtin_amdgcn_readfirstlane(C.tid >> 6); C.G = gridDim.x; C.bid = blockIdx.x;
    volatile LAS unsigned* bst = (volatile LAS unsigned*)(C.lds + pg8::STAGE_BYTES);
    if (C.tid < 4) bst[C.tid] = 0u;
    __syncthreads();
    XcdBarrier bar = xcd_barrier_post((unsigned*)(C.ws + WS_CTL), bst);
#ifdef ONLY_PHASE
#define ON(k) ((k) == ONLY_PHASE)
#else
#define ON(k) (P.ph_lo <= (k) && (k) < P.ph_hi)
#endif
#define BAR(k) do { if (ON(k) && (k) + 1 < P.ph_hi) xcd_barrier(bar); } while (0)
    if (ON(0)) phase_prologue(C);
    BAR(0);
    if (ON(1)) { auto E = mk_epi<EM_IN0>(C); E.o0 = WSP(bf16_t, WS_PZ); E.o1 = WSP(bf16_t, WS_U5);
        run_gemm(C, E, WSP(const bf16_t, WS_XN), 1024, WSP(const bf16_t, WS_WIN0), 1024, 2048, 1024, 0, 0); }
    BAR(1);
    if (ON(2)) phase_conv_gates(C);
    BAR(2);
    if (ON(3)) { auto E = mk_epi<EM_PLAIN>(C); E.o0 = WSP(bf16_t, WS_QK); E.ldc = 1024;
        run_gemm(C, E, WSP(const bf16_t, WS_XC), 512, WSP(const bf16_t, WS_WQK), 512, 1024, 512, 0, 0); }
    if (ON(4)) { auto E = mk_epi<EM_PLAIN>(C); E.o0 = WSP(bf16_t, WS_VTMP); E.ldc = 512;
        run_gemm(C, E, WSP(const bf16_t, WS_PZ) + 512, 1536, WSP(const bf16_t, WS_WV), 512, 512, 512, 0, 0); }
    if (ON(5)) { auto E = mk_epi<EM_S5A>(C); E.o0 = WSP(bf16_t, WS_YLOC); E.f0 = WSP(float, WS_XLOC);
        run_gemm(C, E, WSP(const bf16_t, WS_U5), 512, WSP(const bf16_t, WS_BT5A), 512, 768, 512, 2, (size_t)768 * 512 * 2); }
    BAR(5);
    if (ON(6)) phase_mid0(C);
    BAR(6);
    if (ON(7)) phase_mlstm(C);
    if (ON(8)) { auto E = mk_epi<EM_S5B>(C); E.o0 = WSP(bf16_t, WS_G5); E.i0 = WSP(const bf16_t, WS_YLOC); E.i1 = WSP(const bf16_t, WS_U5); E.c0 = C.in[11];
        run_gemm(C, E, WSP(const bf16_t, WS_XST), 256, WSP(const bf16_t, WS_BT5B), 256, 512, 256, 2, (size_t)512 * 256 * 2); }
    BAR(8);
    if (ON(9)) { auto E = mk_epi<EM_GLU>(C); E.o0 = WSP(bf16_t, WS_AB); E.i0 = WSP(const bf16_t, WS_G5); E.i1 = WSP(const bf16_t, WS_PZ); E.c0 = C.in[13];
        run_gemm(C, E, WSP(const bf16_t, WS_G5), 512, WSP(const bf16_t, WS_GLU), 512, 512, 512, 0, 0); }
    BAR(9);
    if (ON(10)) { auto E = mk_epi<EM_OUT>(C); E.o0 = WSP(bf16_t, WS_Y0); E.f0 = WSP(float, WS_SS0);
        run_gemm(C, E, WSP(const bf16_t, WS_AB), 1024, WSP(const bf16_t, WS_WOUT0), 1024, 1024, 1024, 0, 0); }
    BAR(10);
    if (ON(11)) rows_pass(C, 1);
    BAR(11);
    if (ON(12)) { auto E = mk_epi<EM_IN1>(C); E.c0 = WSP(const float, WS_ROPE_C); E.c1 = WSP(const float, WS_ROPE_S);
        run_gemm(C, E, WSP(const bf16_t, WS_XN1), 1024, WSP(const bf16_t, WS_WIN1), 1024, 4096, 1024, 0, 0); }
    BAR(12);
    if (ON(13)) { transpose_tok(C, WSP(const bf16_t, WS_CVTMP), WSP(bf16_t, WS_CVT), 1); transpose_tok(C, WSP(const bf16_t, WS_DVTMP), WSP(bf16_t, WS_DVT), 0); }
    BAR(13);
    if (ON(14)) { phase_diff(C); phase_dilated(C); }
    BAR(14);
    if (ON(15)) { auto E = mk_epi<EM_OUT>(C); E.o0 = WSP(bf16_t, WS_Y1); E.f0 = WSP(float, WS_SS1);
        run_gemm(C, E, WSP(const bf16_t, WS_CD), 1024, WSP(const bf16_t, WS_WOUT1), 1024, 1024, 1024, 0, 0); }
    BAR(15);
    if (ON(16)) rows_pass(C, 2);
#undef ON
#undef BAR
}

#ifndef MK_SPLIT
#define MK_SPLIT 0
#endif
extern "C" void kernel_launch(void* const* d_in, const int* in_sizes, int n_in, void* d_out, int out_size, void* d_ws, size_t ws_size, hipStream_t stream) {
    static int grid = 0;
    if (grid == 0) {
        int dev = 0, cus = 0, per_cu = 0;
        (void)hipGetDevice(&dev);
        (void)hipDeviceGetAttribute(&cus, hipDeviceAttributeMultiprocessorCount, dev);
        (void)hipFuncSetAttribute((const void*)mega_fwd, hipFuncAttributeMaxDynamicSharedMemorySize, LDS_BYTES);
        (void)hipOccupancyMaxActiveBlocksPerMultiprocessor(&per_cu, (const void*)mega_fwd, 512, LDS_BYTES);
        if (per_cu < 1) per_cu = 1;
        if (per_cu > 1) per_cu = 1;
        grid = cus * per_cu;
        if (n_in != 31 || ws_size < WS_END) { fprintf(stderr, "kernel_launch: unexpected n_in %d or ws_size %zu (< %zu)\n", n_in, ws_size, (size_t)WS_END); }
        (void)hipGetLastError();
    }
    (void)hipMemsetAsync((char*)d_ws + WS_CTL, 0, 16384, stream);
    Params p{};
    for (int i = 0; i < 31; ++i) p.in[i] = (const float*)d_in[i];
    p.out = (float*)d_out; p.ws = (unsigned char*)d_ws;
#if MK_SPLIT
    for (int st = 0; st < N_STEPS; ++st) {
        p.ph_lo = st; p.ph_hi = st + 1;
        hipLaunchKernelGGL(mega_fwd, dim3(grid), dim3(512), LDS_BYTES, stream, p);
    }
#else
    p.ph_lo = 0; p.ph_hi = N_STEPS;
    void* args[] = {&p};
    hipError_t e = hipLaunchCooperativeKernel((const void*)mega_fwd, dim3(grid), dim3(512), args, LDS_BYTES, stream);
    if (e != hipSuccess) fprintf(stderr, "cooperative launch failed: %s (grid %d)\n", hipGetErrorString(e), grid);
#endif
}
```

```cpp
#include <hip/hip_runtime.h>
#include <stdint.h>
#include <stdio.h>

typedef unsigned short bf16_t;
typedef short bf16x8 __attribute__((ext_vector_type(8)));
typedef short bf16x4 __attribute__((ext_vector_type(4)));
typedef float f32x4 __attribute__((ext_vector_type(4)));
typedef float f32x2 __attribute__((ext_vector_type(2)));
typedef unsigned u32x4 __attribute__((ext_vector_type(4)));
typedef unsigned u32x2 __attribute__((ext_vector_type(2)));
#define LAS __attribute__((address_space(3)))
#define DEVI __device__ __forceinline__

constexpr int NB = 16, SEQ = 2048, DM = 1024, NT = NB * SEQ;
constexpr float LOG2E = 1.4426950408889634f;
constexpr size_t MiB = 1024ull * 1024ull;

constexpr size_t WS_CTL = 0;
constexpr size_t WS_LAM = 64 * 1024;
constexpr size_t WS_ROPE_C = 128 * 1024;
constexpr size_t WS_ROPE_S = 384 * 1024;
constexpr size_t WS_GF = 640 * 1024;
constexpr size_t WS_A32 = 704 * 1024;
constexpr size_t WS_WIN0 = 1 * MiB;
constexpr size_t WS_WOUT0 = 5 * MiB;
constexpr size_t WS_WIN1 = 7 * MiB;
constexpr size_t WS_WOUT1 = 15 * MiB;
constexpr size_t WS_GLU = 17 * MiB;
constexpr size_t WS_WQK = 17 * MiB + 512 * 1024;
constexpr size_t WS_WV = 18 * MiB + 512 * 1024;
constexpr size_t WS_BT5A = 19 * MiB;
constexpr size_t WS_BT5B = 43 * MiB;
constexpr size_t WS_R1 = 52 * MiB;
constexpr size_t WS_R2 = 116 * MiB;
constexpr size_t WS_R3 = 372 * MiB;
constexpr size_t WS_R4 = 436 * MiB;
constexpr size_t WS_R5 = 500 * MiB;
constexpr size_t WS_END = 506 * MiB;
constexpr size_t WS_PZ = WS_R2;
constexpr size_t WS_U5 = WS_R2 + 96 * MiB;
constexpr size_t WS_XC = WS_R2 + 128 * MiB;
constexpr size_t WS_VTMP = WS_R2 + 160 * MiB;
constexpr size_t WS_VT0 = WS_R2 + 192 * MiB;
constexpr size_t WS_YLOC = WS_R2 + 224 * MiB;
constexpr size_t WS_CQ = WS_R2;
constexpr size_t WS_CK = WS_R2 + 32 * MiB;
constexpr size_t WS_CVTMP = WS_R2 + 64 * MiB;
constexpr size_t WS_CZ = WS_R2 + 96 * MiB;
constexpr size_t WS_DQ = WS_R2 + 128 * MiB;
constexpr size_t WS_DK = WS_R2 + 160 * MiB;
constexpr size_t WS_DVTMP = WS_R2 + 192 * MiB;
constexpr size_t WS_DZ = WS_R2 + 224 * MiB;
constexpr size_t WS_Y1 = WS_R2;
constexpr size_t WS_XN = WS_R1;
constexpr size_t WS_QK = WS_R1;
constexpr size_t WS_Y0 = WS_R1;
constexpr size_t WS_AB = WS_R3;
constexpr size_t WS_XN1 = WS_R3;
constexpr size_t WS_CD = WS_R3;
constexpr size_t WS_XLOC = WS_R4;
constexpr size_t WS_XST = WS_R4 + 16 * MiB;
constexpr size_t WS_G5 = WS_R4 + 32 * MiB;
constexpr size_t WS_CVT = WS_R4;
constexpr size_t WS_DVT = WS_R4 + 32 * MiB;
constexpr size_t WS_LI = WS_R5;
constexpr size_t WS_LF = WS_R5 + 512 * 1024;
constexpr size_t WS_BC = WS_R5 + 1024 * 1024;
constexpr size_t WS_DS = WS_R5 + 1536 * 1024;
constexpr size_t WS_SS0 = WS_R5 + 2 * MiB;
constexpr size_t WS_SS1 = WS_R5 + 4 * MiB;

DEVI unsigned cvt_pk_bf16(float lo, float hi) { unsigned r; asm("v_cvt_pk_bf16_f32 %0, %1, %2" : "=v"(r) : "v"(lo), "v"(hi)); return r; }
DEVI float bf2f(unsigned v16) { return __uint_as_float(v16 << 16); }
DEVI float bflo(unsigned w) { return __uint_as_float(w << 16); }
DEVI float bfhi(unsigned w) { return __uint_as_float(w & 0xffff0000u); }
DEVI bf16_t f2bf(float f) { return (bf16_t)(cvt_pk_bf16(f, 0.f) & 0xffffu); }
DEVI float wave_sum(float v) { v += __shfl_xor(v, 32); v += __shfl_xor(v, 16); v += __shfl_xor(v, 8); v += __shfl_xor(v, 4); v += __shfl_xor(v, 2); v += __shfl_xor(v, 1); return v; }
DEVI float fast_exp2(float x) { return __builtin_amdgcn_exp2f(x); }
DEVI float silu_f(float x) { return x / (1.0f + __expf(-x)); }
DEVI float sigmoid_f(float x) { return 1.0f / (1.0f + __expf(-x)); }
DEVI float gelu_tanh_f(float x) { const float u = 0.7978845608028654f * (x + 0.044715f * x * x * x); const float e = __expf(2.0f * u); const float th = 1.0f - 2.0f / (e + 1.0f); return 0.5f * x * (1.0f + th); }
DEVI f32x4 mfma16(bf16x8 a, bf16x8 b, f32x4 c) { return __builtin_amdgcn_mfma_f32_16x16x32_bf16(a, b, c, 0, 0, 0); }
namespace pg8 {
constexpr int BM = 256, BK = 64, HALF = 128, HTB = HALF * BK * 2  , STAGE_BYTES = 8 * HTB, NXCD = 8, WGM = 8;

__host__ __device__ __forceinline__ int lds_byte(int r, int c) { const int st = (r >> 4) * 2 + (c >> 5), rr = r & 15, cc = c & 31, ob = rr * 64 + cc * 2; return st * 1024 + (ob ^ (((ob >> 9) & 1) << 5)); }
__host__ __device__ __forceinline__ void stage_rc(int b, int& R, int& C) { const int st = b / 1024, sb = b % 1024, swz = sb ^ (((sb >> 9) & 1) << 5); R = (st >> 1) * 16 + swz / 64; C = (st & 1) * 32 + (swz % 64) / 2; }
__host__ __device__ __forceinline__ int perm32(int rho) { const int n = rho >> 4, i = rho & 15; return 8 * (i >> 2) + 4 * n + (i & 3); }

struct Unit { int pm, pn; };
struct Gemm { const bf16_t* A; const bf16_t* Bt; int M, N, K, lda, ldb, grp_shift; size_t grp_bbytes; };

struct StaticOrder {
    int nM, nN, nwg, G, c;
    __host__ __device__ void init(int M, int N, int G_, int c_) { nM = M / BM; nN = N / BM; nwg = nM * nN; G = G_; c = c_; }
    __host__ __device__ bool next(int i, Unit& u) const {
        const long L = (long)i * G + c; if (L >= nwg) return false;
        int wgid = (int)L; { const int q = nwg / NXCD, r = nwg % NXCD, xcd = wgid % NXCD, off = wgid / NXCD; wgid = (xcd < r ? xcd * (q + 1) : r * (q + 1) + (xcd - r) * q) + off; }
        const int nig = WGM * nN, gid = wgid / nig, fm = gid * WGM, gsz = (nM - fm) < WGM ? (nM - fm) : WGM;
        u.pm = fm + ((wgid % nig) % gsz); u.pn = (wgid % nig) / gsz; return true;
    }
};

template <class Epi>
__device__ __forceinline__ void gemm_phase(LAS unsigned char* lds, const Gemm g, const StaticOrder& S, const Epi& E) {
    const int tid = threadIdx.x, wid = __builtin_amdgcn_readfirstlane(tid >> 6), lane = tid & 63, wr = wid >> 2, wc = wid & 3, fr = lane & 15, fq = lane >> 4;
    int nt = g.K / BK; asm volatile("" : "+s"(nt));
    unsigned voffA[2], voffB[2];
#pragma unroll
    for (int i = 0; i < 2; ++i) { int R, C; stage_rc(tid * 16 + i * 8192, R, C); const int Rb = (R & ~31) + perm32(R & 31);
        voffA[i] = (unsigned)(R * g.lda + C) * 2u; voffB[i] = (unsigned)(Rb * g.ldb + C) * 2u; }
    const size_t kstep = (size_t)(BK * 2);
    const size_t hstepA = (size_t)HALF * g.lda * 2, hstepB = (size_t)HALF * g.ldb * 2;
    const size_t tstepA = 2 * hstepA, tstepB = 2 * hstepB;
    const unsigned ldsw = (unsigned)wid * 1024u;
    const int aoff = lds_byte(wr * 64 + fr, fq * 8), boff = lds_byte(wc * 32 + fr, fq * 8);
#define PG8_SA(b, h) (((b) * 2 + (h)) * HTB)
#define PG8_SB(b, h) ((4 + (b) * 2 + (h)) * HTB)
#define PG8_STAGE(bufoff, gbase, voff) do { _Pragma("unroll") for (int _i = 0; _i < 2; ++_i) \
        __builtin_amdgcn_global_load_lds((const unsigned*)((const char*)(gbase) + (voff)[_i]), (LAS unsigned*)(lds + (bufoff) + ldsw + _i * 8192), 16, 0, 0); } while (0)
#define PG8_LDA(dst, b, h) do { _Pragma("unroll") for (int m = 0; m < 4; ++m) _Pragma("unroll") for (int k = 0; k < 2; ++k) dst[m][k] = *(const LAS bf16x8*)(lds + PG8_SA(b, h) + aoff + m * 2048 + k * 1024); } while (0)
#define PG8_LDB(dst, b, h) do { _Pragma("unroll") for (int n = 0; n < 2; ++n) _Pragma("unroll") for (int k = 0; k < 2; ++k) dst[n][k] = *(const LAS bf16x8*)(lds + PG8_SB(b, h) + boff + n * 2048 + k * 1024); } while (0)
#define PG8_MMA(ai, bj, At, Bt) do { __builtin_amdgcn_s_setprio(1); _Pragma("unroll") for (int m = 0; m < 4; ++m) _Pragma("unroll") for (int n = 0; n < 2; ++n) _Pragma("unroll") for (int k = 0; k < 2; ++k) \
        acc[ai][bj][m][n] = __builtin_amdgcn_mfma_f32_16x16x32_bf16(Bt[n][k], At[m][k], acc[ai][bj][m][n], 0, 0, 0); __builtin_amdgcn_s_setprio(0); } while (0)
#define PG8_WAIT_V(n) asm volatile("s_waitcnt vmcnt(" #n ")" ::: "memory")
#define PG8_WAIT_L(n) asm volatile("s_waitcnt lgkmcnt(" #n ")" ::: "memory")
#define PG8_BAR __builtin_amdgcn_s_barrier()
#define PG8_SCHED __builtin_amdgcn_sched_barrier(0)
#define PG8_BBASE(u) ((const char*)g.Bt + (size_t)((u).pm >> g.grp_shift) * g.grp_bbytes + (size_t)(u).pn * tstepB)
    Unit cur, nxt; int ui = 0;
    if (!S.next(0, cur)) return;
    f32x4 acc[2][2][4][2];
#pragma unroll
    for (int a = 0; a < 2; ++a)
#pragma unroll
        for (int b = 0; b < 2; ++b)
#pragma unroll
            for (int m = 0; m < 4; ++m)
#pragma unroll
                for (int n = 0; n < 2; ++n) acc[a][b][m][n] = (f32x4){0.f, 0.f, 0.f, 0.f};
    bf16x8 At[4][2], B0[2][2], B1[2][2];
    const char* cA = (const char*)g.A + (size_t)cur.pm * tstepA; const char* cB = PG8_BBASE(cur);
    PG8_STAGE(PG8_SB(0, 0), cB, voffB); PG8_STAGE(PG8_SA(0, 0), cA, voffA); PG8_STAGE(PG8_SB(0, 1), cB + hstepB, voffB); PG8_STAGE(PG8_SA(0, 1), cA + hstepA, voffA);
    if (wr == 1) PG8_BAR;
    PG8_WAIT_V(4); PG8_BAR;
    PG8_STAGE(PG8_SB(1, 0), cB + kstep, voffB); PG8_STAGE(PG8_SA(1, 0), cA + kstep, voffA); PG8_STAGE(PG8_SB(1, 1), cB + hstepB + kstep, voffB);
    PG8_WAIT_V(6); PG8_BAR;
    for (;;) {
        const bool has_next = S.next(ui + 1, nxt);
        const char* nA = has_next ? (const char*)g.A + (size_t)nxt.pm * tstepA : cA; const char* nB = has_next ? PG8_BBASE(nxt) : cB;
        for (int t = 0; t < nt; t += 2) {
            const bool last = (t == nt - 2);
            const char* a1 = cA + (size_t)(t + 1) * kstep;
            const char* a2 = last ? nA : cA + (size_t)(t + 2) * kstep; const char* b2 = last ? nB : cB + (size_t)(t + 2) * kstep;
            const char* a3 = a2 + kstep; const char* b3 = b2 + kstep;
            PG8_LDB(B0, 0, 0); PG8_SCHED; PG8_LDA(At, 0, 0); PG8_STAGE(PG8_SA(1, 1), a1 + hstepA, voffA);
            PG8_WAIT_L(8); PG8_BAR; PG8_WAIT_L(0); PG8_MMA(0, 0, At, B0); PG8_BAR; PG8_SCHED;
            PG8_LDB(B1, 0, 1); PG8_STAGE(PG8_SB(0, 0), b2, voffB);
            PG8_BAR; PG8_WAIT_L(0); PG8_MMA(0, 1, At, B1); PG8_BAR;
            PG8_LDA(At, 0, 1); PG8_STAGE(PG8_SA(0, 0), a2, voffA);
            PG8_BAR; PG8_WAIT_L(0); PG8_MMA(1, 0, At, B0); PG8_BAR; PG8_SCHED;
            PG8_STAGE(PG8_SB(0, 1), b2 + hstepB, voffB);
            PG8_WAIT_V(6); PG8_BAR; PG8_MMA(1, 1, At, B1); PG8_BAR;
            PG8_LDB(B0, 1, 0); PG8_SCHED; PG8_LDA(At, 1, 0); PG8_STAGE(PG8_SA(0, 1), a2 + hstepA, voffA);
            PG8_WAIT_L(8); PG8_BAR; PG8_WAIT_L(0); PG8_MMA(0, 0, At, B0); PG8_BAR; PG8_SCHED;
            PG8_LDB(B1, 1, 1); PG8_STAGE(PG8_SB(1, 0), b3, voffB);
            PG8_BAR; PG8_WAIT_L(0); PG8_MMA(0, 1, At, B1); PG8_BAR;
            PG8_LDA(At, 1, 1); PG8_STAGE(PG8_SA(1, 0), a3, voffA);
            PG8_BAR; PG8_WAIT_L(0); PG8_MMA(1, 0, At, B0); PG8_BAR; PG8_SCHED;
            PG8_STAGE(PG8_SB(1, 1), b3 + hstepB, voffB);
            PG8_WAIT_V(6); PG8_BAR; PG8_MMA(1, 1, At, B1); PG8_BAR;
        }
        E(acc, cur, wr, wc, fr, fq);
        if (!has_next) break;
#pragma unroll
        for (int a = 0; a < 2; ++a)
#pragma unroll
            for (int b = 0; b < 2; ++b)
#pragma unroll
                for (int m = 0; m < 4; ++m)
#pragma unroll
                    for (int n = 0; n < 2; ++n) acc[a][b][m][n] = (f32x4){0.f, 0.f, 0.f, 0.f};
        cur = nxt; cA = nA; cB = nB; ++ui;
    }
    PG8_WAIT_V(0);
    if (wr == 0) PG8_BAR;
    PG8_BAR;
#undef PG8_SA
#undef PG8_SB
#undef PG8_STAGE
#undef PG8_LDA
#undef PG8_LDB
#undef PG8_MMA
#undef PG8_WAIT_V
#undef PG8_WAIT_L
#undef PG8_BAR
#undef PG8_SCHED
#undef PG8_BBASE
}
}
#define XB_TMO      128
#define XB_XCNT(j)  (256  + 64 * (j))
#define XB_XSUB(j)  (1280 + 64 * (j))
#define XB_XGEN(j)  (2304 + 64 * (j))
#define XB_TOP      3328
#define XB_TOPGEN   3392
#define XCD_BAR_WORDS 3456
#define XB_SPIN_CAP (1u << 22)
__device__ __forceinline__ unsigned xb_ld(unsigned* p)              { return __hip_atomic_load(p, __ATOMIC_RELAXED, __HIP_MEMORY_SCOPE_AGENT); }
__device__ __forceinline__ unsigned xb_add(unsigned* p, unsigned v) { return __hip_atomic_fetch_add(p, v, __ATOMIC_RELAXED, __HIP_MEMORY_SCOPE_AGENT); }
__device__ __forceinline__ unsigned xb_xcc_id() { return (unsigned)__builtin_amdgcn_s_getreg((3 << 11) | 20) & 0xFu; }
#define XB_SPIN(cond, bar) do { unsigned _sp = 0; while (cond) { __builtin_amdgcn_s_sleep(1); \
    if ((++_sp & 255u) == 0u) { if (xb_ld(&(bar)[XB_TMO])) break; if (_sp > XB_SPIN_CAP) { atomicAdd(&(bar)[XB_TMO], 1u); break; } } } } while (0)
struct XcdBarrier { unsigned* bar; unsigned x; volatile LAS unsigned* st; };
__device__ __forceinline__ XcdBarrier xcd_barrier_post(unsigned* bar, volatile LAS unsigned* st) {
    XcdBarrier b; b.bar = bar; b.x = xb_xcc_id(); b.st = st;
    if (threadIdx.x == 0) (void)xb_add(&bar[XB_XCNT(b.x)], 1u);
    return b;
}
__device__ __forceinline__ void xcd_barrier_complete(unsigned* bar, unsigned x, unsigned& nloc, unsigned& nx) {
    const unsigned G = gridDim.x * gridDim.y * gridDim.z;
    unsigned sum, cnt, mine, sp = 0u;
    for (;;) {
        sum = 0u; cnt = 0u; mine = 0u;
#pragma unroll
        for (unsigned j = 0; j < 16; ++j) { const unsigned c = xb_ld(&bar[XB_XCNT(j)]); sum += c; cnt += (c > 0u) ? 1u : 0u; mine = (j == x) ? c : mine; }
        if (sum == G) break;
        __builtin_amdgcn_s_sleep(1);
        if ((++sp & 255u) == 0u) { if (xb_ld(&bar[XB_TMO])) break; if (sp > XB_SPIN_CAP) { atomicAdd(&bar[XB_TMO], 1u); break; } }
    }
    nloc = mine > 0u ? mine : 1u; nx = cnt > 0u ? cnt : 1u;
}
__device__ __forceinline__ void xcd_barrier(const XcdBarrier& b) {
    asm volatile("s_waitcnt vmcnt(0)" ::: "memory");
    __syncthreads();
    if (threadIdx.x == 0) {
        unsigned* bar = b.bar;
        __builtin_amdgcn_s_waitcnt(0);
        unsigned nloc = b.st[0], nx = b.st[1];
        if (nloc == 0u) { xcd_barrier_complete(bar, b.x, nloc, nx); b.st[0] = nloc; b.st[1] = nx; }
        const unsigned old = xb_add(&bar[XB_XSUB(b.x)], 1u);
        const unsigned gen = old / nloc;
        if (old + 1u == (gen + 1u) * nloc) {
            __builtin_amdgcn_fence(__ATOMIC_RELEASE, "agent");
            asm volatile("s_waitcnt vmcnt(0)" ::: "memory");
            const unsigned og = xb_add(&bar[XB_TOP], 1u);
            const unsigned tg = og / nx;
            if (og + 1u == (tg + 1u) * nx) xb_add(&bar[XB_TOPGEN], 1u);
            else XB_SPIN(xb_ld(&bar[XB_TOPGEN]) == tg, bar);
            __builtin_amdgcn_fence(__ATOMIC_ACQUIRE, "agent");
            xb_add(&bar[XB_XGEN(b.x)], 1u);
            asm volatile("s_waitcnt vmcnt(0)" ::: "memory");
        } else {
            XB_SPIN(xb_ld(&bar[XB_XGEN(b.x)]) == gen, bar);
            __builtin_amdgcn_fence(__ATOMIC_ACQUIRE, "agent");
            asm volatile("s_waitcnt vmcnt(0)" ::: "memory");
        }
    }
    __syncthreads();
}

enum { EM_IN0 = 0, EM_PLAIN = 1, EM_S5A = 2, EM_S5B = 3, EM_GLU = 4, EM_OUT = 5, EM_IN1 = 6 };
template <int mode> struct EpiMulti {
    int ldc;
    bf16_t* o0; bf16_t* o1; float* f0;
    const bf16_t* i0; const bf16_t* i1; const float* c0; const float* c1;
    unsigned char* ws;
    __device__ __forceinline__ void operator()(const f32x4 (&acc)[2][2][4][2], const pg8::Unit& u, int wr, int wc, int fr, int fq) const {
        const int rowb = u.pm * 256 + wr * 64 + fr;
        const int colb = u.pn * 256 + wc * 32 + 8 * fq;
#pragma unroll
        for (int ai = 0; ai < 2; ++ai)
#pragma unroll
            for (int m = 0; m < 4; ++m) {
                const int row = rowb + ai * 128 + m * 16;
                float ssq = 0.f;
#pragma unroll
                for (int bj = 0; bj < 2; ++bj) {
                    const int c = colb + bj * 128;
                    f32x4 v0 = acc[ai][bj][m][0], v1 = acc[ai][bj][m][1];
                    if constexpr (mode == EM_PLAIN) {
                        u32x4 w; w.x = cvt_pk_bf16(v0[0], v0[1]); w.y = cvt_pk_bf16(v0[2], v0[3]); w.z = cvt_pk_bf16(v1[0], v1[1]); w.w = cvt_pk_bf16(v1[2], v1[3]);
                        *(u32x4*)(o0 + (size_t)row * ldc + c) = w;
                    } else if constexpr (mode == EM_IN0) {
                        u32x4 w; w.x = cvt_pk_bf16(v0[0], v0[1]); w.y = cvt_pk_bf16(v0[2], v0[3]); w.z = cvt_pk_bf16(v1[0], v1[1]); w.w = cvt_pk_bf16(v1[2], v1[3]);
                        if (c < 512) {
                            const int g = c >> 4, b = row >> 11, l = row & 2047;
                            *(u32x4*)(o1 + ((size_t)((g * 16 + b) * 2048 + l)) * 16 + (c & 15)) = w;
                        } else {
                            *(u32x4*)(o0 + (size_t)row * 1536 + (c - 512)) = w;
                        }
                    } else if constexpr (mode == EM_S5A) {
                        if (c < 512) {
                            u32x4 w; w.x = cvt_pk_bf16(v0[0], v0[1]); w.y = cvt_pk_bf16(v0[2], v0[3]); w.z = cvt_pk_bf16(v1[0], v1[1]); w.w = cvt_pk_bf16(v1[2], v1[3]);
                            *(u32x4*)(o0 + (size_t)row * 512 + c) = w;
                        } else if (c < 640) {
                            float* p = f0 + (size_t)row * 128 + (c - 512);
                            *(f32x4*)p = v0; *(f32x4*)(p + 4) = v1;
                        }
                    } else if constexpr (mode == EM_S5B) {
                        const size_t idx = (size_t)row * 512 + c;
                        const u32x4 yl = *(const u32x4*)(i0 + idx), uu = *(const u32x4*)(i1 + idx);
                        const int g = row >> 10, b = (row >> 6) & 15, ck = row & 63, t = c >> 4, ch = c & 15;
                        const f32x4 d0 = *(const f32x4*)(c0 + g * 16 + ch), d1 = *(const f32x4*)(c0 + g * 16 + ch + 4);
                        float y[8];
                        y[0] = v0[0] + bflo(yl.x) + d0[0] * bflo(uu.x); y[1] = v0[1] + bfhi(yl.x) + d0[1] * bfhi(uu.x);
                        y[2] = v0[2] + bflo(yl.y) + d0[2] * bflo(uu.y); y[3] = v0[3] + bfhi(yl.y) + d0[3] * bfhi(uu.y);
                        y[4] = v1[0] + bflo(yl.z) + d1[0] * bflo(uu.z); y[5] = v1[1] + bfhi(yl.z) + d1[1] * bfhi(uu.z);
                        y[6] = v1[2] + bflo(yl.w) + d1[2] * bflo(uu.w); y[7] = v1[3] + bfhi(yl.w) + d1[3] * bfhi(uu.w);
#pragma unroll
                        for (int j = 0; j < 8; ++j) y[j] = gelu_tanh_f(y[j]);
                        u32x4 w; w.x = cvt_pk_bf16(y[0], y[1]); w.y = cvt_pk_bf16(y[2], y[3]); w.z = cvt_pk_bf16(y[4], y[5]); w.w = cvt_pk_bf16(y[6], y[7]);
                        const size_t tok = (size_t)b * 2048 + ck * 32 + t;
                        *(u32x4*)(o0 + tok * 512 + g * 16 + ch) = w;
                        asm volatile("" ::: "memory");
                    } else if constexpr (mode == EM_GLU) {
                        const u32x4 gg = *(const u32x4*)(i0 + (size_t)row * 512 + c), zz = *(const u32x4*)(i1 + (size_t)row * 1536 + c);
                        const f32x4 b0 = *(const f32x4*)(c0 + c), b1 = *(const f32x4*)(c0 + c + 4);
                        float y[8];
                        y[0] = bflo(gg.x) * sigmoid_f(v0[0] + b0[0]) * silu_f(bflo(zz.x)); y[1] = bfhi(gg.x) * sigmoid_f(v0[1] + b0[1]) * silu_f(bfhi(zz.x));
                        y[2] = bflo(gg.y) * sigmoid_f(v0[2] + b0[2]) * silu_f(bflo(zz.y)); y[3] = bfhi(gg.y) * sigmoid_f(v0[3] + b0[3]) * silu_f(bfhi(zz.y));
                        y[4] = bflo(gg.z) * sigmoid_f(v1[0] + b1[0]) * silu_f(bflo(zz.z)); y[5] = bfhi(gg.z) * sigmoid_f(v1[1] + b1[1]) * silu_f(bfhi(zz.z));
                        y[6] = bflo(gg.w) * sigmoid_f(v1[2] + b1[2]) * silu_f(bflo(zz.w)); y[7] = bfhi(gg.w) * sigmoid_f(v1[3] + b1[3]) * silu_f(bfhi(zz.w));
                        u32x4 w; w.x = cvt_pk_bf16(y[0], y[1]); w.y = cvt_pk_bf16(y[2], y[3]); w.z = cvt_pk_bf16(y[4], y[5]); w.w = cvt_pk_bf16(y[6], y[7]);
                        *(u32x4*)(o0 + (size_t)row * 1024 + c) = w;
                    } else if constexpr (mode == EM_OUT) {
                        u32x4 w; w.x = cvt_pk_bf16(v0[0], v0[1]); w.y = cvt_pk_bf16(v0[2], v0[3]); w.z = cvt_pk_bf16(v1[0], v1[1]); w.w = cvt_pk_bf16(v1[2], v1[3]);
                        *(u32x4*)(o0 + (size_t)row * 1024 + c) = w;
                        ssq += (v0[0] * v0[0] + v0[1] * v0[1]) + (v0[2] * v0[2] + v0[3] * v0[3]) + (v1[0] * v1[0] + v1[1] * v1[1]) + (v1[2] * v1[2] + v1[3] * v1[3]);
                    } else {
                        const int blk = c >> 9, cc = c & 511, b = row >> 11, l = row & 2047;
                        if (blk == 0 || blk == 1 || blk == 4 || blk == 5) {
                            const int hh = cc >> 6, p = cc & 63, j0 = (p >> 3) * 4;
                            const f32x4 cs = *(const f32x4*)(c0 + l * 32 + j0), sn = *(const f32x4*)(c1 + l * 32 + j0);
                            f32x4 r0, r1;
#pragma unroll
                            for (int e = 0; e < 4; ++e) { r0[e] = v0[e] * cs[e] - v1[e] * sn[e]; r1[e] = v1[e] * cs[e] + v0[e] * sn[e]; }
                            u32x4 w; w.x = cvt_pk_bf16(r0[0], r0[1]); w.y = cvt_pk_bf16(r0[2], r0[3]); w.z = cvt_pk_bf16(r1[0], r1[1]); w.w = cvt_pk_bf16(r1[2], r1[3]);
                            bf16_t* base = (bf16_t*)(ws + (blk == 0 ? WS_CQ : blk == 1 ? WS_CK : blk == 4 ? WS_DQ : WS_DK));
                            size_t off;
                            if (blk < 2) off = ((size_t)(((b * 8 + hh) * 16 + (l & 15)) * 128 + (l >> 4))) * 64 + p;
                            else off = ((size_t)((b * 8 + hh) * 2048 + l)) * 64 + p;
                            *(u32x4*)(base + off) = w;
                        } else {
                            u32x4 w; w.x = cvt_pk_bf16(v0[0], v0[1]); w.y = cvt_pk_bf16(v0[2], v0[3]); w.z = cvt_pk_bf16(v1[0], v1[1]); w.w = cvt_pk_bf16(v1[2], v1[3]);
                            bf16_t* base = (bf16_t*)(ws + (blk == 2 ? WS_CVTMP : blk == 3 ? WS_CZ : blk == 6 ? WS_DVTMP : WS_DZ));
                            *(u32x4*)(base + (size_t)row * 512 + cc) = w;
                        }
                    }
                }
                if constexpr (mode == EM_OUT) {
                    ssq += __shfl_xor(ssq, 16); ssq += __shfl_xor(ssq, 32);
                    if (fq == 0) f0[(size_t)row * 16 + u.pn * 4 + wc] = ssq;
                }
                asm volatile("" ::: "memory");
            }
    }
};
struct Params { const float* in[31]; float* out; unsigned char* ws; int ph_lo, ph_hi; int rep_mask, pad; };
struct Ctx {
    const float* const* in; float* out; unsigned char* ws;
    LAS unsigned char* lds; int tid, lane, wid, G, bid;
};
#define WSP(T, off) ((T*)(C.ws + (off)))

DEVI void rows_pass(const Ctx& C, int mode) {
    const float* x = C.in[0];
    const float* pre = C.in[1]; const float* post = C.in[2];
    const bf16_t* Y0 = WSP(const bf16_t, WS_Y0); const bf16_t* Y1 = WSP(const bf16_t, WS_Y1);
    const float* SS0 = WSP(const float, WS_SS0); const float* SS1 = WSP(const float, WS_SS1);
    bf16_t* XN = (mode == 0) ? WSP(bf16_t, WS_XN) : WSP(bf16_t, WS_XN1);
    const int gw = C.bid * 8 + C.wid, nw = C.G * 8, lane = C.lane;
    for (int r = gw; r < NT; r += nw) {
        f32x4 v[4];
#pragma unroll
        for (int i = 0; i < 4; ++i) v[i] = *(const f32x4*)(x + (size_t)r * 1024 + i * 256 + lane * 4);
        if (mode >= 1) {
            float s0 = (lane < 16) ? SS0[(size_t)r * 16 + lane] : 0.f; s0 = wave_sum(s0);
            const float rs0 = rsqrtf(s0 * (1.0f / 1024.0f) + 1e-6f);
#pragma unroll
            for (int i = 0; i < 4; ++i) {
                const u32x2 y = *(const u32x2*)(Y0 + (size_t)r * 1024 + i * 256 + lane * 4);
                const f32x4 gp = *(const f32x4*)(post + i * 256 + lane * 4);
                v[i][0] += bflo(y.x) * rs0 * gp[0]; v[i][1] += bfhi(y.x) * rs0 * gp[1]; v[i][2] += bflo(y.y) * rs0 * gp[2]; v[i][3] += bfhi(y.y) * rs0 * gp[3];
            }
        }
        if (mode == 2) {
            float s1 = (lane < 16) ? SS1[(size_t)r * 16 + lane] : 0.f; s1 = wave_sum(s1);
            const float rs1 = rsqrtf(s1 * (1.0f / 1024.0f) + 1e-6f);
#pragma unroll
            for (int i = 0; i < 4; ++i) {
                const u32x2 y = *(const u32x2*)(Y1 + (size_t)r * 1024 + i * 256 + lane * 4);
                const f32x4 gp = *(const f32x4*)(post + 1024 + i * 256 + lane * 4);
                f32x4 o = v[i];
                o[0] += bflo(y.x) * rs1 * gp[0]; o[1] += bfhi(y.x) * rs1 * gp[1]; o[2] += bflo(y.y) * rs1 * gp[2]; o[3] += bfhi(y.y) * rs1 * gp[3];
                *(f32x4*)(C.out + (size_t)r * 1024 + i * 256 + lane * 4) = o;
            }
        } else {
            float ss = 0.f;
#pragma unroll
            for (int i = 0; i < 4; ++i) ss += (v[i][0] * v[i][0] + v[i][1] * v[i][1]) + (v[i][2] * v[i][2] + v[i][3] * v[i][3]);
            ss = wave_sum(ss);
            const float rs = rsqrtf(ss * (1.0f / 1024.0f) + 1e-6f);
            const float* gpre = pre + (mode == 0 ? 0 : 1024);
#pragma unroll
            for (int i = 0; i < 4; ++i) {
                const f32x4 gp = *(const f32x4*)(gpre + i * 256 + lane * 4);
                u32x2 w; w.x = cvt_pk_bf16(v[i][0] * rs * gp[0], v[i][1] * rs * gp[1]); w.y = cvt_pk_bf16(v[i][2] * rs * gp[2], v[i][3] * rs * gp[3]);
                *(u32x2*)(XN + (size_t)r * 1024 + i * 256 + lane * 4) = w;
            }
        }
    }
}

DEVI int rope_dim(int p) { return ((p & 7) < 4) ? (4 * (p >> 3) + (p & 7)) : (32 + 4 * (p >> 3) + ((p & 7) - 4)); }
DEVI void wt_tile(const Ctx& C, const float* W, int K, int N, bf16_t* Wt, int tile, bool rope_perm) {
    LAS float* T = (LAS float*)C.lds;
    const int ntn = N / 64, tk = tile / ntn, tn = tile % ntn, k0 = tk * 64, n0 = tn * 64, tid = C.tid;
    __syncthreads();
#pragma unroll
    for (int i = 0; i < 2; ++i) { const int e = tid + i * 512, r = e >> 4, c4 = (e & 15) * 4;
        const f32x4 v = *(const f32x4*)(W + (size_t)(k0 + r) * N + n0 + c4);
        T[r * 65 + c4 + 0] = v[0]; T[r * 65 + c4 + 1] = v[1]; T[r * 65 + c4 + 2] = v[2]; T[r * 65 + c4 + 3] = v[3]; }
    __syncthreads();
    const int nn = tid >> 3, kc = (tid & 7) * 8;
    bool perm = false;
    if (rope_perm) { const int blk = n0 >> 9; perm = (blk == 0 || blk == 1 || blk == 4 || blk == 5); }
    const int src = perm ? rope_dim(nn) : nn;
    float f[8];
#pragma unroll
    for (int j = 0; j < 8; ++j) f[j] = T[(kc + j) * 65 + src];
    u32x4 w; w.x = cvt_pk_bf16(f[0], f[1]); w.y = cvt_pk_bf16(f[2], f[3]); w.z = cvt_pk_bf16(f[4], f[5]); w.w = cvt_pk_bf16(f[6], f[7]);
    *(u32x4*)(Wt + (size_t)(n0 + nn) * K + k0 + kc) = w;
}

DEVI void s5_tables(const Ctx& C, int g, int part) {
    LAS float* APr = (LAS float*)C.lds;
    LAS float* APi = APr + 64 * 33;
    LAS float* BBr = APi + 64 * 33;
    LAS float* BBi = BBr + 1024;
    LAS float* Cr = BBi + 1024;
    LAS float* Ci = Cr + 1024;
    LAS float* KL = Ci + 1024;
    const int tid = C.tid;
    const float* lre = C.in[4]; const float* lim = C.in[5]; const float* ldt = C.in[6];
    const float* bre = C.in[7]; const float* bim = C.in[8]; const float* cre = C.in[9]; const float* cim = C.in[10];
    __syncthreads();
    if (tid < 64) {
        const int p = tid;
        const float lr = lre[g * 64 + p], li = lim[g * 64 + p], dt = expf(ldt[g]);
        const float mag = expf(lr * dt);
        const float ar = mag * cosf(li * dt), ai = mag * sinf(li * dt);
        const float den = lr * lr + li * li;
        const float fr = ((ar - 1.0f) * lr + ai * li) / den, fi = (ai * lr - (ar - 1.0f) * li) / den;
        double pr = 1.0, pi = 0.0;
        for (int k = 0; k <= 32; ++k) { APr[p * 33 + k] = (float)pr; APi[p * 33 + k] = (float)pi; const double nr = pr * (double)ar - pi * (double)ai, ni = pr * (double)ai + pi * (double)ar; pr = nr; pi = ni; }
        for (int c = 0; c < 16; ++c) { const float br = bre[(g * 64 + p) * 16 + c], bi = bim[(g * 64 + p) * 16 + c]; BBr[p * 16 + c] = fr * br - fi * bi; BBi[p * 16 + c] = fr * bi + fi * br; }
    }
    for (int e = tid; e < 1024; e += 512) { Cr[e] = cre[g * 1024 + e]; Ci[e] = cim[g * 1024 + e]; }
    __syncthreads();
    for (int e = tid; e < 8192; e += 512) {
        const int k = e >> 8, c = (e >> 4) & 15, cp = e & 15; float s = 0.f;
        for (int p = 0; p < 64; ++p) { const float a_r = APr[p * 33 + k], a_i = APi[p * 33 + k], c_r = Cr[c * 64 + p], c_i = Ci[c * 64 + p];
            const float car = c_r * a_r - c_i * a_i, cai = c_r * a_i + c_i * a_r; s += car * BBr[p * 16 + cp] - cai * BBi[p * 16 + cp]; }
        KL[e] = s;
    }
    __syncthreads();
    bf16_t* A5 = WSP(bf16_t, WS_BT5A) + (size_t)g * 768 * 512;
    bf16_t* B5 = WSP(bf16_t, WS_BT5B) + (size_t)g * 512 * 256;
    for (int e = tid; e < 96 * 64; e += 512) {
        const int R = part * 96 + (e >> 6), col0 = (e & 63) * 8; float f[8];
        if (R < 512) { const int t = R >> 4, c = R & 15, s = col0 >> 4, cp0 = col0 & 15;
#pragma unroll
            for (int j = 0; j < 8; ++j) f[j] = (s <= t) ? KL[(t - s) * 256 + c * 16 + cp0 + j] : 0.f;
        } else if (R < 640) { const int pp = R - 512, p = pp >> 1, ri = pp & 1, s = col0 >> 4, cp0 = col0 & 15;
            const float a_r = APr[p * 33 + (31 - s)], a_i = APi[p * 33 + (31 - s)];
#pragma unroll
            for (int j = 0; j < 8; ++j) { const float b_r = BBr[p * 16 + cp0 + j], b_i = BBi[p * 16 + cp0 + j]; f[j] = ri ? (a_r * b_i + a_i * b_r) : (a_r * b_r - a_i * b_i); }
        } else {
#pragma unroll
            for (int j = 0; j < 8; ++j) f[j] = 0.f;
        }
        u32x4 w; w.x = cvt_pk_bf16(f[0], f[1]); w.y = cvt_pk_bf16(f[2], f[3]); w.z = cvt_pk_bf16(f[4], f[5]); w.w = cvt_pk_bf16(f[6], f[7]);
        *(u32x4*)(A5 + (size_t)R * 512 + col0) = w;
    }
    for (int e = tid; e < 64 * 32; e += 512) {
        const int R = part * 64 + (e >> 5), col0 = (e & 31) * 8, t = R >> 4, c = R & 15; float f[8];
        if (col0 < 128) {
#pragma unroll
            for (int j = 0; j < 4; ++j) { const int p = (col0 >> 1) + j; const float a_r = APr[p * 33 + t + 1], a_i = APi[p * 33 + t + 1], c_r = Cr[c * 64 + p], c_i = Ci[c * 64 + p];
                f[2 * j] = c_r * a_r - c_i * a_i; f[2 * j + 1] = -(c_r * a_i + c_i * a_r); }
        } else {
#pragma unroll
            for (int j = 0; j < 8; ++j) f[j] = 0.f;
        }
        u32x4 w; w.x = cvt_pk_bf16(f[0], f[1]); w.y = cvt_pk_bf16(f[2], f[3]); w.z = cvt_pk_bf16(f[4], f[5]); w.w = cvt_pk_bf16(f[6], f[7]);
        *(u32x4*)(B5 + (size_t)R * 256 + col0) = w;
    }
    if (part == 0 && tid < 64) { f32x2 a; a.x = APr[tid * 33 + 32]; a.y = APi[tid * 33 + 32]; WSP(f32x2, WS_A32)[g * 64 + tid] = a; }
}

DEVI void phase_prologue(const Ctx& C) {
    const int tid = C.tid, G = C.G, bid = C.bid;
    {
        const int t0 = 16 * 32, t1 = t0 + 16 * 16, t2 = t1 + 16 * 64, t3 = t2 + 16 * 16, t4 = t3 + 8 * 8;
        for (int j = bid; j < t4; j += G) {
            if (j < t0) wt_tile(C, C.in[3], 1024, 2048, WSP(bf16_t, WS_WIN0), j, false);
            else if (j < t1) wt_tile(C, C.in[23], 1024, 1024, WSP(bf16_t, WS_WOUT0), j - t0, false);
            else if (j < t2) wt_tile(C, C.in[24], 1024, 4096, WSP(bf16_t, WS_WIN1), j - t1, true);
            else if (j < t3) wt_tile(C, C.in[30], 1024, 1024, WSP(bf16_t, WS_WOUT1), j - t2, false);
            else wt_tile(C, C.in[12], 512, 512, WSP(bf16_t, WS_GLU), j - t3, false);
        }
    }
    for (int j = bid; j < 256; j += G) s5_tables(C, j >> 3, j & 7);
    const int gt = bid * 512 + tid, ngt = G * 512;
    {
        const float* wq = C.in[16]; const float* wk = C.in[17]; const float* wv = C.in[18];
        bf16_t* WQK = WSP(bf16_t, WS_WQK); bf16_t* WV = WSP(bf16_t, WS_WV);
        for (int e = gt; e < 1536 * 512; e += ngt) {
            const int n = e >> 9, k = e & 511; const int nn = n & 511, h = nn >> 7, ee = nn & 127; float v = 0.f;
            if ((k >> 7) == h) { const int d = k & 127; const size_t wi = ((size_t)h * 128 + d) * 128 + ee;
                v = (n < 512) ? wq[wi] : (n < 1024) ? wk[wi] * 0.08838834764831845f : wv[wi]; }
            if (n < 1024) WQK[(size_t)n * 512 + k] = f2bf(v); else WV[(size_t)(n - 1024) * 512 + k] = f2bf(v);
        }
        const float* gw = C.in[19]; float* GF = WSP(float, WS_GF);
        for (int e = gt; e < 1024 * 8; e += ngt) {
            const int rr = e >> 3, j = e & 7, ch = rr & 511, h = ch >> 7, d = ch & 127; float s = 0.f;
            if (rr < 512) { for (int ee = 0; ee < 128; ++ee) { const size_t wi = ((size_t)h * 128 + d) * 128 + ee; s += wq[wi] * gw[(size_t)(h * 128 + ee) * 8 + j] + wk[wi] * gw[(size_t)(512 + h * 128 + ee) * 8 + j]; } }
            else { for (int ee = 0; ee < 128; ++ee) { const size_t wi = ((size_t)h * 128 + d) * 128 + ee; s += wv[wi] * gw[(size_t)(1024 + h * 128 + ee) * 8 + j]; } }
            GF[e] = s;
        }
    }
    {
        float* RC = WSP(float, WS_ROPE_C); float* RS = WSP(float, WS_ROPE_S);
        for (int e = gt; e < 2048 * 32; e += ngt) { const int pos = e >> 5, j = e & 31; const float inv = powf(10000.0f, -(float)(2 * j) / 64.0f); const float ang = (float)pos * inv; RC[e] = cosf(ang); RS[e] = sinf(ang); }
    }
    if (bid == 0 && tid == 0) {
        float s1 = 0.f, s2 = 0.f; for (int j = 0; j < 64; ++j) { s1 += C.in[25][j] * C.in[26][j]; s2 += C.in[27][j] * C.in[28][j]; }
        WSP(float, WS_LAM)[0] = expf(s1) - expf(s2) + (0.8f - 0.6f * expf(-0.3f));
    }
    rows_pass(C, 0);
}

DEVI void phase_conv_gates(const Ctx& C) {
    const bf16_t* PZ = WSP(const bf16_t, WS_PZ); bf16_t* XC = WSP(bf16_t, WS_XC);
    float* LI = WSP(float, WS_LI); float* LF = WSP(float, WS_LF);
    const float* cw = C.in[14]; const float* cb = C.in[15]; const float* gb = C.in[20];
    LAS float* GFs = (LAS float*)C.lds;
    __syncthreads();
    for (int e = C.tid; e < 8192; e += 512) GFs[e] = WSP(const float, WS_GF)[e];
    __syncthreads();
    const int lane = C.lane, ch0 = lane * 8;
    float w[4][8], bb[8];
#pragma unroll
    for (int j = 0; j < 4; ++j)
#pragma unroll
        for (int i = 0; i < 8; ++i) w[j][i] = cw[j * 512 + ch0 + i];
#pragma unroll
    for (int i = 0; i < 8; ++i) bb[i] = cb[ch0 + i];
    const int gw = C.bid * 8 + C.wid, nw = C.G * 8;
    for (int r = gw; r < NT; r += nw) {
        const int l = r & 2047;
        float xs[4][8];
#pragma unroll
        for (int j = 0; j < 4; ++j) {
            const int dl = 3 - j;
            if (l - dl >= 0) { const u32x4 q = *(const u32x4*)(PZ + (size_t)(r - dl) * 1536 + 512 + ch0);
                xs[j][0] = bflo(q.x); xs[j][1] = bfhi(q.x); xs[j][2] = bflo(q.y); xs[j][3] = bfhi(q.y); xs[j][4] = bflo(q.z); xs[j][5] = bfhi(q.z); xs[j][6] = bflo(q.w); xs[j][7] = bfhi(q.w); }
            else {
#pragma unroll
                for (int i = 0; i < 8; ++i) xs[j][i] = 0.f; }
        }
        float xc[8];
#pragma unroll
        for (int i = 0; i < 8; ++i) { const float a = bb[i] + xs[0][i] * w[0][i] + xs[1][i] * w[1][i] + xs[2][i] * w[2][i] + xs[3][i] * w[3][i]; xc[i] = silu_f(a); }
        u32x4 o; o.x = cvt_pk_bf16(xc[0], xc[1]); o.y = cvt_pk_bf16(xc[2], xc[3]); o.z = cvt_pk_bf16(xc[4], xc[5]); o.w = cvt_pk_bf16(xc[6], xc[7]);
        *(u32x4*)(XC + (size_t)r * 512 + ch0) = o;
        float gt8[8];
#pragma unroll
        for (int j = 0; j < 8; ++j) gt8[j] = 0.f;
#pragma unroll
        for (int i = 0; i < 8; ++i) {
            const f32x4 a0 = *(const LAS f32x4*)(GFs + (ch0 + i) * 8), a1 = *(const LAS f32x4*)(GFs + (ch0 + i) * 8 + 4);
            const f32x4 b0 = *(const LAS f32x4*)(GFs + (512 + ch0 + i) * 8), b1 = *(const LAS f32x4*)(GFs + (512 + ch0 + i) * 8 + 4);
            const float xcv = xc[i], xmv = xs[3][i];
            gt8[0] += xcv * a0[0] + xmv * b0[0]; gt8[1] += xcv * a0[1] + xmv * b0[1]; gt8[2] += xcv * a0[2] + xmv * b0[2]; gt8[3] += xcv * a0[3] + xmv * b0[3];
            gt8[4] += xcv * a1[0] + xmv * b1[0]; gt8[5] += xcv * a1[1] + xmv * b1[1]; gt8[6] += xcv * a1[2] + xmv * b1[2]; gt8[7] += xcv * a1[3] + xmv * b1[3];
        }
#pragma unroll
        for (int j = 0; j < 8; ++j) gt8[j] = wave_sum(gt8[j]);
        if (lane < 8) {
            float gsel = gt8[0];
#pragma unroll
            for (int j = 1; j < 8; ++j) gsel = (lane == j) ? gt8[j] : gsel;
            gsel += gb[lane];
            const int b = r >> 11;
            if (lane < 4) LI[(size_t)(b * 4 + lane) * 2048 + l] = gsel;
            else { const float ax = fabsf(gsel); const float ls = fminf(gsel, 0.f) - log1pf(expf(-ax)); LF[(size_t)(b * 4 + lane - 4) * 2048 + l] = ls; }
        }
    }
}

DEVI void transpose_tok(const Ctx& C, const bf16_t* src, bf16_t* dst, int mode) {
    LAS unsigned* T = (LAS unsigned*)C.lds;
    LAS bf16_t* Ts = (LAS bf16_t*)C.lds;
    const int tid = C.tid;
    for (int tile = C.bid; tile < (NT / 64) * 8; tile += C.G) {
        const int tt = tile >> 3, cblk = tile & 7, tok0 = tt * 64, ch0 = cblk * 64;
        __syncthreads();
        { const int r = tid >> 3, cc = (tid & 7) * 8;
          const u32x4 q = *(const u32x4*)(src + (size_t)(tok0 + r) * 512 + ch0 + cc);
          const unsigned wv[4] = {q.x, q.y, q.z, q.w};
#pragma unroll
          for (int j = 0; j < 4; ++j) { Ts[(cc + 2 * j) * 66 + r] = (bf16_t)(wv[j] & 0xffffu); Ts[(cc + 2 * j + 1) * 66 + r] = (bf16_t)(wv[j] >> 16); } }
        __syncthreads();
        { const int c = tid >> 3, tc = (tid & 7) * 8;
          const int ch = ch0 + c, b = tok0 >> 11, l0 = (tok0 & 2047) + tc;
          if (mode == 0) {
              u32x4 w; w.x = T[c * 33 + (tc >> 1)]; w.y = T[c * 33 + (tc >> 1) + 1]; w.z = T[c * 33 + (tc >> 1) + 2]; w.w = T[c * 33 + (tc >> 1) + 3];
              const int h = ch >> 7, dv = ch & 127;
              *(u32x4*)(dst + ((size_t)((b * 4 + h) * 128 + dv)) * 2048 + l0) = w;
          } else {
              const int h = ch >> 6, dv = ch & 63;
#pragma unroll
              for (int j = 0; j < 8; ++j) { const int l = l0 + j; dst[((size_t)(((b * 8 + h) * 64 + dv) * 16 + (l & 15))) * 128 + (l >> 4)] = Ts[c * 66 + tc + j]; }
          } }
    }
}

DEVI void phase_mid0(const Ctx& C) {
    const int gw = C.bid * 8 + C.wid, lane = C.lane;
    if (gw < 64) {
        const float* LF = WSP(const float, WS_LF) + (size_t)gw * 2048; const float* LI = WSP(const float, WS_LI) + (size_t)gw * 2048;
        float* BC = WSP(float, WS_BC) + (size_t)gw * 2048; float* DS = WSP(float, WS_DS) + (size_t)gw * 2048;
        float tot = 0.f;
        for (int j = 0; j < 32; ++j) tot += LF[lane * 32 + j];
        float inc = tot;
#pragma unroll
        for (int d = 1; d < 64; d <<= 1) { const float o = __shfl_up(inc, d); if (lane >= d) inc += o; }
        float run = inc - tot;
        for (int j = 0; j < 32; ++j) { run += LF[lane * 32 + j]; BC[lane * 32 + j] = run; DS[lane * 32 + j] = LI[lane * 32 + j] - run; }
    }
    {
        const float* XLOC = WSP(const float, WS_XLOC); bf16_t* XST = WSP(bf16_t, WS_XST); const f32x2* A32 = WSP(const f32x2, WS_A32);
        for (int e = C.bid * 512 + C.tid; e < 32 * 16 * 64; e += C.G * 512) {
            const int p = e & 63, gb = e >> 6, g = gb >> 4;
            const f32x2 a = A32[g * 64 + p]; float xr = 0.f, xi = 0.f;
            for (int i = 0; i < 64; ++i) {
                const size_t n = (size_t)gb * 64 + i;
                *(unsigned*)(XST + n * 256 + 2 * p) = cvt_pk_bf16(xr, xi);
                *(unsigned*)(XST + n * 256 + 128 + 2 * p) = 0u;
                const f32x2 lc = *(const f32x2*)(XLOC + n * 128 + 2 * p);
                const float nr = a.x * xr - a.y * xi + lc.x, ni = a.x * xi + a.y * xr + lc.y; xr = nr; xi = ni;
            }
        }
    }
}
constexpr float NEG_INF = -__builtin_inff();

template <int NDT>
DEVI void osm_update(float (&s)[8], float& m, float& l, f32x4 (&o)[NDT], bf16x8& pf) {
    float mx = fmaxf(fmaxf(fmaxf(s[0], s[1]), fmaxf(s[2], s[3])), fmaxf(fmaxf(s[4], s[5]), fmaxf(s[6], s[7])));
    mx = fmaxf(mx, __shfl_xor(mx, 16)); mx = fmaxf(mx, __shfl_xor(mx, 32));
    const float mn = fmaxf(m, mx);
    const float mref = (mn == NEG_INF) ? 0.f : mn;
    const float alpha = fast_exp2(m - mref);
    float p[8]; float ps = 0.f;
#pragma unroll
    for (int i = 0; i < 8; ++i) { p[i] = fast_exp2(s[i] - mref); ps += p[i]; }
    l = l * alpha + ps; m = mn;
#pragma unroll
    for (int d = 0; d < NDT; ++d) o[d] *= alpha;
    u32x4 w; w.x = cvt_pk_bf16(p[0], p[1]); w.y = cvt_pk_bf16(p[2], p[3]); w.z = cvt_pk_bf16(p[4], p[5]); w.w = cvt_pk_bf16(p[6], p[7]);
    pf = __builtin_bit_cast(bf16x8, w);
}

DEVI bf16x8 ld_vt(const bf16_t* lo, const bf16_t* hi) {
    const u32x2 a = *(const u32x2*)lo, b = *(const u32x2*)hi; u32x4 w; w.x = a.x; w.y = a.y; w.z = b.x; w.w = b.y; return __builtin_bit_cast(bf16x8, w);
}

DEVI void phase_mlstm(const Ctx& C) {
    const bf16_t* QK = WSP(const bf16_t, WS_QK); const bf16_t* VT = WSP(const bf16_t, WS_VT0);
    const float* BC = WSP(const float, WS_BC); const float* DS = WSP(const float, WS_DS);
    const bf16_t* XC = WSP(const bf16_t, WS_XC); const bf16_t* PZ = WSP(const bf16_t, WS_PZ);
    bf16_t* AB = WSP(bf16_t, WS_AB);
    const float* ng = C.in[21]; const float* sk = C.in[22];
    const int lane = C.lane, r = lane & 15, g4 = lane >> 4;
    const int gw = C.bid * 8 + C.wid, nw = C.G * 8;
    for (int task = gw; task < 64 * 128; task += nw) {
        const int seq = task & 63, x = (task >> 6) & 31, q = task >> 11;
        const int rt = (q == 0) ? 127 - x : (q == 1) ? x : (q == 2) ? 95 - x : 32 + x;
        const int b = seq >> 2, h = seq & 3;
        const int t = 16 * rt + r; const size_t row = (size_t)b * 2048 + t;
        bf16x8 qf[4];
#pragma unroll
        for (int ks = 0; ks < 4; ++ks) qf[ks] = *(const bf16x8*)(QK + row * 1024 + h * 128 + 32 * ks + 8 * g4);
        const bf16_t* Kb = QK + (size_t)b * 2048 * 1024 + 512 + h * 128 + 8 * g4;
        const bf16_t* Vb = VT + ((size_t)(seq * 128 + r)) * 2048 + 4 * g4;
        const float* BCs = BC + (size_t)seq * 2048; const float* DSs = DS + (size_t)seq * 2048;
        const float bct = BCs[t];
        f32x4 o[8];
#pragma unroll
        for (int d = 0; d < 8; ++d) o[d] = (f32x4){0.f, 0.f, 0.f, 0.f};
        float dsum = 0.f;
        const int nseg = rt / 2 + 1;
        for (int sg = 0; sg < nseg; ++sg) {
            const int s0 = 32 * sg;
            f32x4 st[2];
#pragma unroll
            for (int kt = 0; kt < 2; ++kt) { st[kt] = (f32x4){0.f, 0.f, 0.f, 0.f}; const bf16_t* kp = Kb + (size_t)(s0 + 16 * kt + r) * 1024;
#pragma unroll
                for (int ks = 0; ks < 4; ++ks) st[kt] = mfma16(*(const bf16x8*)(kp + 32 * ks), qf[ks], st[kt]); }
            const float bref = BCs[s0];
            const float rowf = fast_exp2((bct - bref) * LOG2E);
            const f32x4 d0 = *(const f32x4*)(DSs + s0 + 4 * g4), d1 = *(const f32x4*)(DSs + s0 + 16 + 4 * g4);
            float p[8];
#pragma unroll
            for (int j = 0; j < 4; ++j) {
                const int k0 = s0 + 4 * g4 + j, k1 = k0 + 16;
                const float c0 = fast_exp2((bref + d0[j]) * LOG2E), c1 = fast_exp2((bref + d1[j]) * LOG2E);
                p[j] = (k0 <= t) ? st[0][j] * rowf * c0 : 0.f; p[4 + j] = (k1 <= t) ? st[1][j] * rowf * c1 : 0.f;
            }
            dsum += (p[0] + p[1]) + (p[2] + p[3]) + (p[4] + p[5]) + (p[6] + p[7]);
            u32x4 w; w.x = cvt_pk_bf16(p[0], p[1]); w.y = cvt_pk_bf16(p[2], p[3]); w.z = cvt_pk_bf16(p[4], p[5]); w.w = cvt_pk_bf16(p[6], p[7]);
            const bf16x8 pf = __builtin_bit_cast(bf16x8, w);
#pragma unroll
            for (int d = 0; d < 8; ++d) { const bf16_t* vp = Vb + (size_t)(16 * d) * 2048 + s0; o[d] = mfma16(ld_vt(vp, vp + 16), pf, o[d]); }
        }
        dsum += __shfl_xor(dsum, 16); dsum += __shfl_xor(dsum, 32);
        const float rden = 1.0f / fmaxf(fabsf(dsum), 1.0f);
        float su = 0.f;
#pragma unroll
        for (int d = 0; d < 8; ++d) { o[d] *= rden; su += (o[d][0] + o[d][1]) + (o[d][2] + o[d][3]); }
        su += __shfl_xor(su, 16); su += __shfl_xor(su, 32);
        const float mu = su * (1.0f / 128.0f);
        float sv = 0.f;
#pragma unroll
        for (int d = 0; d < 8; ++d) { const f32x4 dd = o[d] - mu; sv += (dd[0] * dd[0] + dd[1] * dd[1]) + (dd[2] * dd[2] + dd[3] * dd[3]); }
        sv += __shfl_xor(sv, 16); sv += __shfl_xor(sv, 32);
        const float rstd = rsqrtf(sv * (1.0f / 128.0f) + 1e-5f);
#pragma unroll
        for (int d = 0; d < 8; ++d) {
            const int ch = h * 128 + 16 * d + 4 * g4;
            const f32x4 gg = *(const f32x4*)(ng + ch), ss = *(const f32x4*)(sk + ch);
            const u32x2 xc = *(const u32x2*)(XC + row * 512 + ch), zz = *(const u32x2*)(PZ + row * 1536 + 1024 + ch);
            const float xcv[4] = {bflo(xc.x), bfhi(xc.x), bflo(xc.y), bfhi(xc.y)}, zv[4] = {bflo(zz.x), bfhi(zz.x), bflo(zz.y), bfhi(zz.y)};
            float y[4];
#pragma unroll
            for (int j = 0; j < 4; ++j) y[j] = ((o[d][j] - mu) * rstd * gg[j] + ss[j] * xcv[j]) * silu_f(zv[j]);
            u32x2 w; w.x = cvt_pk_bf16(y[0], y[1]); w.y = cvt_pk_bf16(y[2], y[3]);
            *(u32x2*)(AB + row * 1024 + 512 + ch) = w;
        }
    }
}

DEVI void phase_diff(const Ctx& C) {
    const bf16_t* DQ = WSP(const bf16_t, WS_DQ); const bf16_t* DK = WSP(const bf16_t, WS_DK); const bf16_t* VT = WSP(const bf16_t, WS_DVT);
    const bf16_t* DZ = WSP(const bf16_t, WS_DZ); bf16_t* CD = WSP(bf16_t, WS_CD);
    const float* dn = C.in[29];
    const float lam = WSP(const float, WS_LAM)[0];
    const float lam_init = 0.8f - 0.6f * 0.7408182206817179f;
    const int lane = C.lane, r = lane & 15, g4 = lane >> 4;
    const int gw = C.bid * 8 + C.wid, nw = C.G * 8;
    const float sc = 0.125f * LOG2E;
    for (int task = gw; task < 64 * 128; task += nw) {
        const int seq = task & 63, x = (task >> 6) & 31, q = task >> 11;
        const int rt = (q == 0) ? 127 - x : (q == 1) ? x : (q == 2) ? 95 - x : 32 + x;
        const int b = seq >> 2, h = seq & 3;
        const int t = 16 * rt + r; const size_t row = (size_t)b * 2048 + t;
        const bf16_t* Vb = VT + ((size_t)(seq * 128 + r)) * 2048 + 4 * g4;
        const int nseg = rt / 2 + 1;
        f32x4 res[8];
#pragma unroll
        for (int comp = 0; comp < 2; ++comp) {
            const size_t hb = ((size_t)(b * 8 + 2 * h + comp)) * 2048;
            bf16x8 qf[2];
#pragma unroll
            for (int ks = 0; ks < 2; ++ks) qf[ks] = *(const bf16x8*)(DQ + (hb + t) * 64 + 32 * ks + 8 * g4);
            const bf16_t* Kb = DK + hb * 64 + 8 * g4;
            f32x4 o[8];
#pragma unroll
            for (int d = 0; d < 8; ++d) o[d] = (f32x4){0.f, 0.f, 0.f, 0.f};
            float m = NEG_INF, l = 0.f;
            for (int sg = 0; sg < nseg; ++sg) {
                const int s0 = 32 * sg;
                f32x4 st[2];
#pragma unroll
                for (int kt = 0; kt < 2; ++kt) { st[kt] = (f32x4){0.f, 0.f, 0.f, 0.f}; const bf16_t* kp = Kb + (size_t)(s0 + 16 * kt + r) * 64;
#pragma unroll
                    for (int ks = 0; ks < 2; ++ks) st[kt] = mfma16(*(const bf16x8*)(kp + 32 * ks), qf[ks], st[kt]); }
                float s[8];
#pragma unroll
                for (int j = 0; j < 4; ++j) { const int k0 = s0 + 4 * g4 + j, k1 = k0 + 16; s[j] = (k0 <= t) ? st[0][j] * sc : NEG_INF; s[4 + j] = (k1 <= t) ? st[1][j] * sc : NEG_INF; }
                bf16x8 pf; osm_update<8>(s, m, l, o, pf);
#pragma unroll
                for (int d = 0; d < 8; ++d) { const bf16_t* vp = Vb + (size_t)(16 * d) * 2048 + s0; o[d] = mfma16(ld_vt(vp, vp + 16), pf, o[d]); }
            }
            l += __shfl_xor(l, 16); l += __shfl_xor(l, 32);
            const float rl = 1.0f / l;
            if (comp == 0) {
#pragma unroll
                for (int d = 0; d < 8; ++d) res[d] = o[d] * rl;
            } else {
#pragma unroll
                for (int d = 0; d < 8; ++d) res[d] -= o[d] * (rl * lam);
            }
        }
        float ss = 0.f;
#pragma unroll
        for (int d = 0; d < 8; ++d) ss += (res[d][0] * res[d][0] + res[d][1] * res[d][1]) + (res[d][2] * res[d][2] + res[d][3] * res[d][3]);
        ss += __shfl_xor(ss, 16); ss += __shfl_xor(ss, 32);
        const float rn = rsqrtf(ss * (1.0f / 128.0f) + 1e-5f) * (1.0f - lam_init);
#pragma unroll
        for (int d = 0; d < 8; ++d) {
            const int dv = 16 * d + 4 * g4, ch = h * 128 + dv;
            const f32x4 gg = *(const f32x4*)(dn + dv);
            const u32x2 zz = *(const u32x2*)(DZ + row * 512 + ch);
            const float zv[4] = {bflo(zz.x), bfhi(zz.x), bflo(zz.y), bfhi(zz.y)};
            float y[4];
#pragma unroll
            for (int j = 0; j < 4; ++j) y[j] = res[d][j] * rn * gg[j] * silu_f(zv[j]);
            u32x2 w; w.x = cvt_pk_bf16(y[0], y[1]); w.y = cvt_pk_bf16(y[2], y[3]);
            *(u32x2*)(CD + row * 1024 + 512 + ch) = w;
        }
    }
}

DEVI void dil_seg(const bf16_t* Kc  , const bf16_t* Vc  , int cc, int is0, int W, int tq, int r, int g4, float sc,
                  const bf16x8 (&qf)[2], f32x4 (&o)[4], float& m, float& l) {
    f32x4 st[2];
#pragma unroll
    for (int kt = 0; kt < 2; ++kt) { int ik = is0 + 16 * kt + r; ik = ik < 0 ? 0 : ik; st[kt] = (f32x4){0.f, 0.f, 0.f, 0.f}; const bf16_t* kp = Kc + (size_t)ik * 64;
#pragma unroll
        for (int ks = 0; ks < 2; ++ks) st[kt] = mfma16(*(const bf16x8*)(kp + 32 * ks), qf[ks], st[kt]); }
    float s[8];
#pragma unroll
    for (int j = 0; j < 4; ++j) {
        const int i0 = is0 + 4 * g4 + j, i1 = i0 + 16;
        const int d0 = tq - (16 * i0 + cc), d1 = tq - (16 * i1 + cc);
        s[j] = (i0 >= 0 && d0 >= 0 && d0 <= W) ? st[0][j] * sc : NEG_INF;
        s[4 + j] = (i1 >= 0 && d1 >= 0 && d1 <= W) ? st[1][j] * sc : NEG_INF;
    }
    bf16x8 pf; osm_update<4>(s, m, l, o, pf);
    int ilo = is0 + 4 * g4, ihi = ilo + 16; ilo = ilo < 0 ? 0 : ilo; ihi = ihi < 0 ? 0 : ihi;
#pragma unroll
    for (int d = 0; d < 4; ++d) { const bf16_t* vb = Vc + (size_t)(16 * d + r) * 2048; o[d] = mfma16(ld_vt(vb + ilo, vb + ihi), pf, o[d]); }
}

DEVI void phase_dilated(const Ctx& C) {
    const bf16_t* CQ = WSP(const bf16_t, WS_CQ); const bf16_t* CK = WSP(const bf16_t, WS_CK); const bf16_t* CVT = WSP(const bf16_t, WS_CVT);
    const bf16_t* CZ = WSP(const bf16_t, WS_CZ); bf16_t* CD = WSP(bf16_t, WS_CD);
    const int lane = C.lane, r = lane & 15, g4 = lane >> 4;
    const int gw = C.bid * 8 + C.wid, nw = C.G * 8;
    const float sc = 0.125f * LOG2E;
    for (int task = gw; task < 16 * 8 * 16 * 8; task += nw) {
        const int it = task & 7, c = (task >> 3) & 15, h = (task >> 7) & 7, b = task >> 10;
        const size_t bh = (size_t)(b * 8 + h);
        const int iq = 16 * it + r, tq = 16 * iq + c;
        bf16x8 qf[2];
#pragma unroll
        for (int ks = 0; ks < 2; ++ks) qf[ks] = *(const bf16x8*)(CQ + ((bh * 16 + c) * 128 + iq) * 64 + 32 * ks + 8 * g4);
        const bf16_t* Kbh = CK + bh * 16 * 128 * 64 + 8 * g4;
        const bf16_t* Vbh = CVT + bh * 64 * 2048;
        f32x4 o[4];
#pragma unroll
        for (int d = 0; d < 4; ++d) o[d] = (f32x4){0.f, 0.f, 0.f, 0.f};
        float m = NEG_INF, l = 0.f;
        for (int cc = 0; cc < 16; ++cc) dil_seg(Kbh + (size_t)cc * 128 * 64, Vbh + cc * 128, cc, 16 * it - 16, 128, tq, r, g4, sc, qf, o, m, l);
        for (int k = 0; k < 4; ++k) { const int cc = (c & 3) + 4 * k;
            if (it > 0) dil_seg(Kbh + (size_t)cc * 128 * 64, Vbh + cc * 128, cc, 16 * it - 48, 512, tq, r, g4, sc, qf, o, m, l);
            dil_seg(Kbh + (size_t)cc * 128 * 64, Vbh + cc * 128, cc, 16 * it - 16, 512, tq, r, g4, sc, qf, o, m, l); }
        for (int is0 = 0; is0 <= 16 * it + 15; is0 += 32) dil_seg(Kbh + (size_t)c * 128 * 64, Vbh + c * 128, c, is0, 4096, tq, r, g4, sc, qf, o, m, l);
        l += __shfl_xor(l, 16); l += __shfl_xor(l, 32);
        const float rl = 1.0f / l;
        const size_t row = (size_t)b * 2048 + tq;
#pragma unroll
        for (int d = 0; d < 4; ++d) {
            const int ch = h * 64 + 16 * d + 4 * g4;
            const u32x2 zz = *(const u32x2*)(CZ + row * 512 + ch);
            const float zv[4] = {bflo(zz.x), bfhi(zz.x), bflo(zz.y), bfhi(zz.y)};
            float y[4];
#pragma unroll
            for (int j = 0; j < 4; ++j) y[j] = o[d][j] * rl * silu_f(zv[j]);
            u32x2 w; w.x = cvt_pk_bf16(y[0], y[1]); w.y = cvt_pk_bf16(y[2], y[3]);
            *(u32x2*)(CD + row * 1024 + ch) = w;
        }
    }
}
typedef float f32x16 __attribute__((ext_vector_type(16)));
typedef short s16x4 __attribute__((ext_vector_type(4)));
DEVI f32x16 mfma32(bf16x8 a, bf16x8 b, f32x16 c) { return __builtin_amdgcn_mfma_f32_32x32x16_bf16(a, b, c, 0, 0, 0); }
DEVI s16x4 tr_read(const LAS unsigned char* p) { return __builtin_amdgcn_ds_read_tr16_b64_v4i16((LAS s16x4*)p); }

template <int DQK, int MODE>
DEVI void flash_core(const Ctx& C, const bf16_t* Qg, int ldq, const bf16_t* Kg, int ldk, const bf16_t* Vg, int ldv, int j, float sc,
                     const float* BCs, const float* DSs, f32x16 (&o)[4], float& lsum) {
    constexpr int NKS = DQK / 16, KROW = (DQK + 8) * 2, KBUF = 64 * KROW, VROW = 320, VBUF = 64 * VROW, NKC = DQK / 8, KLD = (64 * NKC) / 512;
    LAS unsigned char* lds = C.lds;
    const int tid = C.tid, lane = C.lane, w = C.wid, ql = lane & 31, h = lane >> 5;
    const int q0w = 256 * j + 32 * w, q = q0w + ql;
    bf16x8 qf[NKS];
#pragma unroll
    for (int ks = 0; ks < NKS; ++ks) qf[ks] = *(const bf16x8*)(Qg + (size_t)q * ldq + 16 * ks + 8 * h);
#pragma unroll
    for (int d = 0; d < 4; ++d)
#pragma unroll
        for (int r = 0; r < 16; ++r) o[d][r] = 0.f;
    float m = NEG_INF; lsum = 0.f;
    const int ntiles = 4 * (j + 1);
    const float bcq = MODE ? BCs[q] : 0.f;
    u32x4 kreg[KLD], vreg[2]; float cfreg = 0.f;
#define FL_LOAD(t) do { \
        _Pragma("unroll") for (int i_ = 0; i_ < KLD; ++i_) { const int idx_ = tid + 512 * i_, key_ = idx_ / NKC, ch_ = idx_ % NKC; kreg[i_] = *(const u32x4*)(Kg + (size_t)(64 * (t) + key_) * ldk + ch_ * 8); } \
        _Pragma("unroll") for (int i_ = 0; i_ < 2; ++i_) { const int idx_ = tid + 512 * i_, key_ = idx_ >> 4, ch_ = idx_ & 15; vreg[i_] = *(const u32x4*)(Vg + (size_t)(64 * (t) + key_) * ldv + ch_ * 8); } \
        if (MODE && tid < 64) cfreg = fast_exp2((BCs[64 * (t)] + DSs[64 * (t) + tid]) * LOG2E); } while (0)
#define FL_STORE(b) do { \
        _Pragma("unroll") for (int i_ = 0; i_ < KLD; ++i_) { const int idx_ = tid + 512 * i_, key_ = idx_ / NKC, ch_ = idx_ % NKC; *(LAS u32x4*)(lds + (b) * KBUF + key_ * KROW + ch_ * 16) = kreg[i_]; } \
        _Pragma("unroll") for (int i_ = 0; i_ < 2; ++i_) { const int idx_ = tid + 512 * i_, key_ = idx_ >> 4, ch_ = idx_ & 15; *(LAS u32x4*)(lds + 2 * KBUF + (b) * VBUF + key_ * VROW + ch_ * 16) = vreg[i_]; } \
        if (MODE && tid < 64) *(LAS float*)(lds + 2 * KBUF + 2 * VBUF + (b) * 256 + tid * 4) = cfreg; } while (0)
    __syncthreads();
    FL_LOAD(0); FL_STORE(0);
    __syncthreads();
    const int li = lane & 15, qq = li >> 2, pp = li & 3, g2 = (lane >> 4) & 1;
    for (int t = 0; t < ntiles; ++t) {
        const int buf = t & 1, k0 = 64 * t;
        if (t + 1 < ntiles) FL_LOAD(t + 1);
        if (k0 <= q0w + 31) {
            f32x16 st[2];
#pragma unroll
            for (int kt = 0; kt < 2; ++kt) {
#pragma unroll
                for (int r = 0; r < 16; ++r) st[kt][r] = 0.f;
                const LAS unsigned char* kb = lds + buf * KBUF + (32 * kt + ql) * KROW + 16 * h;
#pragma unroll
                for (int ks = 0; ks < NKS; ++ks) st[kt] = mfma32(*(const LAS bf16x8*)(kb + ks * 32), qf[ks], st[kt]);
            }
            __builtin_amdgcn_sched_barrier(0);
            const bool diag = (k0 + 63 > q0w);
            if (MODE == 0) {
                float smax = NEG_INF;
#pragma unroll
                for (int kt = 0; kt < 2; ++kt)
#pragma unroll
                    for (int r = 0; r < 16; ++r) { float s = st[kt][r] * sc; if (diag) { const int key = k0 + 32 * kt + (r & 3) + 8 * (r >> 2) + 4 * h; s = (key <= q) ? s : NEG_INF; } st[kt][r] = s; smax = fmaxf(smax, s); }
                smax = fmaxf(smax, __shfl_xor(smax, 32));
                if (!__all(smax <= m + 8.0f)) {
                    const float mn = fmaxf(m, smax), alpha = fast_exp2(m - mn);
#pragma unroll
                    for (int d = 0; d < 4; ++d) o[d] *= alpha;
                    lsum *= alpha; m = mn;
                }
#pragma unroll
                for (int kt = 0; kt < 2; ++kt)
#pragma unroll
                    for (int r = 0; r < 16; ++r) { const float p = fast_exp2(st[kt][r] - m); st[kt][r] = p; lsum += p; }
            } else {
                const float rowf = fast_exp2((bcq - BCs[k0]) * LOG2E);
                const LAS unsigned char* cfb = lds + 2 * KBUF + 2 * VBUF + buf * 256;
#pragma unroll
                for (int kt = 0; kt < 2; ++kt)
#pragma unroll
                    for (int g = 0; g < 4; ++g) { const f32x4 c4 = *(const LAS f32x4*)(cfb + (32 * kt + 8 * g + 4 * h) * 4);
#pragma unroll
                        for (int e = 0; e < 4; ++e) { const int r = 4 * g + e; float p = st[kt][r] * rowf * c4[e]; if (diag) { const int key = k0 + 32 * kt + e + 8 * g + 4 * h; p = (key <= q) ? p : 0.f; } st[kt][r] = p; lsum += p; } }
            }
            bf16x8 pf[4];
#pragma unroll
            for (int u = 0; u < 4; ++u) { const int kt = u >> 1, r0 = 8 * (u & 1); u32x4 wv;
                wv.x = cvt_pk_bf16(st[kt][r0 + 0], st[kt][r0 + 1]); wv.y = cvt_pk_bf16(st[kt][r0 + 2], st[kt][r0 + 3]); wv.z = cvt_pk_bf16(st[kt][r0 + 4], st[kt][r0 + 5]); wv.w = cvt_pk_bf16(st[kt][r0 + 6], st[kt][r0 + 7]);
                pf[u] = __builtin_bit_cast(bf16x8, wv); }
            __builtin_amdgcn_sched_barrier(0);
            const LAS unsigned char* vl = lds + 2 * KBUF + buf * VBUF + (4 * h + qq) * VROW + (16 * g2 + 4 * pp) * 2;
#pragma unroll
            for (int u = 0; u < 4; ++u)
#pragma unroll
                for (int d = 0; d < 4; ++d) {
                    const s16x4 lo = tr_read(vl + u * 16 * VROW + d * 64), hi = tr_read(vl + u * 16 * VROW + 8 * VROW + d * 64);
                    bf16x8 vf; vf[0] = lo[0]; vf[1] = lo[1]; vf[2] = lo[2]; vf[3] = lo[3]; vf[4] = hi[0]; vf[5] = hi[1]; vf[6] = hi[2]; vf[7] = hi[3];
                    o[d] = mfma32(vf, pf[u], o[d]);
                }
        }
        if (t + 1 < ntiles) FL_STORE(buf ^ 1);
        __syncthreads();
    }
#undef FL_LOAD
#undef FL_STORE
}

DEVI void phase_mlstm_blk(const Ctx& C) {
    const bf16_t* QK = WSP(const bf16_t, WS_QK); const bf16_t* V = WSP(const bf16_t, WS_VTMP);
    const float* BC = WSP(const float, WS_BC); const float* DS = WSP(const float, WS_DS);
    const bf16_t* XC = WSP(const bf16_t, WS_XC); const bf16_t* PZ = WSP(const bf16_t, WS_PZ);
    bf16_t* AB = WSP(bf16_t, WS_AB);
    const float* ng = C.in[21]; const float* sk = C.in[22];
    const int lane = C.lane, ql = lane & 31, h2 = lane >> 5;
    for (int task = C.bid; task < 512; task += C.G) {
        const int seq = task & 63, x = (task >> 6) & 3, j = (task < 256) ? 7 - x : x;
        const int b = seq >> 2, h = seq & 3;
        const bf16_t* Qg = QK + (size_t)b * 2048 * 1024 + h * 128;
        f32x16 o[4]; float dsum;
        flash_core<128, 1>(C, Qg, 1024, Qg + 512, 1024, V + (size_t)b * 2048 * 512 + h * 128, 512, j, 1.0f, BC + (size_t)seq * 2048, DS + (size_t)seq * 2048, o, dsum);
        dsum += __shfl_xor(dsum, 32);
        const float rden = 1.0f / fmaxf(fabsf(dsum), 1.0f);
        float su = 0.f;
#pragma unroll
        for (int d = 0; d < 4; ++d) { o[d] *= rden;
#pragma unroll
            for (int r = 0; r < 16; ++r) su += o[d][r]; }
        su += __shfl_xor(su, 32);
        const float mu = su * (1.0f / 128.0f);
        float sv = 0.f;
#pragma unroll
        for (int d = 0; d < 4; ++d)
#pragma unroll
            for (int r = 0; r < 16; ++r) { const float dd = o[d][r] - mu; sv += dd * dd; }
        sv += __shfl_xor(sv, 32);
        const float rstd = rsqrtf(sv * (1.0f / 128.0f) + 1e-5f);
        const size_t row = (size_t)b * 2048 + 256 * j + 32 * C.wid + ql;
#pragma unroll
        for (int d = 0; d < 4; ++d)
#pragma unroll
            for (int g = 0; g < 4; ++g) {
                const int ch = h * 128 + 32 * d + 8 * g + 4 * h2;
                const f32x4 gg = *(const f32x4*)(ng + ch), ss = *(const f32x4*)(sk + ch);
                const u32x2 xc = *(const u32x2*)(XC + row * 512 + ch), zz = *(const u32x2*)(PZ + row * 1536 + 1024 + ch);
                const float xcv[4] = {bflo(xc.x), bfhi(xc.x), bflo(xc.y), bfhi(xc.y)}, zv[4] = {bflo(zz.x), bfhi(zz.x), bflo(zz.y), bfhi(zz.y)};
                float y[4];
#pragma unroll
                for (int e = 0; e < 4; ++e) y[e] = ((o[d][4 * g + e] - mu) * rstd * gg[e] + ss[e] * xcv[e]) * silu_f(zv[e]);
                u32x2 wv; wv.x = cvt_pk_bf16(y[0], y[1]); wv.y = cvt_pk_bf16(y[2], y[3]);
                *(u32x2*)(AB + row * 1024 + 512 + ch) = wv;
            }
    }
}

DEVI void phase_diff_blk(const Ctx& C) {
    const bf16_t* DQ = WSP(const bf16_t, WS_DQ); const bf16_t* DK = WSP(const bf16_t, WS_DK); const bf16_t* DV = WSP(const bf16_t, WS_DVTMP);
    const bf16_t* DZ = WSP(const bf16_t, WS_DZ); bf16_t* CD = WSP(bf16_t, WS_CD);
    float* stp = WSP(float, WS_DVT) + ((size_t)C.bid * 512 + C.tid) * 64;
    const float* dn = C.in[29];
    const float lam = WSP(const float, WS_LAM)[0];
    const float lam_init = 0.8f - 0.6f * 0.7408182206817179f;
    const int lane = C.lane, ql = lane & 31, h2 = lane >> 5;
    const float sc = 0.125f * LOG2E;
    for (int task = C.bid; task < 512; task += C.G) {
        const int seq = task & 63, x = (task >> 6) & 3, j = (task < 256) ? 7 - x : x;
        const int b = seq >> 2, h = seq & 3;
        const bf16_t* Vg = DV + (size_t)b * 2048 * 512 + h * 128;
        f32x16 o[4]; float l;
#pragma unroll 1
        for (int comp = 0; comp < 2; ++comp) {
            const size_t hb = ((size_t)(b * 8 + 2 * h + comp)) * 2048 * 64;
            flash_core<64, 0>(C, DQ + hb, 64, DK + hb, 64, Vg, 512, j, sc, nullptr, nullptr, o, l);
            l += __shfl_xor(l, 32);
            if (comp == 0) {
                const float rl = 1.0f / l;
#pragma unroll
                for (int d = 0; d < 4; ++d) {
#pragma unroll
                    for (int g = 0; g < 4; ++g) { f32x4 v4; v4[0] = o[d][4 * g] * rl; v4[1] = o[d][4 * g + 1] * rl; v4[2] = o[d][4 * g + 2] * rl; v4[3] = o[d][4 * g + 3] * rl; *(f32x4*)(stp + d * 16 + g * 4) = v4; }
                    asm volatile("" ::: "memory"); }
            } else {
                const float rl = lam / l;
#pragma unroll
                for (int d = 0; d < 4; ++d) {
#pragma unroll
                    for (int g = 0; g < 4; ++g) { const f32x4 v4 = *(const f32x4*)(stp + d * 16 + g * 4); o[d][4 * g] = v4[0] - o[d][4 * g] * rl; o[d][4 * g + 1] = v4[1] - o[d][4 * g + 1] * rl; o[d][4 * g + 2] = v4[2] - o[d][4 * g + 2] * rl; o[d][4 * g + 3] = v4[3] - o[d][4 * g + 3] * rl; }
                    asm volatile("" ::: "memory"); }
            }
        }
        float ss = 0.f;
#pragma unroll
        for (int d = 0; d < 4; ++d)
#pragma unroll
            for (int r = 0; r < 16; ++r) ss += o[d][r] * o[d][r];
        ss += __shfl_xor(ss, 32);
        const float rn = rsqrtf(ss * (1.0f / 128.0f) + 1e-5f) * (1.0f - lam_init);
        const size_t row = (size_t)b * 2048 + 256 * j + 32 * C.wid + ql;
#pragma unroll
        for (int d = 0; d < 4; ++d)
#pragma unroll
            for (int g = 0; g < 4; ++g) {
                const int dv = 32 * d + 8 * g + 4 * h2, ch = h * 128 + dv;
                const f32x4 gg = *(const f32x4*)(dn + dv);
                const u32x2 zz = *(const u32x2*)(DZ + row * 512 + ch);
                const float zv[4] = {bflo(zz.x), bfhi(zz.x), bflo(zz.y), bfhi(zz.y)};
                float y[4];
#pragma unroll
                for (int e = 0; e < 4; ++e) y[e] = o[d][4 * g + e] * rn * gg[e] * silu_f(zv[e]);
                u32x2 wv; wv.x = cvt_pk_bf16(y[0], y[1]); wv.y = cvt_pk_bf16(y[2], y[3]);
                *(u32x2*)(CD + row * 1024 + 512 + ch) = wv;
            }
    }
}
#ifndef REP_MASK
#define REP_MASK 0
#endif
constexpr int N_STEPS = 17;
constexpr int LDS_BYTES = pg8::STAGE_BYTES + 256;

template <int MODE>
DEVI void run_gemm(const Ctx& C, const EpiMulti<MODE>& E, const bf16_t* A, int lda, const bf16_t* Bt, int ldb, int N, int K, int grp_shift, size_t grp_bbytes) {
    pg8::Gemm g; g.A = A; g.Bt = Bt; g.M = NT; g.N = N; g.K = K; g.lda = lda; g.ldb = ldb; g.grp_shift = grp_shift; g.grp_bbytes = grp_bbytes;
    pg8::StaticOrder S; S.init(NT, N, C.G, C.bid);
    pg8::gemm_phase<EpiMulti<MODE>>(C.lds, g, S, E);
}
template <int MODE> DEVI EpiMulti<MODE> mk_epi(const Ctx& C) { EpiMulti<MODE> E; E.ldc = 0; E.o0 = nullptr; E.o1 = nullptr; E.f0 = nullptr; E.i0 = nullptr; E.i1 = nullptr; E.c0 = nullptr; E.c1 = nullptr; E.ws = C.ws; return E; }

__global__ void __launch_bounds__(512, 2) mega_fwd(Params P) {
    extern __shared__ __attribute__((aligned(16))) unsigned char lds_raw[];
    Ctx C;
    C.in = P.in;
    C.out = P.out; C.ws = P.ws; C.lds = (LAS unsigned char*)lds_raw;
    C.tid = threadIdx.x; C.lane = C.tid & 63; C.wid = __builtin_amdgcn_readfirstlane(C.tid >> 6); C.G = gridDim.x; C.bid = blockIdx.x;
    volatile LAS unsigned* bst = (volatile LAS unsigned*)(C.lds + pg8::STAGE_BYTES);
    if (C.tid < 4) bst[C.tid] = 0u;
    __syncthreads();
    XcdBarrier bar = xcd_barrier_post((unsigned*)(C.ws + WS_CTL), bst);
#ifdef ONLY_PHASE
#define ON(k) ((k) == ONLY_PHASE)
#else
#define ON(k) (P.ph_lo <= (k) && (k) < P.ph_hi)
#endif
#define STEP(k, ...) if (ON(k)) { __VA_ARGS__ } if (ON(k) && ((REP_MASK >> (k)) & 1)) { __VA_ARGS__ }
#define BAR(k) do { if (ON(k) && (k) + 1 < P.ph_hi) xcd_barrier(bar); } while (0)
    STEP(0, phase_prologue(C);)
    BAR(0);
    STEP(1, { auto E = mk_epi<EM_IN0>(C); E.o0 = WSP(bf16_t, WS_PZ); E.o1 = WSP(bf16_t, WS_U5);
        run_gemm(C, E, WSP(const bf16_t, WS_XN), 1024, WSP(const bf16_t, WS_WIN0), 1024, 2048, 1024, 0, 0); })
    BAR(1);
    STEP(2, phase_conv_gates(C);)
    BAR(2);
    STEP(3, { auto E = mk_epi<EM_PLAIN>(C); E.o0 = WSP(bf16_t, WS_QK); E.ldc = 1024;
        run_gemm(C, E, WSP(const bf16_t, WS_XC), 512, WSP(const bf16_t, WS_WQK), 512, 1024, 512, 0, 0); })
    STEP(4, { auto E = mk_epi<EM_PLAIN>(C); E.o0 = WSP(bf16_t, WS_VTMP); E.ldc = 512;
        run_gemm(C, E, WSP(const bf16_t, WS_PZ) + 512, 1536, WSP(const bf16_t, WS_WV), 512, 512, 512, 0, 0); })
    STEP(5, { auto E = mk_epi<EM_S5A>(C); E.o0 = WSP(bf16_t, WS_YLOC); E.f0 = WSP(float, WS_XLOC);
        run_gemm(C, E, WSP(const bf16_t, WS_U5), 512, WSP(const bf16_t, WS_BT5A), 512, 768, 512, 2, (size_t)768 * 512 * 2); })
    BAR(5);
    STEP(6, phase_mid0(C);)
    BAR(6);
    STEP(7, phase_mlstm_blk(C);)
    STEP(8, { auto E = mk_epi<EM_S5B>(C); E.o0 = WSP(bf16_t, WS_G5); E.i0 = WSP(const bf16_t, WS_YLOC); E.i1 = WSP(const bf16_t, WS_U5); E.c0 = C.in[11];
        run_gemm(C, E, WSP(const bf16_t, WS_XST), 256, WSP(const bf16_t, WS_BT5B), 256, 512, 256, 2, (size_t)512 * 256 * 2); })
    BAR(8);
    STEP(9, { auto E = mk_epi<EM_GLU>(C); E.o0 = WSP(bf16_t, WS_AB); E.i0 = WSP(const bf16_t, WS_G5); E.i1 = WSP(const bf16_t, WS_PZ); E.c0 = C.in[13];
        run_gemm(C, E, WSP(const bf16_t, WS_G5), 512, WSP(const bf16_t, WS_GLU), 512, 512, 512, 0, 0); })
    BAR(9);
    STEP(10, { auto E = mk_epi<EM_OUT>(C); E.o0 = WSP(bf16_t, WS_Y0); E.f0 = WSP(float, WS_SS0);
        run_gemm(C, E, WSP(const bf16_t, WS_AB), 1024, WSP(const bf16_t, WS_WOUT0), 1024, 1024, 1024, 0, 0); })
    BAR(10);
    STEP(11, rows_pass(C, 1);)
    BAR(11);
    STEP(12, { auto E = mk_epi<EM_IN1>(C); E.c0 = WSP(const float, WS_ROPE_C); E.c1 = WSP(const float, WS_ROPE_S);
        run_gemm(C, E, WSP(const bf16_t, WS_XN1), 1024, WSP(const bf16_t, WS_WIN1), 1024, 4096, 1024, 0, 0); })
    BAR(12);
    STEP(13, { transpose_tok(C, WSP(const bf16_t, WS_CVTMP), WSP(bf16_t, WS_CVT), 1); })
    BAR(13);
    STEP(14, phase_diff_blk(C);)
    if (ON(14)) { phase_dilated(C); } if (ON(14) && ((REP_MASK >> 17) & 1)) { phase_dilated(C); }
    BAR(14);
    STEP(15, { auto E = mk_epi<EM_OUT>(C); E.o0 = WSP(bf16_t, WS_Y1); E.f0 = WSP(float, WS_SS1);
        run_gemm(C, E, WSP(const bf16_t, WS_CD), 1024, WSP(const bf16_t, WS_WOUT1), 1024, 1024, 1024, 0, 0); })
    BAR(15);
    STEP(16, rows_pass(C, 2);)
#undef ON
#undef BAR
}

#ifndef MK_SPLIT
#define MK_SPLIT 0
#endif
extern "C" void kernel_launch(void* const* d_in, const int* in_sizes, int n_in, void* d_out, int out_size, void* d_ws, size_t ws_size, hipStream_t stream) {
    static int grid = 0;
    if (grid == 0) {
        int dev = 0, cus = 0, per_cu = 0;
        (void)hipGetDevice(&dev);
        (void)hipDeviceGetAttribute(&cus, hipDeviceAttributeMultiprocessorCount, dev);
        (void)hipFuncSetAttribute((const void*)mega_fwd, hipFuncAttributeMaxDynamicSharedMemorySize, LDS_BYTES);
        (void)hipOccupancyMaxActiveBlocksPerMultiprocessor(&per_cu, (const void*)mega_fwd, 512, LDS_BYTES);
        if (per_cu < 1) per_cu = 1;
        if (per_cu > 1) per_cu = 1;
        grid = cus * per_cu;
        if (n_in != 31 || ws_size < WS_END) { fprintf(stderr, "kernel_launch: unexpected n_in %d or ws_size %zu (< %zu)\n", n_in, ws_size, (size_t)WS_END); }
        (void)hipGetLastError();
    }
    (void)hipMemsetAsync((char*)d_ws + WS_CTL, 0, 16384, stream);
    Params p{};
    for (int i = 0; i < 31; ++i) p.in[i] = (const float*)d_in[i];
    p.out = (float*)d_out; p.ws = (unsigned char*)d_ws;
#if MK_SPLIT
    for (int st = 0; st < N_STEPS; ++st) {
        p.ph_lo = st; p.ph_hi = st + 1;
        hipLaunchKernelGGL(mega_fwd, dim3(grid), dim3(512), LDS_BYTES, stream, p);
    }
#else
    p.ph_lo = 0; p.ph_hi = N_STEPS;
    void* args[] = {&p};
    hipError_t e = hipLaunchCooperativeKernel((const void*)mega_fwd, dim3(grid), dim3(512), args, LDS_BYTES, stream);
    if (e != hipSuccess) fprintf(stderr, "cooperative launch failed: %s (grid %d)\n", hipGetErrorString(e), grid);
#endif
}
```

```cpp
#include <hip/hip_runtime.h>
#include <stdint.h>
#include <stdio.h>

typedef unsigned short bf16_t;
typedef short bf16x8 __attribute__((ext_vector_type(8)));
typedef short bf16x4 __attribute__((ext_vector_type(4)));
typedef float f32x4 __attribute__((ext_vector_type(4)));
typedef float f32x2 __attribute__((ext_vector_type(2)));
typedef unsigned u32x4 __attribute__((ext_vector_type(4)));
typedef unsigned u32x2 __attribute__((ext_vector_type(2)));
#define LAS __attribute__((address_space(3)))
#define DEVI __device__ __forceinline__

constexpr int NB = 16, SEQ = 2048, DM = 1024, NT = NB * SEQ;
constexpr float LOG2E = 1.4426950408889634f;
constexpr size_t MiB = 1024ull * 1024ull;

constexpr size_t WS_CTL = 0;
constexpr size_t WS_LAM = 64 * 1024;
constexpr size_t WS_ROPE_C = 128 * 1024;
constexpr size_t WS_ROPE_S = 384 * 1024;
constexpr size_t WS_GF = 640 * 1024;
constexpr size_t WS_A32 = 704 * 1024;
constexpr size_t WS_WIN0 = 1 * MiB;
constexpr size_t WS_WOUT0 = 5 * MiB;
constexpr size_t WS_WIN1 = 7 * MiB;
constexpr size_t WS_WOUT1 = 15 * MiB;
constexpr size_t WS_GLU = 17 * MiB;
constexpr size_t WS_WQK = 17 * MiB + 512 * 1024;
constexpr size_t WS_WV = 18 * MiB + 512 * 1024;
constexpr size_t WS_BT5A = 19 * MiB;
constexpr size_t WS_BT5B = 43 * MiB;
constexpr size_t WS_R1 = 52 * MiB;
constexpr size_t WS_R2 = 116 * MiB;
constexpr size_t WS_R3 = 372 * MiB;
constexpr size_t WS_R4 = 436 * MiB;
constexpr size_t WS_R5 = 500 * MiB;
constexpr size_t WS_END = 506 * MiB;
constexpr size_t WS_PZ = WS_R2;
constexpr size_t WS_U5 = WS_R2 + 96 * MiB;
constexpr size_t WS_XC = WS_R2 + 128 * MiB;
constexpr size_t WS_VTMP = WS_R2 + 160 * MiB;
constexpr size_t WS_VT0 = WS_R2 + 192 * MiB;
constexpr size_t WS_YLOC = WS_R2 + 224 * MiB;
constexpr size_t WS_CQ = WS_R2;
constexpr size_t WS_CK = WS_R2 + 32 * MiB;
constexpr size_t WS_CVTMP = WS_R2 + 64 * MiB;
constexpr size_t WS_CZ = WS_R2 + 96 * MiB;
constexpr size_t WS_DQ = WS_R2 + 128 * MiB;
constexpr size_t WS_DK = WS_R2 + 160 * MiB;
constexpr size_t WS_DVTMP = WS_R2 + 192 * MiB;
constexpr size_t WS_DZ = WS_R2 + 224 * MiB;
constexpr size_t WS_Y1 = WS_R2;
constexpr size_t WS_XN = WS_R1;
constexpr size_t WS_QK = WS_R1;
constexpr size_t WS_Y0 = WS_R1;
constexpr size_t WS_AB = WS_R3;
constexpr size_t WS_XN1 = WS_R3;
constexpr size_t WS_CD = WS_R3;
constexpr size_t WS_XLOC = WS_R4;
constexpr size_t WS_XST = WS_R4 + 16 * MiB;
constexpr size_t WS_G5 = WS_R4 + 32 * MiB;
constexpr size_t WS_CVT = WS_R4;
constexpr size_t WS_DVT = WS_R4 + 32 * MiB;
constexpr size_t WS_LI = WS_R5;
constexpr size_t WS_LF = WS_R5 + 512 * 1024;
constexpr size_t WS_BC = WS_R5 + 1024 * 1024;
constexpr size_t WS_DS = WS_R5 + 1536 * 1024;
constexpr size_t WS_SS0 = WS_R5 + 2 * MiB;
constexpr size_t WS_SS1 = WS_R5 + 4 * MiB;

DEVI unsigned cvt_pk_bf16(float lo, float hi) { unsigned r; asm("v_cvt_pk_bf16_f32 %0, %1, %2" : "=v"(r) : "v"(lo), "v"(hi)); return r; }
DEVI float bf2f(unsigned v16) { return __uint_as_float(v16 << 16); }
DEVI float bflo(unsigned w) { return __uint_as_float(w << 16); }
DEVI float bfhi(unsigned w) { return __uint_as_float(w & 0xffff0000u); }
DEVI bf16_t f2bf(float f) { return (bf16_t)(cvt_pk_bf16(f, 0.f) & 0xffffu); }
DEVI float wave_sum(float v) { v += __shfl_xor(v, 32); v += __shfl_xor(v, 16); v += __shfl_xor(v, 8); v += __shfl_xor(v, 4); v += __shfl_xor(v, 2); v += __shfl_xor(v, 1); return v; }
DEVI float fast_exp2(float x) { return __builtin_amdgcn_exp2f(x); }
DEVI float silu_f(float x) { return x / (1.0f + __expf(-x)); }
DEVI float sigmoid_f(float x) { return 1.0f / (1.0f + __expf(-x)); }
DEVI float gelu_tanh_f(float x) { const float u = 0.7978845608028654f * (x + 0.044715f * x * x * x); const float e = __expf(2.0f * u); const float th = 1.0f - 2.0f / (e + 1.0f); return 0.5f * x * (1.0f + th); }
DEVI f32x4 mfma16(bf16x8 a, bf16x8 b, f32x4 c) { return __builtin_amdgcn_mfma_f32_16x16x32_bf16(a, b, c, 0, 0, 0); }
namespace pg8 {
constexpr int BM = 256, BK = 64, HALF = 128, HTB = HALF * BK * 2  , STAGE_BYTES = 8 * HTB, NXCD = 8, WGM = 8;

__host__ __device__ __forceinline__ int lds_byte(int r, int c) { const int st = (r >> 4) * 2 + (c >> 5), rr = r & 15, cc = c & 31, ob = rr * 64 + cc * 2; return st * 1024 + (ob ^ (((ob >> 9) & 1) << 5)); }
__host__ __device__ __forceinline__ void stage_rc(int b, int& R, int& C) { const int st = b / 1024, sb = b % 1024, swz = sb ^ (((sb >> 9) & 1) << 5); R = (st >> 1) * 16 + swz / 64; C = (st & 1) * 32 + (swz % 64) / 2; }
__host__ __device__ __forceinline__ int perm32(int rho) { const int n = rho >> 4, i = rho & 15; return 8 * (i >> 2) + 4 * n + (i & 3); }

struct Unit { int pm, pn; };
struct Gemm { const bf16_t* A; const bf16_t* Bt; int M, N, K, lda, ldb, grp_shift; size_t grp_bbytes; };

struct StaticOrder {
    int nM, nN, nwg, G, c;
    __host__ __device__ void init(int M, int N, int G_, int c_) { nM = M / BM; nN = N / BM; nwg = nM * nN; G = G_; c = c_; }
    __host__ __device__ bool next(int i, Unit& u) const {
        const long L = (long)i * G + c; if (L >= nwg) return false;
        int wgid = (int)L; { const int q = nwg / NXCD, r = nwg % NXCD, xcd = wgid % NXCD, off = wgid / NXCD; wgid = (xcd < r ? xcd * (q + 1) : r * (q + 1) + (xcd - r) * q) + off; }
        const int nig = WGM * nN, gid = wgid / nig, fm = gid * WGM, gsz = (nM - fm) < WGM ? (nM - fm) : WGM;
        u.pm = fm + ((wgid % nig) % gsz); u.pn = (wgid % nig) / gsz; return true;
    }
};

template <class Epi>
__device__ __forceinline__ void gemm_phase(LAS unsigned char* lds, const Gemm g, const StaticOrder& S, const Epi& E) {
    const int tid = threadIdx.x, wid = __builtin_amdgcn_readfirstlane(tid >> 6), lane = tid & 63, wr = wid >> 2, wc = wid & 3, fr = lane & 15, fq = lane >> 4;
    int nt = g.K / BK; asm volatile("" : "+s"(nt));
    unsigned voffA[2], voffB[2];
#pragma unroll
    for (int i = 0; i < 2; ++i) { int R, C; stage_rc(tid * 16 + i * 8192, R, C); const int Rb = (R & ~31) + perm32(R & 31);
        voffA[i] = (unsigned)(R * g.lda + C) * 2u; voffB[i] = (unsigned)(Rb * g.ldb + C) * 2u; }
    const size_t kstep = (size_t)(BK * 2);
    const size_t hstepA = (size_t)HALF * g.lda * 2, hstepB = (size_t)HALF * g.ldb * 2;
    const size_t tstepA = 2 * hstepA, tstepB = 2 * hstepB;
    const unsigned ldsw = (unsigned)wid * 1024u;
    const int aoff = lds_byte(wr * 64 + fr, fq * 8), boff = lds_byte(wc * 32 + fr, fq * 8);
#define PG8_SA(b, h) (((b) * 2 + (h)) * HTB)
#define PG8_SB(b, h) ((4 + (b) * 2 + (h)) * HTB)
#define PG8_STAGE(bufoff, gbase, voff) do { _Pragma("unroll") for (int _i = 0; _i < 2; ++_i) \
        __builtin_amdgcn_global_load_lds((const unsigned*)((const char*)(gbase) + (voff)[_i]), (LAS unsigned*)(lds + (bufoff) + ldsw + _i * 8192), 16, 0, 0); } while (0)
#define PG8_LDA(dst, b, h) do { _Pragma("unroll") for (int m = 0; m < 4; ++m) _Pragma("unroll") for (int k = 0; k < 2; ++k) dst[m][k] = *(const LAS bf16x8*)(lds + PG8_SA(b, h) + aoff + m * 2048 + k * 1024); } while (0)
#define PG8_LDB(dst, b, h) do { _Pragma("unroll") for (int n = 0; n < 2; ++n) _Pragma("unroll") for (int k = 0; k < 2; ++k) dst[n][k] = *(const LAS bf16x8*)(lds + PG8_SB(b, h) + boff + n * 2048 + k * 1024); } while (0)
#define PG8_MMA(ai, bj, At, Bt) do { __builtin_amdgcn_s_setprio(1); _Pragma("unroll") for (int m = 0; m < 4; ++m) _Pragma("unroll") for (int n = 0; n < 2; ++n) _Pragma("unroll") for (int k = 0; k < 2; ++k) \
        acc[ai][bj][m][n] = __builtin_amdgcn_mfma_f32_16x16x32_bf16(Bt[n][k], At[m][k], acc[ai][bj][m][n], 0, 0, 0); __builtin_amdgcn_s_setprio(0); } while (0)
#define PG8_WAIT_V(n) asm volatile("s_waitcnt vmcnt(" #n ")" ::: "memory")
#define PG8_WAIT_L(n) asm volatile("s_waitcnt lgkmcnt(" #n ")" ::: "memory")
#define PG8_BAR __builtin_amdgcn_s_barrier()
#define PG8_SCHED __builtin_amdgcn_sched_barrier(0)
#define PG8_BBASE(u) ((const char*)g.Bt + (size_t)((u).pm >> g.grp_shift) * g.grp_bbytes + (size_t)(u).pn * tstepB)
    Unit cur, nxt; int ui = 0;
    if (!S.next(0, cur)) return;
    f32x4 acc[2][2][4][2];
#pragma unroll
    for (int a = 0; a < 2; ++a)
#pragma unroll
        for (int b = 0; b < 2; ++b)
#pragma unroll
            for (int m = 0; m < 4; ++m)
#pragma unroll
                for (int n = 0; n < 2; ++n) acc[a][b][m][n] = (f32x4){0.f, 0.f, 0.f, 0.f};
    bf16x8 At[4][2], B0[2][2], B1[2][2];
    const char* cA = (const char*)g.A + (size_t)cur.pm * tstepA; const char* cB = PG8_BBASE(cur);
    PG8_STAGE(PG8_SB(0, 0), cB, voffB); PG8_STAGE(PG8_SA(0, 0), cA, voffA); PG8_STAGE(PG8_SB(0, 1), cB + hstepB, voffB); PG8_STAGE(PG8_SA(0, 1), cA + hstepA, voffA);
    if (wr == 1) PG8_BAR;
    PG8_WAIT_V(4); PG8_BAR;
    PG8_STAGE(PG8_SB(1, 0), cB + kstep, voffB); PG8_STAGE(PG8_SA(1, 0), cA + kstep, voffA); PG8_STAGE(PG8_SB(1, 1), cB + hstepB + kstep, voffB);
    PG8_WAIT_V(6); PG8_BAR;
    for (;;) {
        const bool has_next = S.next(ui + 1, nxt);
        const char* nA = has_next ? (const char*)g.A + (size_t)nxt.pm * tstepA : cA; const char* nB = has_next ? PG8_BBASE(nxt) : cB;
        for (int t = 0; t < nt; t += 2) {
            const bool last = (t == nt - 2);
            const char* a1 = cA + (size_t)(t + 1) * kstep;
            const char* a2 = last ? nA : cA + (size_t)(t + 2) * kstep; const char* b2 = last ? nB : cB + (size_t)(t + 2) * kstep;
            const char* a3 = a2 + kstep; const char* b3 = b2 + kstep;
            PG8_LDB(B0, 0, 0); PG8_SCHED; PG8_LDA(At, 0, 0); PG8_STAGE(PG8_SA(1, 1), a1 + hstepA, voffA);
            PG8_WAIT_L(8); PG8_BAR; PG8_WAIT_L(0); PG8_MMA(0, 0, At, B0); PG8_BAR; PG8_SCHED;
            PG8_LDB(B1, 0, 1); PG8_STAGE(PG8_SB(0, 0), b2, voffB);
            PG8_BAR; PG8_WAIT_L(0); PG8_MMA(0, 1, At, B1); PG8_BAR;
            PG8_LDA(At, 0, 1); PG8_STAGE(PG8_SA(0, 0), a2, voffA);
            PG8_BAR; PG8_WAIT_L(0); PG8_MMA(1, 0, At, B0); PG8_BAR; PG8_SCHED;
            PG8_STAGE(PG8_SB(0, 1), b2 + hstepB, voffB);
            PG8_WAIT_V(6); PG8_BAR; PG8_MMA(1, 1, At, B1); PG8_BAR;
            PG8_LDB(B0, 1, 0); PG8_SCHED; PG8_LDA(At, 1, 0); PG8_STAGE(PG8_SA(0, 1), a2 + hstepA, voffA);
            PG8_WAIT_L(8); PG8_BAR; PG8_WAIT_L(0); PG8_MMA(0, 0, At, B0); PG8_BAR; PG8_SCHED;
            PG8_LDB(B1, 1, 1); PG8_STAGE(PG8_SB(1, 0), b3, voffB);
            PG8_BAR; PG8_WAIT_L(0); PG8_MMA(0, 1, At, B1); PG8_BAR;
            PG8_LDA(At, 1, 1); PG8_STAGE(PG8_SA(1, 0), a3, voffA);
            PG8_BAR; PG8_WAIT_L(0); PG8_MMA(1, 0, At, B0); PG8_BAR; PG8_SCHED;
            PG8_STAGE(PG8_SB(1, 1), b3 + hstepB, voffB);
            PG8_WAIT_V(6); PG8_BAR; PG8_MMA(1, 1, At, B1); PG8_BAR;
        }
        E(acc, cur, wr, wc, fr, fq);
        if (!has_next) break;
#pragma unroll
        for (int a = 0; a < 2; ++a)
#pragma unroll
            for (int b = 0; b < 2; ++b)
#pragma unroll
                for (int m = 0; m < 4; ++m)
#pragma unroll
                    for (int n = 0; n < 2; ++n) acc[a][b][m][n] = (f32x4){0.f, 0.f, 0.f, 0.f};
        cur = nxt; cA = nA; cB = nB; ++ui;
    }
    PG8_WAIT_V(0);
    if (wr == 0) PG8_BAR;
    PG8_BAR;
#undef PG8_SA
#undef PG8_SB
#undef PG8_STAGE
#undef PG8_LDA
#undef PG8_LDB
#undef PG8_MMA
#undef PG8_WAIT_V
#undef PG8_WAIT_L
#undef PG8_BAR
#undef PG8_SCHED
#undef PG8_BBASE
}
}
#define XB_TMO      128
#define XB_XCNT(j)  (256  + 64 * (j))
#define XB_XSUB(j)  (1280 + 64 * (j))
#define XB_XGEN(j)  (2304 + 64 * (j))
#define XB_TOP      3328
#define XB_TOPGEN   3392
#define XCD_BAR_WORDS 3456
#define XB_SPIN_CAP (1u << 22)
__device__ __forceinline__ unsigned xb_ld(unsigned* p)              { return __hip_atomic_load(p, __ATOMIC_RELAXED, __HIP_MEMORY_SCOPE_AGENT); }
__device__ __forceinline__ unsigned xb_add(unsigned* p, unsigned v) { return __hip_atomic_fetch_add(p, v, __ATOMIC_RELAXED, __HIP_MEMORY_SCOPE_AGENT); }
__device__ __forceinline__ unsigned xb_xcc_id() { return (unsigned)__builtin_amdgcn_s_getreg((3 << 11) | 20) & 0xFu; }
#define XB_SPIN(cond, bar) do { unsigned _sp = 0; while (cond) { __builtin_amdgcn_s_sleep(1); \
    if ((++_sp & 255u) == 0u) { if (xb_ld(&(bar)[XB_TMO])) break; if (_sp > XB_SPIN_CAP) { atomicAdd(&(bar)[XB_TMO], 1u); break; } } } } while (0)
struct XcdBarrier { unsigned* bar; unsigned x; volatile LAS unsigned* st; };
__device__ __forceinline__ XcdBarrier xcd_barrier_post(unsigned* bar, volatile LAS unsigned* st) {
    XcdBarrier b; b.bar = bar; b.x = xb_xcc_id(); b.st = st;
    if (threadIdx.x == 0) (void)xb_add(&bar[XB_XCNT(b.x)], 1u);
    return b;
}
__device__ __forceinline__ void xcd_barrier_complete(unsigned* bar, unsigned x, unsigned& nloc, unsigned& nx) {
    const unsigned G = gridDim.x * gridDim.y * gridDim.z;
    unsigned sum, cnt, mine, sp = 0u;
    for (;;) {
        sum = 0u; cnt = 0u; mine = 0u;
#pragma unroll
        for (unsigned j = 0; j < 16; ++j) { const unsigned c = xb_ld(&bar[XB_XCNT(j)]); sum += c; cnt += (c > 0u) ? 1u : 0u; mine = (j == x) ? c : mine; }
        if (sum == G) break;
        __builtin_amdgcn_s_sleep(1);
        if ((++sp & 255u) == 0u) { if (xb_ld(&bar[XB_TMO])) break; if (sp > XB_SPIN_CAP) { atomicAdd(&bar[XB_TMO], 1u); break; } }
    }
    nloc = mine > 0u ? mine : 1u; nx = cnt > 0u ? cnt : 1u;
}
__device__ __forceinline__ void xcd_barrier(const XcdBarrier& b) {
    asm volatile("s_waitcnt vmcnt(0)" ::: "memory");
    __syncthreads();
    if (threadIdx.x == 0) {
        unsigned* bar = b.bar;
        __builtin_amdgcn_s_waitcnt(0);
        unsigned nloc = b.st[0], nx = b.st[1];
        if (nloc == 0u) { xcd_barrier_complete(bar, b.x, nloc, nx); b.st[0] = nloc; b.st[1] = nx; }
        const unsigned old = xb_add(&bar[XB_XSUB(b.x)], 1u);
        const unsigned gen = old / nloc;
        if (old + 1u == (gen + 1u) * nloc) {
            __builtin_amdgcn_fence(__ATOMIC_RELEASE, "agent");
            asm volatile("s_waitcnt vmcnt(0)" ::: "memory");
            const unsigned og = xb_add(&bar[XB_TOP], 1u);
            const unsigned tg = og / nx;
            if (og + 1u == (tg + 1u) * nx) xb_add(&bar[XB_TOPGEN], 1u);
            else XB_SPIN(xb_ld(&bar[XB_TOPGEN]) == tg, bar);
            __builtin_amdgcn_fence(__ATOMIC_ACQUIRE, "agent");
            xb_add(&bar[XB_XGEN(b.x)], 1u);
            asm volatile("s_waitcnt vmcnt(0)" ::: "memory");
        } else {
            XB_SPIN(xb_ld(&bar[XB_XGEN(b.x)]) == gen, bar);
            __builtin_amdgcn_fence(__ATOMIC_ACQUIRE, "agent");
            asm volatile("s_waitcnt vmcnt(0)" ::: "memory");
        }
    }
    __syncthreads();
}

enum { EM_IN0 = 0, EM_PLAIN = 1, EM_S5A = 2, EM_S5B = 3, EM_GLU = 4, EM_OUT = 5, EM_IN1 = 6 };
template <int mode> struct EpiMulti {
    int ldc;
    bf16_t* o0; bf16_t* o1; float* f0;
    const bf16_t* i0; const bf16_t* i1; const float* c0; const float* c1;
    unsigned char* ws;
    __device__ __forceinline__ void operator()(const f32x4 (&acc)[2][2][4][2], const pg8::Unit& u, int wr, int wc, int fr, int fq) const {
        const int rowb = u.pm * 256 + wr * 64 + fr;
        const int colb = u.pn * 256 + wc * 32 + 8 * fq;
#pragma unroll
        for (int ai = 0; ai < 2; ++ai)
#pragma unroll
            for (int m = 0; m < 4; ++m) {
                const int row = rowb + ai * 128 + m * 16;
                float ssq = 0.f;
#pragma unroll
                for (int bj = 0; bj < 2; ++bj) {
                    const int c = colb + bj * 128;
                    f32x4 v0 = acc[ai][bj][m][0], v1 = acc[ai][bj][m][1];
                    if constexpr (mode == EM_PLAIN) {
                        u32x4 w; w.x = cvt_pk_bf16(v0[0], v0[1]); w.y = cvt_pk_bf16(v0[2], v0[3]); w.z = cvt_pk_bf16(v1[0], v1[1]); w.w = cvt_pk_bf16(v1[2], v1[3]);
                        *(u32x4*)(o0 + (size_t)row * ldc + c) = w;
                    } else if constexpr (mode == EM_IN0) {
                        u32x4 w; w.x = cvt_pk_bf16(v0[0], v0[1]); w.y = cvt_pk_bf16(v0[2], v0[3]); w.z = cvt_pk_bf16(v1[0], v1[1]); w.w = cvt_pk_bf16(v1[2], v1[3]);
                        if (c < 512) {
                            const int g = c >> 4, b = row >> 11, l = row & 2047;
                            *(u32x4*)(o1 + ((size_t)((g * 16 + b) * 2048 + l)) * 16 + (c & 15)) = w;
                        } else {
                            *(u32x4*)(o0 + (size_t)row * 1536 + (c - 512)) = w;
                        }
                    } else if constexpr (mode == EM_S5A) {
                        if (c < 512) {
                            u32x4 w; w.x = cvt_pk_bf16(v0[0], v0[1]); w.y = cvt_pk_bf16(v0[2], v0[3]); w.z = cvt_pk_bf16(v1[0], v1[1]); w.w = cvt_pk_bf16(v1[2], v1[3]);
                            *(u32x4*)(o0 + (size_t)row * 512 + c) = w;
                        } else if (c < 640) {
                            float* p = f0 + (size_t)row * 128 + (c - 512);
                            *(f32x4*)p = v0; *(f32x4*)(p + 4) = v1;
                        }
                    } else if constexpr (mode == EM_S5B) {
                        const size_t idx = (size_t)row * 512 + c;
                        const u32x4 yl = *(const u32x4*)(i0 + idx), uu = *(const u32x4*)(i1 + idx);
                        const int g = row >> 10, b = (row >> 6) & 15, ck = row & 63, t = c >> 4, ch = c & 15;
                        const f32x4 d0 = *(const f32x4*)(c0 + g * 16 + ch), d1 = *(const f32x4*)(c0 + g * 16 + ch + 4);
                        float y[8];
                        y[0] = v0[0] + bflo(yl.x) + d0[0] * bflo(uu.x); y[1] = v0[1] + bfhi(yl.x) + d0[1] * bfhi(uu.x);
                        y[2] = v0[2] + bflo(yl.y) + d0[2] * bflo(uu.y); y[3] = v0[3] + bfhi(yl.y) + d0[3] * bfhi(uu.y);
                        y[4] = v1[0] + bflo(yl.z) + d1[0] * bflo(uu.z); y[5] = v1[1] + bfhi(yl.z) + d1[1] * bfhi(uu.z);
                        y[6] = v1[2] + bflo(yl.w) + d1[2] * bflo(uu.w); y[7] = v1[3] + bfhi(yl.w) + d1[3] * bfhi(uu.w);
#pragma unroll
                        for (int j = 0; j < 8; ++j) y[j] = gelu_tanh_f(y[j]);
                        u32x4 w; w.x = cvt_pk_bf16(y[0], y[1]); w.y = cvt_pk_bf16(y[2], y[3]); w.z = cvt_pk_bf16(y[4], y[5]); w.w = cvt_pk_bf16(y[6], y[7]);
                        const size_t tok = (size_t)b * 2048 + ck * 32 + t;
                        *(u32x4*)(o0 + tok * 512 + g * 16 + ch) = w;
                        asm volatile("" ::: "memory");
                    } else if constexpr (mode == EM_GLU) {
                        const u32x4 gg = *(const u32x4*)(i0 + (size_t)row * 512 + c), zz = *(const u32x4*)(i1 + (size_t)row * 1536 + c);
                        const f32x4 b0 = *(const f32x4*)(c0 + c), b1 = *(const f32x4*)(c0 + c + 4);
                        float y[8];
                        y[0] = bflo(gg.x) * sigmoid_f(v0[0] + b0[0]) * silu_f(bflo(zz.x)); y[1] = bfhi(gg.x) * sigmoid_f(v0[1] + b0[1]) * silu_f(bfhi(zz.x));
                        y[2] = bflo(gg.y) * sigmoid_f(v0[2] + b0[2]) * silu_f(bflo(zz.y)); y[3] = bfhi(gg.y) * sigmoid_f(v0[3] + b0[3]) * silu_f(bfhi(zz.y));
                        y[4] = bflo(gg.z) * sigmoid_f(v1[0] + b1[0]) * silu_f(bflo(zz.z)); y[5] = bfhi(gg.z) * sigmoid_f(v1[1] + b1[1]) * silu_f(bfhi(zz.z));
                        y[6] = bflo(gg.w) * sigmoid_f(v1[2] + b1[2]) * silu_f(bflo(zz.w)); y[7] = bfhi(gg.w) * sigmoid_f(v1[3] + b1[3]) * silu_f(bfhi(zz.w));
                        u32x4 w; w.x = cvt_pk_bf16(y[0], y[1]); w.y = cvt_pk_bf16(y[2], y[3]); w.z = cvt_pk_bf16(y[4], y[5]); w.w = cvt_pk_bf16(y[6], y[7]);
                        *(u32x4*)(o0 + (size_t)row * 1024 + c) = w;
                    } else if constexpr (mode == EM_OUT) {
                        u32x4 w; w.x = cvt_pk_bf16(v0[0], v0[1]); w.y = cvt_pk_bf16(v0[2], v0[3]); w.z = cvt_pk_bf16(v1[0], v1[1]); w.w = cvt_pk_bf16(v1[2], v1[3]);
                        *(u32x4*)(o0 + (size_t)row * 1024 + c) = w;
                        ssq += (v0[0] * v0[0] + v0[1] * v0[1]) + (v0[2] * v0[2] + v0[3] * v0[3]) + (v1[0] * v1[0] + v1[1] * v1[1]) + (v1[2] * v1[2] + v1[3] * v1[3]);
                    } else {
                        const int blk = c >> 9, cc = c & 511, b = row >> 11, l = row & 2047;
                        f32x4 r0 = v0, r1 = v1;
                        if (blk == 0 || blk == 1 || blk == 4 || blk == 5) {
                            const int j0 = ((cc & 63) >> 3) * 4;
                            const f32x4 cs = *(const f32x4*)(c0 + l * 32 + j0), sn = *(const f32x4*)(c1 + l * 32 + j0);
#pragma unroll
                            for (int e = 0; e < 4; ++e) { r0[e] = v0[e] * cs[e] - v1[e] * sn[e]; r1[e] = v1[e] * cs[e] + v0[e] * sn[e]; }
                        }
                        u32x4 w; w.x = cvt_pk_bf16(r0[0], r0[1]); w.y = cvt_pk_bf16(r0[2], r0[3]); w.z = cvt_pk_bf16(r1[0], r1[1]); w.w = cvt_pk_bf16(r1[2], r1[3]);
                        if (blk == 3 || blk >= 6) {
                            bf16_t* base = (bf16_t*)(ws + (blk == 3 ? WS_CZ : blk == 6 ? WS_DVTMP : WS_DZ));
                            *(u32x4*)(base + (size_t)row * 512 + cc) = w;
                        } else {
                            bf16_t* base = (bf16_t*)(ws + (blk == 0 ? WS_CQ : blk == 1 ? WS_CK : blk == 2 ? WS_CVTMP : blk == 4 ? WS_DQ : WS_DK));
                            *(u32x4*)(base + ((size_t)((b * 8 + (cc >> 6)) * 2048 + l)) * 64 + (cc & 63)) = w;
                        }
                    }
                }
                if constexpr (mode == EM_OUT) {
                    ssq += __shfl_xor(ssq, 16); ssq += __shfl_xor(ssq, 32);
                    if (fq == 0) f0[(size_t)row * 16 + u.pn * 4 + wc] = ssq;
                }
                asm volatile("" ::: "memory");
            }
    }
};
struct Params { const float* in[31]; float* out; unsigned char* ws; int ph_lo, ph_hi; int rep_mask, pad; };
struct Ctx {
    const float* const* in; float* out; unsigned char* ws;
    LAS unsigned char* lds; int tid, lane, wid, G, bid;
};
#define WSP(T, off) ((T*)(C.ws + (off)))

DEVI void rows_pass(const Ctx& C, int mode) {
    const float* x = C.in[0];
    const float* pre = C.in[1]; const float* post = C.in[2];
    const bf16_t* Y0 = WSP(const bf16_t, WS_Y0); const bf16_t* Y1 = WSP(const bf16_t, WS_Y1);
    const float* SS0 = WSP(const float, WS_SS0); const float* SS1 = WSP(const float, WS_SS1);
    bf16_t* XN = (mode == 0) ? WSP(bf16_t, WS_XN) : WSP(bf16_t, WS_XN1);
    const int gw = C.bid * 8 + C.wid, nw = C.G * 8, lane = C.lane;
    for (int r = gw; r < NT; r += nw) {
        f32x4 v[4];
#pragma unroll
        for (int i = 0; i < 4; ++i) v[i] = *(const f32x4*)(x + (size_t)r * 1024 + i * 256 + lane * 4);
        if (mode >= 1) {
            float s0 = (lane < 16) ? SS0[(size_t)r * 16 + lane] : 0.f; s0 = wave_sum(s0);
            const float rs0 = rsqrtf(s0 * (1.0f / 1024.0f) + 1e-6f);
#pragma unroll
            for (int i = 0; i < 4; ++i) {
                const u32x2 y = *(const u32x2*)(Y0 + (size_t)r * 1024 + i * 256 + lane * 4);
                const f32x4 gp = *(const f32x4*)(post + i * 256 + lane * 4);
                v[i][0] += bflo(y.x) * rs0 * gp[0]; v[i][1] += bfhi(y.x) * rs0 * gp[1]; v[i][2] += bflo(y.y) * rs0 * gp[2]; v[i][3] += bfhi(y.y) * rs0 * gp[3];
            }
        }
        if (mode == 2) {
            float s1 = (lane < 16) ? SS1[(size_t)r * 16 + lane] : 0.f; s1 = wave_sum(s1);
            const float rs1 = rsqrtf(s1 * (1.0f / 1024.0f) + 1e-6f);
#pragma unroll
            for (int i = 0; i < 4; ++i) {
                const u32x2 y = *(const u32x2*)(Y1 + (size_t)r * 1024 + i * 256 + lane * 4);
                const f32x4 gp = *(const f32x4*)(post + 1024 + i * 256 + lane * 4);
                f32x4 o = v[i];
                o[0] += bflo(y.x) * rs1 * gp[0]; o[1] += bfhi(y.x) * rs1 * gp[1]; o[2] += bflo(y.y) * rs1 * gp[2]; o[3] += bfhi(y.y) * rs1 * gp[3];
                *(f32x4*)(C.out + (size_t)r * 1024 + i * 256 + lane * 4) = o;
            }
        } else {
            float ss = 0.f;
#pragma unroll
            for (int i = 0; i < 4; ++i) ss += (v[i][0] * v[i][0] + v[i][1] * v[i][1]) + (v[i][2] * v[i][2] + v[i][3] * v[i][3]);
            ss = wave_sum(ss);
            const float rs = rsqrtf(ss * (1.0f / 1024.0f) + 1e-6f);
            const float* gpre = pre + (mode == 0 ? 0 : 1024);
#pragma unroll
            for (int i = 0; i < 4; ++i) {
                const f32x4 gp = *(const f32x4*)(gpre + i * 256 + lane * 4);
                u32x2 w; w.x = cvt_pk_bf16(v[i][0] * rs * gp[0], v[i][1] * rs * gp[1]); w.y = cvt_pk_bf16(v[i][2] * rs * gp[2], v[i][3] * rs * gp[3]);
                *(u32x2*)(XN + (size_t)r * 1024 + i * 256 + lane * 4) = w;
            }
        }
    }
}

DEVI int rope_dim(int p) { return ((p & 7) < 4) ? (4 * (p >> 3) + (p & 7)) : (32 + 4 * (p >> 3) + ((p & 7) - 4)); }
DEVI void wt_tile(const Ctx& C, const float* W, int K, int N, bf16_t* Wt, int tile, bool rope_perm) {
    LAS float* T = (LAS float*)C.lds;
    const int ntn = N / 64, tk = tile / ntn, tn = tile % ntn, k0 = tk * 64, n0 = tn * 64, tid = C.tid;
    __syncthreads();
#pragma unroll
    for (int i = 0; i < 2; ++i) { const int e = tid + i * 512, r = e >> 4, c4 = (e & 15) * 4;
        const f32x4 v = *(const f32x4*)(W + (size_t)(k0 + r) * N + n0 + c4);
        T[r * 65 + c4 + 0] = v[0]; T[r * 65 + c4 + 1] = v[1]; T[r * 65 + c4 + 2] = v[2]; T[r * 65 + c4 + 3] = v[3]; }
    __syncthreads();
    const int nn = tid >> 3, kc = (tid & 7) * 8;
    bool perm = false;
    if (rope_perm) { const int blk = n0 >> 9; perm = (blk == 0 || blk == 1 || blk == 4 || blk == 5); }
    const int src = perm ? rope_dim(nn) : nn;
    float f[8];
#pragma unroll
    for (int j = 0; j < 8; ++j) f[j] = T[(kc + j) * 65 + src];
    u32x4 w; w.x = cvt_pk_bf16(f[0], f[1]); w.y = cvt_pk_bf16(f[2], f[3]); w.z = cvt_pk_bf16(f[4], f[5]); w.w = cvt_pk_bf16(f[6], f[7]);
    *(u32x4*)(Wt + (size_t)(n0 + nn) * K + k0 + kc) = w;
}

DEVI void s5_tables(const Ctx& C, int g, int part) {
    LAS float* APr = (LAS float*)C.lds;
    LAS float* APi = APr + 64 * 33;
    LAS float* BBr = APi + 64 * 33;
    LAS float* BBi = BBr + 1024;
    LAS float* Cr = BBi + 1024;
    LAS float* Ci = Cr + 1024;
    LAS float* KL = Ci + 1024;
    const int tid = C.tid;
    const float* lre = C.in[4]; const float* lim = C.in[5]; const float* ldt = C.in[6];
    const float* bre = C.in[7]; const float* bim = C.in[8]; const float* cre = C.in[9]; const float* cim = C.in[10];
    __syncthreads();
    if (tid < 64) {
        const int p = tid;
        const float lr = lre[g * 64 + p], li = lim[g * 64 + p], dt = expf(ldt[g]);
        const float mag = expf(lr * dt);
        const float ar = mag * cosf(li * dt), ai = mag * sinf(li * dt);
        const float den = lr * lr + li * li;
        const float fr = ((ar - 1.0f) * lr + ai * li) / den, fi = (ai * lr - (ar - 1.0f) * li) / den;
        double pr = 1.0, pi = 0.0;
        for (int k = 0; k <= 32; ++k) { APr[p * 33 + k] = (float)pr; APi[p * 33 + k] = (float)pi; const double nr = pr * (double)ar - pi * (double)ai, ni = pr * (double)ai + pi * (double)ar; pr = nr; pi = ni; }
        for (int c = 0; c < 16; ++c) { const float br = bre[(g * 64 + p) * 16 + c], bi = bim[(g * 64 + p) * 16 + c]; BBr[p * 16 + c] = fr * br - fi * bi; BBi[p * 16 + c] = fr * bi + fi * br; }
    }
    for (int e = tid; e < 1024; e += 512) { Cr[e] = cre[g * 1024 + e]; Ci[e] = cim[g * 1024 + e]; }
    __syncthreads();
    for (int e = tid; e < 8192; e += 512) {
        const int k = e >> 8, c = (e >> 4) & 15, cp = e & 15; float s = 0.f;
        for (int p = 0; p < 64; ++p) { const float a_r = APr[p * 33 + k], a_i = APi[p * 33 + k], c_r = Cr[c * 64 + p], c_i = Ci[c * 64 + p];
            const float car = c_r * a_r - c_i * a_i, cai = c_r * a_i + c_i * a_r; s += car * BBr[p * 16 + cp] - cai * BBi[p * 16 + cp]; }
        KL[e] = s;
    }
    __syncthreads();
    bf16_t* A5 = WSP(bf16_t, WS_BT5A) + (size_t)g * 768 * 512;
    bf16_t* B5 = WSP(bf16_t, WS_BT5B) + (size_t)g * 512 * 256;
    for (int e = tid; e < 96 * 64; e += 512) {
        const int R = part * 96 + (e >> 6), col0 = (e & 63) * 8; float f[8];
        if (R < 512) { const int t = R >> 4, c = R & 15, s = col0 >> 4, cp0 = col0 & 15;
#pragma unroll
            for (int j = 0; j < 8; ++j) f[j] = (s <= t) ? KL[(t - s) * 256 + c * 16 + cp0 + j] : 0.f;
        } else if (R < 640) { const int pp = R - 512, p = pp >> 1, ri = pp & 1, s = col0 >> 4, cp0 = col0 & 15;
            const float a_r = APr[p * 33 + (31 - s)], a_i = APi[p * 33 + (31 - s)];
#pragma unroll
            for (int j = 0; j < 8; ++j) { const float b_r = BBr[p * 16 + cp0 + j], b_i = BBi[p * 16 + cp0 + j]; f[j] = ri ? (a_r * b_i + a_i * b_r) : (a_r * b_r - a_i * b_i); }
        } else {
#pragma unroll
            for (int j = 0; j < 8; ++j) f[j] = 0.f;
        }
        u32x4 w; w.x = cvt_pk_bf16(f[0], f[1]); w.y = cvt_pk_bf16(f[2], f[3]); w.z = cvt_pk_bf16(f[4], f[5]); w.w = cvt_pk_bf16(f[6], f[7]);
        *(u32x4*)(A5 + (size_t)R * 512 + col0) = w;
    }
    for (int e = tid; e < 64 * 32; e += 512) {
        const int R = part * 64 + (e >> 5), col0 = (e & 31) * 8, t = R >> 4, c = R & 15; float f[8];
        if (col0 < 128) {
#pragma unroll
            for (int j = 0; j < 4; ++j) { const int p = (col0 >> 1) + j; const float a_r = APr[p * 33 + t + 1], a_i = APi[p * 33 + t + 1], c_r = Cr[c * 64 + p], c_i = Ci[c * 64 + p];
                f[2 * j] = c_r * a_r - c_i * a_i; f[2 * j + 1] = -(c_r * a_i + c_i * a_r); }
        } else {
#pragma unroll
            for (int j = 0; j < 8; ++j) f[j] = 0.f;
        }
        u32x4 w; w.x = cvt_pk_bf16(f[0], f[1]); w.y = cvt_pk_bf16(f[2], f[3]); w.z = cvt_pk_bf16(f[4], f[5]); w.w = cvt_pk_bf16(f[6], f[7]);
        *(u32x4*)(B5 + (size_t)R * 256 + col0) = w;
    }
    if (part == 0 && tid < 64) { f32x2 a; a.x = APr[tid * 33 + 32]; a.y = APi[tid * 33 + 32]; WSP(f32x2, WS_A32)[g * 64 + tid] = a; }
}

DEVI void phase_prologue(const Ctx& C) {
    const int tid = C.tid, G = C.G, bid = C.bid;
    {
        const int t0 = 16 * 32, t1 = t0 + 16 * 16, t2 = t1 + 16 * 64, t3 = t2 + 16 * 16, t4 = t3 + 8 * 8;
        for (int j = bid; j < t4; j += G) {
            if (j < t0) wt_tile(C, C.in[3], 1024, 2048, WSP(bf16_t, WS_WIN0), j, false);
            else if (j < t1) wt_tile(C, C.in[23], 1024, 1024, WSP(bf16_t, WS_WOUT0), j - t0, false);
            else if (j < t2) wt_tile(C, C.in[24], 1024, 4096, WSP(bf16_t, WS_WIN1), j - t1, true);
            else if (j < t3) wt_tile(C, C.in[30], 1024, 1024, WSP(bf16_t, WS_WOUT1), j - t2, false);
            else wt_tile(C, C.in[12], 512, 512, WSP(bf16_t, WS_GLU), j - t3, false);
        }
    }
    for (int j = bid; j < 256; j += G) s5_tables(C, j >> 3, j & 7);
    const int gt = bid * 512 + tid, ngt = G * 512;
    {
        const float* wq = C.in[16]; const float* wk = C.in[17]; const float* wv = C.in[18];
        bf16_t* WQK = WSP(bf16_t, WS_WQK); bf16_t* WV = WSP(bf16_t, WS_WV);
        for (int e = gt; e < 1536 * 512; e += ngt) {
            const int n = e >> 9, k = e & 511; const int nn = n & 511, h = nn >> 7, ee = nn & 127; float v = 0.f;
            if ((k >> 7) == h) { const int d = k & 127; const size_t wi = ((size_t)h * 128 + d) * 128 + ee;
                v = (n < 512) ? wq[wi] : (n < 1024) ? wk[wi] * 0.08838834764831845f : wv[wi]; }
            if (n < 1024) WQK[(size_t)n * 512 + k] = f2bf(v); else WV[(size_t)(n - 1024) * 512 + k] = f2bf(v);
        }
        const float* gw = C.in[19]; float* GF = WSP(float, WS_GF);
        for (int e = gt; e < 1024 * 8; e += ngt) {
            const int rr = e >> 3, j = e & 7, ch = rr & 511, h = ch >> 7, d = ch & 127; float s = 0.f;
            if (rr < 512) { for (int ee = 0; ee < 128; ++ee) { const size_t wi = ((size_t)h * 128 + d) * 128 + ee; s += wq[wi] * gw[(size_t)(h * 128 + ee) * 8 + j] + wk[wi] * gw[(size_t)(512 + h * 128 + ee) * 8 + j]; } }
            else { for (int ee = 0; ee < 128; ++ee) { const size_t wi = ((size_t)h * 128 + d) * 128 + ee; s += wv[wi] * gw[(size_t)(1024 + h * 128 + ee) * 8 + j]; } }
            GF[e] = s;
        }
    }
    {
        float* RC = WSP(float, WS_ROPE_C); float* RS = WSP(float, WS_ROPE_S);
        for (int e = gt; e < 2048 * 32; e += ngt) { const int pos = e >> 5, j = e & 31; const float inv = powf(10000.0f, -(float)(2 * j) / 64.0f); const float ang = (float)pos * inv; RC[e] = cosf(ang); RS[e] = sinf(ang); }
    }
    if (bid == 0 && tid == 0) {
        float s1 = 0.f, s2 = 0.f; for (int j = 0; j < 64; ++j) { s1 += C.in[25][j] * C.in[26][j]; s2 += C.in[27][j] * C.in[28][j]; }
        WSP(float, WS_LAM)[0] = expf(s1) - expf(s2) + (0.8f - 0.6f * expf(-0.3f));
    }
    rows_pass(C, 0);
}

DEVI void phase_conv_gates(const Ctx& C) {
    const bf16_t* PZ = WSP(const bf16_t, WS_PZ); bf16_t* XC = WSP(bf16_t, WS_XC);
    float* LI = WSP(float, WS_LI); float* LF = WSP(float, WS_LF);
    const float* cw = C.in[14]; const float* cb = C.in[15]; const float* gb = C.in[20];
    LAS float* GFs = (LAS float*)C.lds;
    __syncthreads();
    for (int e = C.tid; e < 8192; e += 512) GFs[e] = WSP(const float, WS_GF)[e];
    __syncthreads();
    const int lane = C.lane, ch0 = lane * 8;
    float w[4][8], bb[8];
#pragma unroll
    for (int j = 0; j < 4; ++j)
#pragma unroll
        for (int i = 0; i < 8; ++i) w[j][i] = cw[j * 512 + ch0 + i];
#pragma unroll
    for (int i = 0; i < 8; ++i) bb[i] = cb[ch0 + i];
    const int gw = C.bid * 8 + C.wid, nw = C.G * 8;
    for (int r = gw; r < NT; r += nw) {
        const int l = r & 2047;
        float xs[4][8];
#pragma unroll
        for (int j = 0; j < 4; ++j) {
            const int dl = 3 - j;
            if (l - dl >= 0) { const u32x4 q = *(const u32x4*)(PZ + (size_t)(r - dl) * 1536 + 512 + ch0);
                xs[j][0] = bflo(q.x); xs[j][1] = bfhi(q.x); xs[j][2] = bflo(q.y); xs[j][3] = bfhi(q.y); xs[j][4] = bflo(q.z); xs[j][5] = bfhi(q.z); xs[j][6] = bflo(q.w); xs[j][7] = bfhi(q.w); }
            else {
#pragma unroll
                for (int i = 0; i < 8; ++i) xs[j][i] = 0.f; }
        }
        float xc[8];
#pragma unroll
        for (int i = 0; i < 8; ++i) { const float a = bb[i] + xs[0][i] * w[0][i] + xs[1][i] * w[1][i] + xs[2][i] * w[2][i] + xs[3][i] * w[3][i]; xc[i] = silu_f(a); }
        u32x4 o; o.x = cvt_pk_bf16(xc[0], xc[1]); o.y = cvt_pk_bf16(xc[2], xc[3]); o.z = cvt_pk_bf16(xc[4], xc[5]); o.w = cvt_pk_bf16(xc[6], xc[7]);
        *(u32x4*)(XC + (size_t)r * 512 + ch0) = o;
        float gt8[8];
#pragma unroll
        for (int j = 0; j < 8; ++j) gt8[j] = 0.f;
#pragma unroll
        for (int i = 0; i < 8; ++i) {
            const f32x4 a0 = *(const LAS f32x4*)(GFs + (ch0 + i) * 8), a1 = *(const LAS f32x4*)(GFs + (ch0 + i) * 8 + 4);
            const f32x4 b0 = *(const LAS f32x4*)(GFs + (512 + ch0 + i) * 8), b1 = *(const LAS f32x4*)(GFs + (512 + ch0 + i) * 8 + 4);
            const float xcv = xc[i], xmv = xs[3][i];
            gt8[0] += xcv * a0[0] + xmv * b0[0]; gt8[1] += xcv * a0[1] + xmv * b0[1]; gt8[2] += xcv * a0[2] + xmv * b0[2]; gt8[3] += xcv * a0[3] + xmv * b0[3];
            gt8[4] += xcv * a1[0] + xmv * b1[0]; gt8[5] += xcv * a1[1] + xmv * b1[1]; gt8[6] += xcv * a1[2] + xmv * b1[2]; gt8[7] += xcv * a1[3] + xmv * b1[3];
        }
#pragma unroll
        for (int j = 0; j < 8; ++j) gt8[j] = wave_sum(gt8[j]);
        if (lane < 8) {
            float gsel = gt8[0];
#pragma unroll
            for (int j = 1; j < 8; ++j) gsel = (lane == j) ? gt8[j] : gsel;
            gsel += gb[lane];
            const int b = r >> 11;
            if (lane < 4) LI[(size_t)(b * 4 + lane) * 2048 + l] = gsel;
            else { const float ax = fabsf(gsel); const float ls = fminf(gsel, 0.f) - log1pf(expf(-ax)); LF[(size_t)(b * 4 + lane - 4) * 2048 + l] = ls; }
        }
    }
}

DEVI void transpose_tok(const Ctx& C, const bf16_t* src, bf16_t* dst, int mode) {
    LAS unsigned* T = (LAS unsigned*)C.lds;
    LAS bf16_t* Ts = (LAS bf16_t*)C.lds;
    const int tid = C.tid;
    for (int tile = C.bid; tile < (NT / 64) * 8; tile += C.G) {
        const int tt = tile >> 3, cblk = tile & 7, tok0 = tt * 64, ch0 = cblk * 64;
        __syncthreads();
        { const int r = tid >> 3, cc = (tid & 7) * 8;
          const u32x4 q = *(const u32x4*)(src + (size_t)(tok0 + r) * 512 + ch0 + cc);
          const unsigned wv[4] = {q.x, q.y, q.z, q.w};
#pragma unroll
          for (int j = 0; j < 4; ++j) { Ts[(cc + 2 * j) * 66 + r] = (bf16_t)(wv[j] & 0xffffu); Ts[(cc + 2 * j + 1) * 66 + r] = (bf16_t)(wv[j] >> 16); } }
        __syncthreads();
        { const int c = tid >> 3, tc = (tid & 7) * 8;
          const int ch = ch0 + c, b = tok0 >> 11, l0 = (tok0 & 2047) + tc;
          if (mode == 0) {
              u32x4 w; w.x = T[c * 33 + (tc >> 1)]; w.y = T[c * 33 + (tc >> 1) + 1]; w.z = T[c * 33 + (tc >> 1) + 2]; w.w = T[c * 33 + (tc >> 1) + 3];
              const int h = ch >> 7, dv = ch & 127;
              *(u32x4*)(dst + ((size_t)((b * 4 + h) * 128 + dv)) * 2048 + l0) = w;
          } else {
              const int h = ch >> 6, dv = ch & 63;
#pragma unroll
              for (int j = 0; j < 8; ++j) { const int l = l0 + j; dst[((size_t)(((b * 8 + h) * 64 + dv) * 16 + (l & 15))) * 128 + (l >> 4)] = Ts[c * 66 + tc + j]; }
          } }
    }
}

DEVI void phase_mid0(const Ctx& C) {
    const int gw = C.bid * 8 + C.wid, lane = C.lane;
    if (gw < 64) {
        const float* LF = WSP(const float, WS_LF) + (size_t)gw * 2048; const float* LI = WSP(const float, WS_LI) + (size_t)gw * 2048;
        float* BC = WSP(float, WS_BC) + (size_t)gw * 2048; float* DS = WSP(float, WS_DS) + (size_t)gw * 2048;
        float tot = 0.f;
        for (int j = 0; j < 32; ++j) tot += LF[lane * 32 + j];
        float inc = tot;
#pragma unroll
        for (int d = 1; d < 64; d <<= 1) { const float o = __shfl_up(inc, d); if (lane >= d) inc += o; }
        float run = inc - tot;
        for (int j = 0; j < 32; ++j) { run += LF[lane * 32 + j]; BC[lane * 32 + j] = run; DS[lane * 32 + j] = LI[lane * 32 + j] - run; }
    }
    {
        const float* XLOC = WSP(const float, WS_XLOC); bf16_t* XST = WSP(bf16_t, WS_XST); const f32x2* A32 = WSP(const f32x2, WS_A32);
        for (int e = C.bid * 512 + C.tid; e < 32 * 16 * 64; e += C.G * 512) {
            const int p = e & 63, gb = e >> 6, g = gb >> 4;
            const f32x2 a = A32[g * 64 + p]; float xr = 0.f, xi = 0.f;
            for (int i = 0; i < 64; ++i) {
                const size_t n = (size_t)gb * 64 + i;
                *(unsigned*)(XST + n * 256 + 2 * p) = cvt_pk_bf16(xr, xi);
                *(unsigned*)(XST + n * 256 + 128 + 2 * p) = 0u;
                const f32x2 lc = *(const f32x2*)(XLOC + n * 128 + 2 * p);
                const float nr = a.x * xr - a.y * xi + lc.x, ni = a.x * xi + a.y * xr + lc.y; xr = nr; xi = ni;
            }
        }
    }
}
constexpr float NEG_INF = -__builtin_inff();

template <int NDT>
DEVI void osm_update(float (&s)[8], float& m, float& l, f32x4 (&o)[NDT], bf16x8& pf) {
    float mx = fmaxf(fmaxf(fmaxf(s[0], s[1]), fmaxf(s[2], s[3])), fmaxf(fmaxf(s[4], s[5]), fmaxf(s[6], s[7])));
    mx = fmaxf(mx, __shfl_xor(mx, 16)); mx = fmaxf(mx, __shfl_xor(mx, 32));
    const float mn = fmaxf(m, mx);
    const float mref = (mn == NEG_INF) ? 0.f : mn;
    const float alpha = fast_exp2(m - mref);
    float p[8]; float ps = 0.f;
#pragma unroll
    for (int i = 0; i < 8; ++i) { p[i] = fast_exp2(s[i] - mref); ps += p[i]; }
    l = l * alpha + ps; m = mn;
#pragma unroll
    for (int d = 0; d < NDT; ++d) o[d] *= alpha;
    u32x4 w; w.x = cvt_pk_bf16(p[0], p[1]); w.y = cvt_pk_bf16(p[2], p[3]); w.z = cvt_pk_bf16(p[4], p[5]); w.w = cvt_pk_bf16(p[6], p[7]);
    pf = __builtin_bit_cast(bf16x8, w);
}

DEVI bf16x8 ld_vt(const bf16_t* lo, const bf16_t* hi) {
    const u32x2 a = *(const u32x2*)lo, b = *(const u32x2*)hi; u32x4 w; w.x = a.x; w.y = a.y; w.z = b.x; w.w = b.y; return __builtin_bit_cast(bf16x8, w);
}

DEVI void phase_mlstm(const Ctx& C) {
    const bf16_t* QK = WSP(const bf16_t, WS_QK); const bf16_t* VT = WSP(const bf16_t, WS_VT0);
    const float* BC = WSP(const float, WS_BC); const float* DS = WSP(const float, WS_DS);
    const bf16_t* XC = WSP(const bf16_t, WS_XC); const bf16_t* PZ = WSP(const bf16_t, WS_PZ);
    bf16_t* AB = WSP(bf16_t, WS_AB);
    const float* ng = C.in[21]; const float* sk = C.in[22];
    const int lane = C.lane, r = lane & 15, g4 = lane >> 4;
    const int gw = C.bid * 8 + C.wid, nw = C.G * 8;
    for (int task = gw; task < 64 * 128; task += nw) {
        const int seq = task & 63, x = (task >> 6) & 31, q = task >> 11;
        const int rt = (q == 0) ? 127 - x : (q == 1) ? x : (q == 2) ? 95 - x : 32 + x;
        const int b = seq >> 2, h = seq & 3;
        const int t = 16 * rt + r; const size_t row = (size_t)b * 2048 + t;
        bf16x8 qf[4];
#pragma unroll
        for (int ks = 0; ks < 4; ++ks) qf[ks] = *(const bf16x8*)(QK + row * 1024 + h * 128 + 32 * ks + 8 * g4);
        const bf16_t* Kb = QK + (size_t)b * 2048 * 1024 + 512 + h * 128 + 8 * g4;
        const bf16_t* Vb = VT + ((size_t)(seq * 128 + r)) * 2048 + 4 * g4;
        const float* BCs = BC + (size_t)seq * 2048; const float* DSs = DS + (size_t)seq * 2048;
        const float bct = BCs[t];
        f32x4 o[8];
#pragma unroll
        for (int d = 0; d < 8; ++d) o[d] = (f32x4){0.f, 0.f, 0.f, 0.f};
        float dsum = 0.f;
        const int nseg = rt / 2 + 1;
        for (int sg = 0; sg < nseg; ++sg) {
            const int s0 = 32 * sg;
            f32x4 st[2];
#pragma unroll
            for (int kt = 0; kt < 2; ++kt) { st[kt] = (f32x4){0.f, 0.f, 0.f, 0.f}; const bf16_t* kp = Kb + (size_t)(s0 + 16 * kt + r) * 1024;
#pragma unroll
                for (int ks = 0; ks < 4; ++ks) st[kt] = mfma16(*(const bf16x8*)(kp + 32 * ks), qf[ks], st[kt]); }
            const float bref = BCs[s0];
            const float rowf = fast_exp2((bct - bref) * LOG2E);
            const f32x4 d0 = *(const f32x4*)(DSs + s0 + 4 * g4), d1 = *(const f32x4*)(DSs + s0 + 16 + 4 * g4);
            float p[8];
#pragma unroll
            for (int j = 0; j < 4; ++j) {
                const int k0 = s0 + 4 * g4 + j, k1 = k0 + 16;
                const float c0 = fast_exp2((bref + d0[j]) * LOG2E), c1 = fast_exp2((bref + d1[j]) * LOG2E);
                p[j] = (k0 <= t) ? st[0][j] * rowf * c0 : 0.f; p[4 + j] = (k1 <= t) ? st[1][j] * rowf * c1 : 0.f;
            }
            dsum += (p[0] + p[1]) + (p[2] + p[3]) + (p[4] + p[5]) + (p[6] + p[7]);
            u32x4 w; w.x = cvt_pk_bf16(p[0], p[1]); w.y = cvt_pk_bf16(p[2], p[3]); w.z = cvt_pk_bf16(p[4], p[5]); w.w = cvt_pk_bf16(p[6], p[7]);
            const bf16x8 pf = __builtin_bit_cast(bf16x8, w);
#pragma unroll
            for (int d = 0; d < 8; ++d) { const bf16_t* vp = Vb + (size_t)(16 * d) * 2048 + s0; o[d] = mfma16(ld_vt(vp, vp + 16), pf, o[d]); }
        }
        dsum += __shfl_xor(dsum, 16); dsum += __shfl_xor(dsum, 32);
        const float rden = 1.0f / fmaxf(fabsf(dsum), 1.0f);
        float su = 0.f;
#pragma unroll
        for (int d = 0; d < 8; ++d) { o[d] *= rden; su += (o[d][0] + o[d][1]) + (o[d][2] + o[d][3]); }
        su += __shfl_xor(su, 16); su += __shfl_xor(su, 32);
        const float mu = su * (1.0f / 128.0f);
        float sv = 0.f;
#pragma unroll
        for (int d = 0; d < 8; ++d) { const f32x4 dd = o[d] - mu; sv += (dd[0] * dd[0] + dd[1] * dd[1]) + (dd[2] * dd[2] + dd[3] * dd[3]); }
        sv += __shfl_xor(sv, 16); sv += __shfl_xor(sv, 32);
        const float rstd = rsqrtf(sv * (1.0f / 128.0f) + 1e-5f);
#pragma unroll
        for (int d = 0; d < 8; ++d) {
            const int ch = h * 128 + 16 * d + 4 * g4;
            const f32x4 gg = *(const f32x4*)(ng + ch), ss = *(const f32x4*)(sk + ch);
            const u32x2 xc = *(const u32x2*)(XC + row * 512 + ch), zz = *(const u32x2*)(PZ + row * 1536 + 1024 + ch);
            const float xcv[4] = {bflo(xc.x), bfhi(xc.x), bflo(xc.y), bfhi(xc.y)}, zv[4] = {bflo(zz.x), bfhi(zz.x), bflo(zz.y), bfhi(zz.y)};
            float y[4];
#pragma unroll
            for (int j = 0; j < 4; ++j) y[j] = ((o[d][j] - mu) * rstd * gg[j] + ss[j] * xcv[j]) * silu_f(zv[j]);
            u32x2 w; w.x = cvt_pk_bf16(y[0], y[1]); w.y = cvt_pk_bf16(y[2], y[3]);
            *(u32x2*)(AB + row * 1024 + 512 + ch) = w;
        }
    }
}

DEVI void phase_diff(const Ctx& C) {
    const bf16_t* DQ = WSP(const bf16_t, WS_DQ); const bf16_t* DK = WSP(const bf16_t, WS_DK); const bf16_t* VT = WSP(const bf16_t, WS_DVT);
    const bf16_t* DZ = WSP(const bf16_t, WS_DZ); bf16_t* CD = WSP(bf16_t, WS_CD);
    const float* dn = C.in[29];
    const float lam = WSP(const float, WS_LAM)[0];
    const float lam_init = 0.8f - 0.6f * 0.7408182206817179f;
    const int lane = C.lane, r = lane & 15, g4 = lane >> 4;
    const int gw = C.bid * 8 + C.wid, nw = C.G * 8;
    const float sc = 0.125f * LOG2E;
    for (int task = gw; task < 64 * 128; task += nw) {
        const int seq = task & 63, x = (task >> 6) & 31, q = task >> 11;
        const int rt = (q == 0) ? 127 - x : (q == 1) ? x : (q == 2) ? 95 - x : 32 + x;
        const int b = seq >> 2, h = seq & 3;
        const int t = 16 * rt + r; const size_t row = (size_t)b * 2048 + t;
        const bf16_t* Vb = VT + ((size_t)(seq * 128 + r)) * 2048 + 4 * g4;
        const int nseg = rt / 2 + 1;
        f32x4 res[8];
#pragma unroll
        for (int comp = 0; comp < 2; ++comp) {
            const size_t hb = ((size_t)(b * 8 + 2 * h + comp)) * 2048;
            bf16x8 qf[2];
#pragma unroll
            for (int ks = 0; ks < 2; ++ks) qf[ks] = *(const bf16x8*)(DQ + (hb + t) * 64 + 32 * ks + 8 * g4);
            const bf16_t* Kb = DK + hb * 64 + 8 * g4;
            f32x4 o[8];
#pragma unroll
            for (int d = 0; d < 8; ++d) o[d] = (f32x4){0.f, 0.f, 0.f, 0.f};
            float m = NEG_INF, l = 0.f;
            for (int sg = 0; sg < nseg; ++sg) {
                const int s0 = 32 * sg;
                f32x4 st[2];
#pragma unroll
                for (int kt = 0; kt < 2; ++kt) { st[kt] = (f32x4){0.f, 0.f, 0.f, 0.f}; const bf16_t* kp = Kb + (size_t)(s0 + 16 * kt + r) * 64;
#pragma unroll
                    for (int ks = 0; ks < 2; ++ks) st[kt] = mfma16(*(const bf16x8*)(kp + 32 * ks), qf[ks], st[kt]); }
                float s[8];
#pragma unroll
                for (int j = 0; j < 4; ++j) { const int k0 = s0 + 4 * g4 + j, k1 = k0 + 16; s[j] = (k0 <= t) ? st[0][j] * sc : NEG_INF; s[4 + j] = (k1 <= t) ? st[1][j] * sc : NEG_INF; }
                bf16x8 pf; osm_update<8>(s, m, l, o, pf);
#pragma unroll
                for (int d = 0; d < 8; ++d) { const bf16_t* vp = Vb + (size_t)(16 * d) * 2048 + s0; o[d] = mfma16(ld_vt(vp, vp + 16), pf, o[d]); }
            }
            l += __shfl_xor(l, 16); l += __shfl_xor(l, 32);
            const float rl = 1.0f / l;
            if (comp == 0) {
#pragma unroll
                for (int d = 0; d < 8; ++d) res[d] = o[d] * rl;
            } else {
#pragma unroll
                for (int d = 0; d < 8; ++d) res[d] -= o[d] * (rl * lam);
            }
        }
        float ss = 0.f;
#pragma unroll
        for (int d = 0; d < 8; ++d) ss += (res[d][0] * res[d][0] + res[d][1] * res[d][1]) + (res[d][2] * res[d][2] + res[d][3] * res[d][3]);
        ss += __shfl_xor(ss, 16); ss += __shfl_xor(ss, 32);
        const float rn = rsqrtf(ss * (1.0f / 128.0f) + 1e-5f) * (1.0f - lam_init);
#pragma unroll
        for (int d = 0; d < 8; ++d) {
            const int dv = 16 * d + 4 * g4, ch = h * 128 + dv;
            const f32x4 gg = *(const f32x4*)(dn + dv);
            const u32x2 zz = *(const u32x2*)(DZ + row * 512 + ch);
            const float zv[4] = {bflo(zz.x), bfhi(zz.x), bflo(zz.y), bfhi(zz.y)};
            float y[4];
#pragma unroll
            for (int j = 0; j < 4; ++j) y[j] = res[d][j] * rn * gg[j] * silu_f(zv[j]);
            u32x2 w; w.x = cvt_pk_bf16(y[0], y[1]); w.y = cvt_pk_bf16(y[2], y[3]);
            *(u32x2*)(CD + row * 1024 + 512 + ch) = w;
        }
    }
}

DEVI void dil_seg(const bf16_t* Kc  , const bf16_t* Vc  , int cc, int is0, int W, int tq, int r, int g4, float sc,
                  const bf16x8 (&qf)[2], f32x4 (&o)[4], float& m, float& l) {
    f32x4 st[2];
#pragma unroll
    for (int kt = 0; kt < 2; ++kt) { int ik = is0 + 16 * kt + r; ik = ik < 0 ? 0 : ik; st[kt] = (f32x4){0.f, 0.f, 0.f, 0.f}; const bf16_t* kp = Kc + (size_t)ik * 64;
#pragma unroll
        for (int ks = 0; ks < 2; ++ks) st[kt] = mfma16(*(const bf16x8*)(kp + 32 * ks), qf[ks], st[kt]); }
    float s[8];
#pragma unroll
    for (int j = 0; j < 4; ++j) {
        const int i0 = is0 + 4 * g4 + j, i1 = i0 + 16;
        const int d0 = tq - (16 * i0 + cc), d1 = tq - (16 * i1 + cc);
        s[j] = (i0 >= 0 && d0 >= 0 && d0 <= W) ? st[0][j] * sc : NEG_INF;
        s[4 + j] = (i1 >= 0 && d1 >= 0 && d1 <= W) ? st[1][j] * sc : NEG_INF;
    }
    bf16x8 pf; osm_update<4>(s, m, l, o, pf);
    int ilo = is0 + 4 * g4, ihi = ilo + 16; ilo = ilo < 0 ? 0 : ilo; ihi = ihi < 0 ? 0 : ihi;
#pragma unroll
    for (int d = 0; d < 4; ++d) { const bf16_t* vb = Vc + (size_t)(16 * d + r) * 2048; o[d] = mfma16(ld_vt(vb + ilo, vb + ihi), pf, o[d]); }
}

DEVI void phase_dilated(const Ctx& C) {
    const bf16_t* CQ = WSP(const bf16_t, WS_CQ); const bf16_t* CK = WSP(const bf16_t, WS_CK); const bf16_t* CVT = WSP(const bf16_t, WS_CVT);
    const bf16_t* CZ = WSP(const bf16_t, WS_CZ); bf16_t* CD = WSP(bf16_t, WS_CD);
    const int lane = C.lane, r = lane & 15, g4 = lane >> 4;
    const int gw = C.bid * 8 + C.wid, nw = C.G * 8;
    const float sc = 0.125f * LOG2E;
    for (int task = gw; task < 16 * 8 * 16 * 8; task += nw) {
        const int it = task & 7, c = (task >> 3) & 15, h = (task >> 7) & 7, b = task >> 10;
        const size_t bh = (size_t)(b * 8 + h);
        const int iq = 16 * it + r, tq = 16 * iq + c;
        bf16x8 qf[2];
#pragma unroll
        for (int ks = 0; ks < 2; ++ks) qf[ks] = *(const bf16x8*)(CQ + ((bh * 16 + c) * 128 + iq) * 64 + 32 * ks + 8 * g4);
        const bf16_t* Kbh = CK + bh * 16 * 128 * 64 + 8 * g4;
        const bf16_t* Vbh = CVT + bh * 64 * 2048;
        f32x4 o[4];
#pragma unroll
        for (int d = 0; d < 4; ++d) o[d] = (f32x4){0.f, 0.f, 0.f, 0.f};
        float m = NEG_INF, l = 0.f;
        for (int cc = 0; cc < 16; ++cc) dil_seg(Kbh + (size_t)cc * 128 * 64, Vbh + cc * 128, cc, 16 * it - 16, 128, tq, r, g4, sc, qf, o, m, l);
        for (int k = 0; k < 4; ++k) { const int cc = (c & 3) + 4 * k;
            if (it > 0) dil_seg(Kbh + (size_t)cc * 128 * 64, Vbh + cc * 128, cc, 16 * it - 48, 512, tq, r, g4, sc, qf, o, m, l);
            dil_seg(Kbh + (size_t)cc * 128 * 64, Vbh + cc * 128, cc, 16 * it - 16, 512, tq, r, g4, sc, qf, o, m, l); }
        for (int is0 = 0; is0 <= 16 * it + 15; is0 += 32) dil_seg(Kbh + (size_t)c * 128 * 64, Vbh + c * 128, c, is0, 4096, tq, r, g4, sc, qf, o, m, l);
        l += __shfl_xor(l, 16); l += __shfl_xor(l, 32);
        const float rl = 1.0f / l;
        const size_t row = (size_t)b * 2048 + tq;
#pragma unroll
        for (int d = 0; d < 4; ++d) {
            const int ch = h * 64 + 16 * d + 4 * g4;
            const u32x2 zz = *(const u32x2*)(CZ + row * 512 + ch);
            const float zv[4] = {bflo(zz.x), bfhi(zz.x), bflo(zz.y), bfhi(zz.y)};
            float y[4];
#pragma unroll
            for (int j = 0; j < 4; ++j) y[j] = o[d][j] * rl * silu_f(zv[j]);
            u32x2 w; w.x = cvt_pk_bf16(y[0], y[1]); w.y = cvt_pk_bf16(y[2], y[3]);
            *(u32x2*)(CD + row * 1024 + ch) = w;
        }
    }
}
typedef float f32x16 __attribute__((ext_vector_type(16)));
typedef short s16x4 __attribute__((ext_vector_type(4)));
DEVI f32x16 mfma32(bf16x8 a, bf16x8 b, f32x16 c) { return __builtin_amdgcn_mfma_f32_32x32x16_bf16(a, b, c, 0, 0, 0); }
DEVI s16x4 tr_read(const LAS unsigned char* p) { return __builtin_amdgcn_ds_read_tr16_b64_v4i16((LAS s16x4*)p); }

template <int DQK, int DV, int MODE, int NG>
DEVI void flash_core(const Ctx& C, const bf16_t* Qg0, const bf16_t* Kg0, const bf16_t* Vg0, const bf16_t* Qg1, const bf16_t* Kg1, const bf16_t* Vg1,
                     int ldq, int ldk, int ldv, int qb, int t_lo, int t_hi, int W, float sc,
                     const float* BCs, const float* DSs, f32x16 (&o)[DV / 32], float& lsum, float& m) {
    constexpr int NKS = DQK / 16, NDT = DV / 32, KROW = (DQK + 8) * 2, KBUF = 64 * KROW, VROW = DV * 2 + 64, VBUF = 64 * VROW, NKC = DQK / 8, NVC = DV / 8;
    constexpr int TG = 512 / NG, KLD = (64 * NKC) / TG, VLD = (64 * NVC) / TG, GSZ = 2 * KBUF + 2 * VBUF + 512;
    const int tid = C.tid, lane = C.lane, w = C.wid, ql = lane & 31, h = lane >> 5;
    const int grp = (NG == 2) ? (w >> 2) : 0, wg = (NG == 2) ? (w & 3) : w, tg = (NG == 2) ? (tid & 255) : tid;
    const bf16_t* Qg = (NG == 2 && grp) ? Qg1 : Qg0; const bf16_t* Kg = (NG == 2 && grp) ? Kg1 : Kg0; const bf16_t* Vg = (NG == 2 && grp) ? Vg1 : Vg0;
    LAS unsigned char* lds = C.lds + grp * GSZ;
    const int q0w = qb + 32 * wg, q = q0w + ql;
    bf16x8 qf[NKS];
#pragma unroll
    for (int ks = 0; ks < NKS; ++ks) qf[ks] = *(const bf16x8*)(Qg + (size_t)q * ldq + 16 * ks + 8 * h);
#pragma unroll
    for (int d = 0; d < NDT; ++d)
#pragma unroll
        for (int r = 0; r < 16; ++r) o[d][r] = 0.f;
    m = NEG_INF; lsum = 0.f;
    const float bcq = MODE ? BCs[q] : 0.f;
    u32x4 kreg[KLD], vreg[VLD]; float cfreg = 0.f;
#define FL_LOAD(t) do { \
        _Pragma("unroll") for (int i_ = 0; i_ < KLD; ++i_) { const int idx_ = tg + TG * i_, key_ = idx_ / NKC, ch_ = idx_ % NKC; kreg[i_] = *(const u32x4*)(Kg + (size_t)(64 * (t) + key_) * ldk + ch_ * 8); } \
        _Pragma("unroll") for (int i_ = 0; i_ < VLD; ++i_) { const int idx_ = tg + TG * i_, key_ = idx_ / NVC, ch_ = idx_ % NVC; vreg[i_] = *(const u32x4*)(Vg + (size_t)(64 * (t) + key_) * ldv + ch_ * 8); } \
        if (MODE && tid < 64) cfreg = fast_exp2((BCs[64 * (t)] + DSs[64 * (t) + tid]) * LOG2E); } while (0)
#define FL_STORE(b) do { \
        _Pragma("unroll") for (int i_ = 0; i_ < KLD; ++i_) { const int idx_ = tg + TG * i_, key_ = idx_ / NKC, ch_ = idx_ % NKC; *(LAS u32x4*)(lds + (b) * KBUF + key_ * KROW + ch_ * 16) = kreg[i_]; } \
        _Pragma("unroll") for (int i_ = 0; i_ < VLD; ++i_) { const int idx_ = tg + TG * i_, key_ = idx_ / NVC, ch_ = idx_ % NVC; *(LAS u32x4*)(lds + 2 * KBUF + (b) * VBUF + key_ * VROW + ch_ * 16) = vreg[i_]; } \
        if (MODE && tid < 64) *(LAS float*)(lds + 2 * KBUF + 2 * VBUF + (b) * 256 + tid * 4) = cfreg; } while (0)
    __syncthreads();
    FL_LOAD(t_lo); FL_STORE(0);
    __syncthreads();
    const int li = lane & 15, qq = li >> 2, pp = li & 3, g2 = (lane >> 4) & 1;
    for (int t = t_lo; t < t_hi; ++t) {
        const int buf = (t - t_lo) & 1, k0 = 64 * t;
        if (t + 1 < t_hi) FL_LOAD(t + 1);
        if (k0 <= q0w + 31 && k0 + 63 >= q0w - W) {
            f32x16 st[2];
#pragma unroll
            for (int kt = 0; kt < 2; ++kt) {
#pragma unroll
                for (int r = 0; r < 16; ++r) st[kt][r] = 0.f;
                const LAS unsigned char* kb = lds + buf * KBUF + (32 * kt + ql) * KROW + 16 * h;
#pragma unroll
                for (int ks = 0; ks < NKS; ++ks) st[kt] = mfma32(*(const LAS bf16x8*)(kb + ks * 32), qf[ks], st[kt]);
            }
            __builtin_amdgcn_sched_barrier(0);
            const bool diag = (k0 + 63 > q0w) || (k0 < q0w + 31 - W);
            if (MODE == 0) {
                float smax = NEG_INF;
#pragma unroll
                for (int kt = 0; kt < 2; ++kt)
#pragma unroll
                    for (int r = 0; r < 16; ++r) { float s = st[kt][r] * sc; if (diag) { const int key = k0 + 32 * kt + (r & 3) + 8 * (r >> 2) + 4 * h; s = (key <= q && q - key <= W) ? s : NEG_INF; } st[kt][r] = s; smax = fmaxf(smax, s); }
                smax = fmaxf(smax, __shfl_xor(smax, 32));
                if (!__all(smax <= m + 8.0f || smax == NEG_INF)) {
                    const float mn = fmaxf(m, smax), alpha = (mn == NEG_INF) ? 1.0f : fast_exp2(m - mn);
#pragma unroll
                    for (int d = 0; d < NDT; ++d) o[d] *= alpha;
                    lsum *= alpha; m = mn;
                }
                const float mref = (m == NEG_INF) ? 0.f : m;
#pragma unroll
                for (int kt = 0; kt < 2; ++kt)
#pragma unroll
                    for (int r = 0; r < 16; ++r) { const float p = fast_exp2(st[kt][r] - mref); st[kt][r] = p; lsum += p; }
            } else {
                const float rowf = fast_exp2((bcq - BCs[k0]) * LOG2E);
                const LAS unsigned char* cfb = lds + 2 * KBUF + 2 * VBUF + buf * 256;
#pragma unroll
                for (int kt = 0; kt < 2; ++kt)
#pragma unroll
                    for (int g = 0; g < 4; ++g) { const f32x4 c4 = *(const LAS f32x4*)(cfb + (32 * kt + 8 * g + 4 * h) * 4);
#pragma unroll
                        for (int e = 0; e < 4; ++e) { const int r = 4 * g + e; float p = st[kt][r] * rowf * c4[e]; if (diag) { const int key = k0 + 32 * kt + e + 8 * g + 4 * h; p = (key <= q) ? p : 0.f; } st[kt][r] = p; lsum += p; } }
            }
            bf16x8 pf[4];
#pragma unroll
            for (int u = 0; u < 4; ++u) { const int kt = u >> 1, r0 = 8 * (u & 1); u32x4 wv;
                wv.x = cvt_pk_bf16(st[kt][r0 + 0], st[kt][r0 + 1]); wv.y = cvt_pk_bf16(st[kt][r0 + 2], st[kt][r0 + 3]); wv.z = cvt_pk_bf16(st[kt][r0 + 4], st[kt][r0 + 5]); wv.w = cvt_pk_bf16(st[kt][r0 + 6], st[kt][r0 + 7]);
                pf[u] = __builtin_bit_cast(bf16x8, wv); }
            __builtin_amdgcn_sched_barrier(0);
            const LAS unsigned char* vl = lds + 2 * KBUF + buf * VBUF + (4 * h + qq) * VROW + (16 * g2 + 4 * pp) * 2;
#pragma unroll
            for (int u = 0; u < 4; ++u)
#pragma unroll
                for (int d = 0; d < NDT; ++d) {
                    const s16x4 lo = tr_read(vl + u * 16 * VROW + d * 64), hi = tr_read(vl + u * 16 * VROW + 8 * VROW + d * 64);
                    bf16x8 vf; vf[0] = lo[0]; vf[1] = lo[1]; vf[2] = lo[2]; vf[3] = lo[3]; vf[4] = hi[0]; vf[5] = hi[1]; vf[6] = hi[2]; vf[7] = hi[3];
                    o[d] = mfma32(vf, pf[u], o[d]);
                }
        }
        if (t + 1 < t_hi) FL_STORE(buf ^ 1);
        __syncthreads();
    }
#undef FL_LOAD
#undef FL_STORE
}

DEVI void phase_mlstm_blk(const Ctx& C) {
    const bf16_t* QK = WSP(const bf16_t, WS_QK); const bf16_t* V = WSP(const bf16_t, WS_VTMP);
    const float* BC = WSP(const float, WS_BC); const float* DS = WSP(const float, WS_DS);
    const bf16_t* XC = WSP(const bf16_t, WS_XC); const bf16_t* PZ = WSP(const bf16_t, WS_PZ);
    bf16_t* AB = WSP(bf16_t, WS_AB);
    const float* ng = C.in[21]; const float* sk = C.in[22];
    const int lane = C.lane, ql = lane & 31, h2 = lane >> 5;
    for (int task = C.bid; task < 512; task += C.G) {
        const int seq = task & 63, x = (task >> 6) & 3, j = (task < 256) ? 7 - x : x;
        const int b = seq >> 2, h = seq & 3;
        const bf16_t* Qg = QK + (size_t)b * 2048 * 1024 + h * 128;
        f32x16 o[4]; float dsum, mdummy;
        { const bf16_t* Vg = V + (size_t)b * 2048 * 512 + h * 128;
          flash_core<128, 128, 1, 1>(C, Qg, Qg + 512, Vg, Qg, Qg + 512, Vg, 1024, 1024, 512, 256 * j, 0, 4 * (j + 1), 1 << 20, 1.0f, BC + (size_t)seq * 2048, DS + (size_t)seq * 2048, o, dsum, mdummy); }
        dsum += __shfl_xor(dsum, 32);
        const float rden = 1.0f / fmaxf(fabsf(dsum), 1.0f);
        float su = 0.f;
#pragma unroll
        for (int d = 0; d < 4; ++d) { o[d] *= rden;
#pragma unroll
            for (int r = 0; r < 16; ++r) su += o[d][r]; }
        su += __shfl_xor(su, 32);
        const float mu = su * (1.0f / 128.0f);
        float sv = 0.f;
#pragma unroll
        for (int d = 0; d < 4; ++d)
#pragma unroll
            for (int r = 0; r < 16; ++r) { const float dd = o[d][r] - mu; sv += dd * dd; }
        sv += __shfl_xor(sv, 32);
        const float rstd = rsqrtf(sv * (1.0f / 128.0f) + 1e-5f);
        const size_t row = (size_t)b * 2048 + 256 * j + 32 * C.wid + ql;
#pragma unroll
        for (int d = 0; d < 4; ++d)
#pragma unroll
            for (int g = 0; g < 4; ++g) {
                const int ch = h * 128 + 32 * d + 8 * g + 4 * h2;
                const f32x4 gg = *(const f32x4*)(ng + ch), ss = *(const f32x4*)(sk + ch);
                const u32x2 xc = *(const u32x2*)(XC + row * 512 + ch), zz = *(const u32x2*)(PZ + row * 1536 + 1024 + ch);
                const float xcv[4] = {bflo(xc.x), bfhi(xc.x), bflo(xc.y), bfhi(xc.y)}, zv[4] = {bflo(zz.x), bfhi(zz.x), bflo(zz.y), bfhi(zz.y)};
                float y[4];
#pragma unroll
                for (int e = 0; e < 4; ++e) y[e] = ((o[d][4 * g + e] - mu) * rstd * gg[e] + ss[e] * xcv[e]) * silu_f(zv[e]);
                u32x2 wv; wv.x = cvt_pk_bf16(y[0], y[1]); wv.y = cvt_pk_bf16(y[2], y[3]);
                *(u32x2*)(AB + row * 1024 + 512 + ch) = wv;
            }
    }
}

DEVI void phase_diff_blk(const Ctx& C) {
    const bf16_t* DQ = WSP(const bf16_t, WS_DQ); const bf16_t* DK = WSP(const bf16_t, WS_DK); const bf16_t* DV = WSP(const bf16_t, WS_DVTMP);
    const bf16_t* DZ = WSP(const bf16_t, WS_DZ); bf16_t* CD = WSP(bf16_t, WS_CD);
    float* stp = WSP(float, WS_DVT) + ((size_t)C.bid * 512 + C.tid) * 64;
    const float* dn = C.in[29];
    const float lam = WSP(const float, WS_LAM)[0];
    const float lam_init = 0.8f - 0.6f * 0.7408182206817179f;
    const int lane = C.lane, ql = lane & 31, h2 = lane >> 5;
    const float sc = 0.125f * LOG2E;
    for (int task = C.bid; task < 512; task += C.G) {
        const int seq = task & 63, x = (task >> 6) & 3, j = (task < 256) ? 7 - x : x;
        const int b = seq >> 2, h = seq & 3;
        const bf16_t* Vg = DV + (size_t)b * 2048 * 512 + h * 128;
        f32x16 o[4]; float l;
#pragma unroll 1
        for (int comp = 0; comp < 2; ++comp) {
            const size_t hb = ((size_t)(b * 8 + 2 * h + comp)) * 2048 * 64;
            float mdummy;
            flash_core<64, 128, 0, 1>(C, DQ + hb, DK + hb, Vg, DQ + hb, DK + hb, Vg, 64, 64, 512, 256 * j, 0, 4 * (j + 1), 1 << 20, sc, nullptr, nullptr, o, l, mdummy);
            l += __shfl_xor(l, 32);
            if (comp == 0) {
                const float rl = 1.0f / l;
#pragma unroll
                for (int d = 0; d < 4; ++d) {
#pragma unroll
                    for (int g = 0; g < 4; ++g) { f32x4 v4; v4[0] = o[d][4 * g] * rl; v4[1] = o[d][4 * g + 1] * rl; v4[2] = o[d][4 * g + 2] * rl; v4[3] = o[d][4 * g + 3] * rl; *(f32x4*)(stp + d * 16 + g * 4) = v4; }
                    asm volatile("" ::: "memory"); }
            } else {
                const float rl = lam / l;
#pragma unroll
                for (int d = 0; d < 4; ++d) {
#pragma unroll
                    for (int g = 0; g < 4; ++g) { const f32x4 v4 = *(const f32x4*)(stp + d * 16 + g * 4); o[d][4 * g] = v4[0] - o[d][4 * g] * rl; o[d][4 * g + 1] = v4[1] - o[d][4 * g + 1] * rl; o[d][4 * g + 2] = v4[2] - o[d][4 * g + 2] * rl; o[d][4 * g + 3] = v4[3] - o[d][4 * g + 3] * rl; }
                    asm volatile("" ::: "memory"); }
            }
        }
        float ss = 0.f;
#pragma unroll
        for (int d = 0; d < 4; ++d)
#pragma unroll
            for (int r = 0; r < 16; ++r) ss += o[d][r] * o[d][r];
        ss += __shfl_xor(ss, 32);
        const float rn = rsqrtf(ss * (1.0f / 128.0f) + 1e-5f) * (1.0f - lam_init);
        const size_t row = (size_t)b * 2048 + 256 * j + 32 * C.wid + ql;
#pragma unroll
        for (int d = 0; d < 4; ++d)
#pragma unroll
            for (int g = 0; g < 4; ++g) {
                const int dv = 32 * d + 8 * g + 4 * h2, ch = h * 128 + dv;
                const f32x4 gg = *(const f32x4*)(dn + dv);
                const u32x2 zz = *(const u32x2*)(DZ + row * 512 + ch);
                const float zv[4] = {bflo(zz.x), bfhi(zz.x), bflo(zz.y), bfhi(zz.y)};
                float y[4];
#pragma unroll
                for (int e = 0; e < 4; ++e) y[e] = o[d][4 * g + e] * rn * gg[e] * silu_f(zv[e]);
                u32x2 wv; wv.x = cvt_pk_bf16(y[0], y[1]); wv.y = cvt_pk_bf16(y[2], y[3]);
                *(u32x2*)(CD + row * 1024 + 512 + ch) = wv;
            }
    }
}

template <int NG>
DEVI void dil_store_partial(const f32x16 (&o)[2], float l, float m, bf16_t* dst  , float* lse_dst, int h2) {
    l += __shfl_xor(l, 32);
    const float rl = 1.0f / l;
#pragma unroll
    for (int d = 0; d < 2; ++d)
#pragma unroll
        for (int g = 0; g < 4; ++g) {
            const int dv = 32 * d + 8 * g + 4 * h2;
            u32x2 wv; wv.x = cvt_pk_bf16(o[d][4 * g] * rl, o[d][4 * g + 1] * rl); wv.y = cvt_pk_bf16(o[d][4 * g + 2] * rl, o[d][4 * g + 3] * rl);
            *(u32x2*)(dst + dv) = wv;
        }
    if (h2 == 0) *lse_dst = m + __log2f(l);
}

DEVI void phase_dil23(const Ctx& C) {
    const bf16_t* CQ = WSP(const bf16_t, WS_CQ); const bf16_t* CK = WSP(const bf16_t, WS_CK); const bf16_t* CV = WSP(const bf16_t, WS_CVTMP);
    bf16_t* O2 = WSP(bf16_t, WS_CVT); bf16_t* CD = WSP(bf16_t, WS_CD);
    float* LSE2 = WSP(float, WS_LI); float* LSE3 = WSP(float, WS_BC);
    const int lane = C.lane, ql = lane & 31, h2 = lane >> 5, w = C.wid;
    const float sc = 0.125f * LOG2E;
    for (int task = C.bid; task < 1024; task += C.G) {
        const int jb = (task < 512) ? 1 : 0, r4 = task & 3, h = (task >> 2) & 7, b = (task >> 5) & 15;
        const size_t base = ((size_t)(b * 8 + h) * 2048 + r4) * 64;
        f32x16 o[2]; float l, m;
        flash_core<64, 64, 0, 1>(C, CQ + base, CK + base, CV + base, CQ + base, CK + base, CV + base, 256, 256, 256, 256 * jb, jb ? 2 : 0, jb ? 8 : 4, 128, sc, nullptr, nullptr, o, l, m);
        const size_t tok = (size_t)b * 2048 + 4 * (256 * jb + 32 * w + ql) + r4;
        dil_store_partial<1>(o, l, m, O2 + tok * 512 + h * 64, LSE2 + tok * 8 + h, h2);
    }
    for (int task = C.bid; task < 1024; task += C.G) {
        const int cp = task & 7, h = (task >> 3) & 7, b = (task >> 6) & 15;
        const size_t base0 = ((size_t)(b * 8 + h) * 2048 + 2 * cp) * 64, base1 = base0 + 64;
        f32x16 o[2]; float l, m;
        flash_core<64, 64, 0, 2>(C, CQ + base0, CK + base0, CV + base0, CQ + base1, CK + base1, CV + base1, 1024, 1024, 1024, 0, 0, 2, 1 << 20, sc, nullptr, nullptr, o, l, m);
        const int c = 2 * cp + (w >> 2);
        const size_t tok = (size_t)b * 2048 + 16 * (32 * (w & 3) + ql) + c;
        dil_store_partial<2>(o, l, m, CD + tok * 1024 + h * 64, LSE3 + tok * 8 + h, h2);
    }
}

DEVI void phase_dil1(const Ctx& C) {
    const bf16_t* CQ = WSP(const bf16_t, WS_CQ); const bf16_t* CK = WSP(const bf16_t, WS_CK); const bf16_t* CV = WSP(const bf16_t, WS_CVTMP);
    const bf16_t* O2 = WSP(const bf16_t, WS_CVT); bf16_t* CD = WSP(bf16_t, WS_CD); const bf16_t* CZ = WSP(const bf16_t, WS_CZ);
    const float* LSE2 = WSP(const float, WS_LI); const float* LSE3 = WSP(const float, WS_BC);
    const int lane = C.lane, ql = lane & 31, h2 = lane >> 5, w = C.wid;
    const float sc = 0.125f * LOG2E;
    for (int task = C.bid; task < 1024; task += C.G) {
        const int j = 7 - (task & 7), h = (task >> 3) & 7, b = (task >> 6) & 15;
        const size_t base = (size_t)(b * 8 + h) * 2048 * 64;
        f32x16 o[2]; float l, m;
        flash_core<64, 64, 0, 1>(C, CQ + base, CK + base, CV + base, CQ + base, CK + base, CV + base, 64, 64, 64, 256 * j, (4 * j - 2) < 0 ? 0 : (4 * j - 2), 4 * j + 4, 128, sc, nullptr, nullptr, o, l, m);
        l += __shfl_xor(l, 32);
        const size_t tok = (size_t)b * 2048 + 256 * j + 32 * w + ql;
        const float lse1 = m + __log2f(l), lse2 = LSE2[tok * 8 + h], lse3 = LSE3[tok * 8 + h];
        const float M = fmaxf(lse1, fmaxf(lse2, lse3));
        const float e1 = fast_exp2(lse1 - M), w2 = fast_exp2(lse2 - M), w3 = fast_exp2(lse3 - M);
        const float rden = 1.0f / (e1 + w2 + w3), w1 = e1 / l;
#pragma unroll
        for (int d = 0; d < 2; ++d)
#pragma unroll
            for (int g = 0; g < 4; ++g) {
                const int ch = h * 64 + 32 * d + 8 * g + 4 * h2;
                const u32x2 p2 = *(const u32x2*)(O2 + tok * 512 + ch), p3 = *(const u32x2*)(CD + tok * 1024 + ch), zz = *(const u32x2*)(CZ + tok * 512 + ch);
                const float a2[4] = {bflo(p2.x), bfhi(p2.x), bflo(p2.y), bfhi(p2.y)}, a3[4] = {bflo(p3.x), bfhi(p3.x), bflo(p3.y), bfhi(p3.y)}, zv[4] = {bflo(zz.x), bfhi(zz.x), bflo(zz.y), bfhi(zz.y)};
                float y[4];
#pragma unroll
                for (int e = 0; e < 4; ++e) y[e] = (o[d][4 * g + e] * w1 + a2[e] * w2 + a3[e] * w3) * rden * silu_f(zv[e]);
                u32x2 wv; wv.x = cvt_pk_bf16(y[0], y[1]); wv.y = cvt_pk_bf16(y[2], y[3]);
                *(u32x2*)(CD + tok * 1024 + ch) = wv;
            }
    }
}
#ifndef REP_MASK
#define REP_MASK 0
#endif
constexpr int N_STEPS = 17;
constexpr int LDS_BYTES = pg8::STAGE_BYTES + 256;

template <int MODE>
DEVI void run_gemm(const Ctx& C, const EpiMulti<MODE>& E, const bf16_t* A, int lda, const bf16_t* Bt, int ldb, int N, int K, int grp_shift, size_t grp_bbytes) {
    pg8::Gemm g; g.A = A; g.Bt = Bt; g.M = NT; g.N = N; g.K = K; g.lda = lda; g.ldb = ldb; g.grp_shift = grp_shift; g.grp_bbytes = grp_bbytes;
    pg8::StaticOrder S; S.init(NT, N, C.G, C.bid);
    pg8::gemm_phase<EpiMulti<MODE>>(C.lds, g, S, E);
}
template <int MODE> DEVI EpiMulti<MODE> mk_epi(const Ctx& C) { EpiMulti<MODE> E; E.ldc = 0; E.o0 = nullptr; E.o1 = nullptr; E.f0 = nullptr; E.i0 = nullptr; E.i1 = nullptr; E.c0 = nullptr; E.c1 = nullptr; E.ws = C.ws; return E; }

__global__ void __launch_bounds__(512, 2) mega_fwd(Params P) {
    extern __shared__ __attribute__((aligned(16))) unsigned char lds_raw[];
    Ctx C;
    C.in = P.in;
    C.out = P.out; C.ws = P.ws; C.lds = (LAS unsigned char*)lds_raw;
    C.tid = threadIdx.x; C.lane = C.tid & 63; C.wid = __builtin_amdgcn_readfirstlane(C.tid >> 6); C.G = gridDim.x; C.bid = blockIdx.x;
    volatile LAS unsigned* bst = (volatile LAS unsigned*)(C.lds + pg8::STAGE_BYTES);
    if (C.tid < 4) bst[C.tid] = 0u;
    __syncthreads();
    XcdBarrier bar = xcd_barrier_post((unsigned*)(C.ws + WS_CTL), bst);
#ifdef ONLY_PHASE
#define ON(k) ((k) == ONLY_PHASE)
#else
#define ON(k) (P.ph_lo <= (k) && (k) < P.ph_hi)
#endif
#define STEP(k, ...) if (ON(k)) { __VA_ARGS__ } if (ON(k) && ((REP_MASK >> (k)) & 1)) { __VA_ARGS__ }
#define BAR(k) do { if (ON(k) && (k) + 1 < P.ph_hi) xcd_barrier(bar); } while (0)
    STEP(0, phase_prologue(C);)
    BAR(0);
    STEP(1, { auto E = mk_epi<EM_IN0>(C); E.o0 = WSP(bf16_t, WS_PZ); E.o1 = WSP(bf16_t, WS_U5);
        run_gemm(C, E, WSP(const bf16_t, WS_XN), 1024, WSP(const bf16_t, WS_WIN0), 1024, 2048, 1024, 0, 0); })
    BAR(1);
    STEP(2, phase_conv_gates(C);)
    BAR(2);
    STEP(3, { auto E = mk_epi<EM_PLAIN>(C); E.o0 = WSP(bf16_t, WS_QK); E.ldc = 1024;
        run_gemm(C, E, WSP(const bf16_t, WS_XC), 512, WSP(const bf16_t, WS_WQK), 512, 1024, 512, 0, 0); })
    STEP(4, { auto E = mk_epi<EM_PLAIN>(C); E.o0 = WSP(bf16_t, WS_VTMP); E.ldc = 512;
        run_gemm(C, E, WSP(const bf16_t, WS_PZ) + 512, 1536, WSP(const bf16_t, WS_WV), 512, 512, 512, 0, 0); })
    STEP(5, { auto E = mk_epi<EM_S5A>(C); E.o0 = WSP(bf16_t, WS_YLOC); E.f0 = WSP(float, WS_XLOC);
        run_gemm(C, E, WSP(const bf16_t, WS_U5), 512, WSP(const bf16_t, WS_BT5A), 512, 768, 512, 2, (size_t)768 * 512 * 2); })
    BAR(5);
    STEP(6, phase_mid0(C);)
    BAR(6);
    STEP(7, phase_mlstm_blk(C);)
    STEP(8, { auto E = mk_epi<EM_S5B>(C); E.o0 = WSP(bf16_t, WS_G5); E.i0 = WSP(const bf16_t, WS_YLOC); E.i1 = WSP(const bf16_t, WS_U5); E.c0 = C.in[11];
        run_gemm(C, E, WSP(const bf16_t, WS_XST), 256, WSP(const bf16_t, WS_BT5B), 256, 512, 256, 2, (size_t)512 * 256 * 2); })
    BAR(8);
    STEP(9, { auto E = mk_epi<EM_GLU>(C); E.o0 = WSP(bf16_t, WS_AB); E.i0 = WSP(const bf16_t, WS_G5); E.i1 = WSP(const bf16_t, WS_PZ); E.c0 = C.in[13];
        run_gemm(C, E, WSP(const bf16_t, WS_G5), 512, WSP(const bf16_t, WS_GLU), 512, 512, 512, 0, 0); })
    BAR(9);
    STEP(10, { auto E = mk_epi<EM_OUT>(C); E.o0 = WSP(bf16_t, WS_Y0); E.f0 = WSP(float, WS_SS0);
        run_gemm(C, E, WSP(const bf16_t, WS_AB), 1024, WSP(const bf16_t, WS_WOUT0), 1024, 1024, 1024, 0, 0); })
    BAR(10);
    STEP(11, rows_pass(C, 1);)
    BAR(11);
    STEP(12, { auto E = mk_epi<EM_IN1>(C); E.c0 = WSP(const float, WS_ROPE_C); E.c1 = WSP(const float, WS_ROPE_S);
        run_gemm(C, E, WSP(const bf16_t, WS_XN1), 1024, WSP(const bf16_t, WS_WIN1), 1024, 4096, 1024, 0, 0); })
    BAR(12);
    STEP(13, { phase_diff_blk(C); phase_dil23(C); })
    BAR(13);
    STEP(14, phase_dil1(C);)
    BAR(14);
    STEP(15, { auto E = mk_epi<EM_OUT>(C); E.o0 = WSP(bf16_t, WS_Y1); E.f0 = WSP(float, WS_SS1);
        run_gemm(C, E, WSP(const bf16_t, WS_CD), 1024, WSP(const bf16_t, WS_WOUT1), 1024, 1024, 1024, 0, 0); })
    BAR(15);
    STEP(16, rows_pass(C, 2);)
#undef ON
#undef BAR
}

#ifndef MK_SPLIT
#define MK_SPLIT 0
#endif
extern "C" void kernel_launch(void* const* d_in, const int* in_sizes, int n_in, void* d_out, int out_size, void* d_ws, size_t ws_size, hipStream_t stream) {
    static int grid = 0;
    if (grid == 0) {
        int dev = 0, cus = 0, per_cu = 0;
        (void)hipGetDevice(&dev);
        (void)hipDeviceGetAttribute(&cus, hipDeviceAttributeMultiprocessorCount, dev);
        (void)hipFuncSetAttribute((const void*)mega_fwd, hipFuncAttributeMaxDynamicSharedMemorySize, LDS_BYTES);
        (void)hipOccupancyMaxActiveBlocksPerMultiprocessor(&per_cu, (const void*)mega_fwd, 512, LDS_BYTES);
        if (per_cu < 1) per_cu = 1;
        if (per_cu > 1) per_cu = 1;
        grid = cus * per_cu;
        if (n_in != 31 || ws_size < WS_END) { fprintf(stderr, "kernel_launch: unexpected n_in %d or ws_size %zu (< %zu)\n", n_in, ws_size, (size_t)WS_END); }
        (void)hipGetLastError();
    }
    (void)hipMemsetAsync((char*)d_ws + WS_CTL, 0, 16384, stream);
    Params p{};
    for (int i = 0; i < 31; ++i) p.in[i] = (const float*)d_in[i];
    p.out = (float*)d_out; p.ws = (unsigned char*)d_ws;
#if MK_SPLIT
    for (int st = 0; st < N_STEPS; ++st) {
        p.ph_lo = st; p.ph_hi = st + 1;
        hipLaunchKernelGGL(mega_fwd, dim3(grid), dim3(512), LDS_BYTES, stream, p);
    }
#else
    p.ph_lo = 0; p.ph_hi = N_STEPS;
    void* args[] = {&p};
    hipError_t e = hipLaunchCooperativeKernel((const void*)mega_fwd, dim3(grid), dim3(512), args, LDS_BYTES, stream);
    if (e != hipSuccess) fprintf(stderr, "cooperative launch failed: %s (grid %d)\n", hipGetErrorString(e), grid);
#endif
}
```

```cpp
#include <hip/hip_runtime.h>
#include <stdint.h>
#include <stdio.h>

typedef unsigned short bf16_t;
typedef short bf16x8 __attribute__((ext_vector_type(8)));
typedef short bf16x4 __attribute__((ext_vector_type(4)));
typedef float f32x4 __attribute__((ext_vector_type(4)));
typedef float f32x2 __attribute__((ext_vector_type(2)));
typedef unsigned u32x4 __attribute__((ext_vector_type(4)));
typedef unsigned u32x2 __attribute__((ext_vector_type(2)));
#define LAS __attribute__((address_space(3)))
#define DEVI __device__ __forceinline__

constexpr int NB = 16, SEQ = 2048, DM = 1024, NT = NB * SEQ;
constexpr float LOG2E = 1.4426950408889634f;
constexpr size_t MiB = 1024ull * 1024ull;

constexpr size_t WS_CTL = 0;
constexpr size_t WS_LAM = 64 * 1024;
constexpr size_t WS_ROPE_C = 128 * 1024;
constexpr size_t WS_ROPE_S = 384 * 1024;
constexpr size_t WS_GF = 640 * 1024;
constexpr size_t WS_A32 = 704 * 1024;
constexpr size_t WS_WIN0 = 1 * MiB;
constexpr size_t WS_WOUT0 = 5 * MiB;
constexpr size_t WS_WIN1 = 7 * MiB;
constexpr size_t WS_WOUT1 = 15 * MiB;
constexpr size_t WS_GLU = 17 * MiB;
constexpr size_t WS_WQK = 17 * MiB + 512 * 1024;
constexpr size_t WS_WV = 18 * MiB + 512 * 1024;
constexpr size_t WS_BT5A = 19 * MiB;
constexpr size_t WS_BT5B = 43 * MiB;
constexpr size_t WS_KL = 51 * MiB;
constexpr size_t WS_R1 = 52 * MiB;
constexpr size_t WS_R2 = 116 * MiB;
constexpr size_t WS_R3 = 372 * MiB;
constexpr size_t WS_R4 = 436 * MiB;
constexpr size_t WS_R5 = 500 * MiB;
constexpr size_t WS_END = 506 * MiB;
constexpr size_t WS_PZ = WS_R2;
constexpr size_t WS_U5 = WS_R2 + 96 * MiB;
constexpr size_t WS_XC = WS_R2 + 128 * MiB;
constexpr size_t WS_VTMP = WS_R2 + 160 * MiB;
constexpr size_t WS_VT0 = WS_R2 + 192 * MiB;
constexpr size_t WS_YLOC = WS_R2 + 224 * MiB;
constexpr size_t WS_CQ = WS_R2;
constexpr size_t WS_CK = WS_R2 + 32 * MiB;
constexpr size_t WS_CVTMP = WS_R2 + 64 * MiB;
constexpr size_t WS_CZ = WS_R2 + 96 * MiB;
constexpr size_t WS_DQ = WS_R2 + 128 * MiB;
constexpr size_t WS_DK = WS_R2 + 160 * MiB;
constexpr size_t WS_DVTMP = WS_R2 + 192 * MiB;
constexpr size_t WS_DZ = WS_R2 + 224 * MiB;
constexpr size_t WS_Y1 = WS_R2;
constexpr size_t WS_XN = WS_R1;
constexpr size_t WS_QK = WS_R1;
constexpr size_t WS_Y0 = WS_R1;
constexpr size_t WS_AB = WS_R3;
constexpr size_t WS_XN1 = WS_R3;
constexpr size_t WS_CD = WS_R3;
constexpr size_t WS_XLOC = WS_R4;
constexpr size_t WS_XST = WS_R4 + 16 * MiB;
constexpr size_t WS_G5 = WS_R4 + 32 * MiB;
constexpr size_t WS_CVT = WS_R4;
constexpr size_t WS_DVT = WS_R4 + 32 * MiB;
constexpr size_t WS_LI = WS_R5;
constexpr size_t WS_LF = WS_R5 + 512 * 1024;
constexpr size_t WS_BC = WS_R5 + 1024 * 1024;
constexpr size_t WS_DS = WS_R5 + 1536 * 1024;
constexpr size_t WS_SS0 = WS_R5 + 2 * MiB;
constexpr size_t WS_SS1 = WS_R5 + 4 * MiB;

DEVI unsigned cvt_pk_bf16(float lo, float hi) { unsigned r; asm("v_cvt_pk_bf16_f32 %0, %1, %2" : "=v"(r) : "v"(lo), "v"(hi)); return r; }
DEVI float bf2f(unsigned v16) { return __uint_as_float(v16 << 16); }
DEVI float bflo(unsigned w) { return __uint_as_float(w << 16); }
DEVI float bfhi(unsigned w) { return __uint_as_float(w & 0xffff0000u); }
DEVI bf16_t f2bf(float f) { return (bf16_t)(cvt_pk_bf16(f, 0.f) & 0xffffu); }
template <int CTRL> DEVI float dpp_f(float v) { return __int_as_float(__builtin_amdgcn_update_dpp(0, __float_as_int(v), CTRL, 0xF, 0xF, true)); }
DEVI float sum8_dpp(float v) { v += dpp_f<0xB1>(v); v += dpp_f<0x4E>(v); v += dpp_f<0x141>(v); return v; }
DEVI float wave_sum(float v) { v = sum8_dpp(v); v += dpp_f<0x140>(v)  ; v += __shfl_xor(v, 16); v += __shfl_xor(v, 32); return v; }
DEVI float fast_exp2(float x) { return __builtin_amdgcn_exp2f(x); }
DEVI float silu_f(float x) { return x * __builtin_amdgcn_rcpf(1.0f + __expf(-x)); }
DEVI float sigmoid_f(float x) { return __builtin_amdgcn_rcpf(1.0f + __expf(-x)); }
DEVI float gelu_tanh_f(float x) { const float u2 = 1.5957691216057308f * (x + 0.044715f * x * x * x); return x * __builtin_amdgcn_rcpf(1.0f + __expf(-u2)); }
DEVI float max3f(float a, float b, float c) { float r; asm("v_max3_f32 %0, %1, %2, %3" : "=v"(r) : "v"(a), "v"(b), "v"(c)); return r; }
DEVI f32x4 mfma16(bf16x8 a, bf16x8 b, f32x4 c) { return __builtin_amdgcn_mfma_f32_16x16x32_bf16(a, b, c, 0, 0, 0); }
DEVI void unpack8(const u32x4 q, float (&f)[8]) { f[0] = bflo(q.x); f[1] = bfhi(q.x); f[2] = bflo(q.y); f[3] = bfhi(q.y); f[4] = bflo(q.z); f[5] = bfhi(q.z); f[6] = bflo(q.w); f[7] = bfhi(q.w); }
DEVI u32x4 pack8(const float (&y)[8]) { u32x4 w; w.x = cvt_pk_bf16(y[0], y[1]); w.y = cvt_pk_bf16(y[2], y[3]); w.z = cvt_pk_bf16(y[4], y[5]); w.w = cvt_pk_bf16(y[6], y[7]); return w; }
namespace pg8 {
constexpr int BM = 256, BK = 64, HALF = 128, HTB = HALF * BK * 2  , STAGE_BYTES = 8 * HTB, NXCD = 8, WGM = 8;

__host__ __device__ __forceinline__ int lds_byte(int r, int c) { const int st = (r >> 4) * 2 + (c >> 5), rr = r & 15, cc = c & 31, ob = rr * 64 + cc * 2; return st * 1024 + (ob ^ (((ob >> 9) & 1) << 5)); }
__host__ __device__ __forceinline__ void stage_rc(int b, int& R, int& C) { const int st = b / 1024, sb = b % 1024, swz = sb ^ (((sb >> 9) & 1) << 5); R = (st >> 1) * 16 + swz / 64; C = (st & 1) * 32 + (swz % 64) / 2; }
__host__ __device__ __forceinline__ int perm32(int rho) { const int n = rho >> 4, i = rho & 15; return 8 * (i >> 2) + 4 * n + (i & 3); }

struct Unit { int pm, pn; };
struct Gemm { const bf16_t* A; const bf16_t* Bt; int M, N, K, lda, ldb, grp_shift; size_t grp_bbytes; int kdiag; };

struct StaticOrder {
    int nM, nN, nwg, G, c;
    __host__ __device__ void init(int M, int N, int G_, int c_) { nM = M / BM; nN = N / BM; nwg = nM * nN; G = G_; c = c_; }
    __host__ __device__ bool next(int i, Unit& u) const {
        const long L = (long)i * G + c; if (L >= nwg) return false;
        int wgid = (int)L; { const int q = nwg / NXCD, r = nwg % NXCD, xcd = wgid % NXCD, off = wgid / NXCD; wgid = (xcd < r ? xcd * (q + 1) : r * (q + 1) + (xcd - r) * q) + off; }
        const int nig = WGM * nN, gid = wgid / nig, fm = gid * WGM, gsz = (nM - fm) < WGM ? (nM - fm) : WGM;
        u.pm = fm + ((wgid % nig) % gsz); u.pn = (wgid % nig) / gsz; return true;
    }
};

template <class Epi>
__device__ __forceinline__ void gemm_phase(LAS unsigned char* lds, const Gemm g, const StaticOrder& S, const Epi& E) {
    const int tid = threadIdx.x, wid = __builtin_amdgcn_readfirstlane(tid >> 6), lane = tid & 63, wr = wid >> 2, wc = wid & 3, fr = lane & 15, fq = lane >> 4;
    int nt = g.K / BK; asm volatile("" : "+s"(nt));
    unsigned voffA[2], voffB[2];
#pragma unroll
    for (int i = 0; i < 2; ++i) { int R, C; stage_rc(tid * 16 + i * 8192, R, C); const int Rb = (R & ~31) + perm32(R & 31);
        voffA[i] = (unsigned)(R * g.lda + C) * 2u; voffB[i] = (unsigned)(Rb * g.ldb + C) * 2u; }
    const size_t kstep = (size_t)(BK * 2);
    const size_t hstepA = (size_t)HALF * g.lda * 2, hstepB = (size_t)HALF * g.ldb * 2;
    const size_t tstepA = 2 * hstepA, tstepB = 2 * hstepB;
    const unsigned ldsw = (unsigned)wid * 1024u;
    const int aoff = lds_byte(wr * 64 + fr, fq * 8), boff = lds_byte(wc * 32 + fr, fq * 8);
#define PG8_SA(b, h) (((b) * 2 + (h)) * HTB)
#define PG8_SB(b, h) ((4 + (b) * 2 + (h)) * HTB)
#define PG8_STAGE(bufoff, gbase, voff) do { _Pragma("unroll") for (int _i = 0; _i < 2; ++_i) \
        __builtin_amdgcn_global_load_lds((const unsigned*)((const char*)(gbase) + (voff)[_i]), (LAS unsigned*)(lds + (bufoff) + ldsw + _i * 8192), 16, 0, 0); } while (0)
#define PG8_LDA(dst, b, h) do { _Pragma("unroll") for (int m = 0; m < 4; ++m) _Pragma("unroll") for (int k = 0; k < 2; ++k) dst[m][k] = *(const LAS bf16x8*)(lds + PG8_SA(b, h) + aoff + m * 2048 + k * 1024); } while (0)
#define PG8_LDB(dst, b, h) do { _Pragma("unroll") for (int n = 0; n < 2; ++n) _Pragma("unroll") for (int k = 0; k < 2; ++k) dst[n][k] = *(const LAS bf16x8*)(lds + PG8_SB(b, h) + boff + n * 2048 + k * 1024); } while (0)
#define PG8_MMA(ai, bj, At, Bt) do { __builtin_amdgcn_s_setprio(1); _Pragma("unroll") for (int m = 0; m < 4; ++m) _Pragma("unroll") for (int n = 0; n < 2; ++n) _Pragma("unroll") for (int k = 0; k < 2; ++k) \
        acc[ai][bj][m][n] = __builtin_amdgcn_mfma_f32_16x16x32_bf16(Bt[n][k], At[m][k], acc[ai][bj][m][n], 0, 0, 0); __builtin_amdgcn_s_setprio(0); } while (0)
#define PG8_WAIT_V(n) asm volatile("s_waitcnt vmcnt(" #n ")" ::: "memory")
#define PG8_WAIT_L(n) asm volatile("s_waitcnt lgkmcnt(" #n ")" ::: "memory")
#define PG8_BAR __builtin_amdgcn_s_barrier()
#define PG8_SCHED __builtin_amdgcn_sched_barrier(0)
#define PG8_BBASE(u) ((const char*)g.Bt + (size_t)((u).pm >> g.grp_shift) * g.grp_bbytes + (size_t)(u).pn * tstepB + (size_t)(g.kdiag * ((u).pn & 1)) * 2)
#define PG8_ABASE(u) ((const char*)g.A + (size_t)(u).pm * tstepA + (size_t)(g.kdiag * ((u).pn & 1)) * 2)
    Unit cur, nxt; int ui = 0;
    __syncthreads();
    if (!S.next(0, cur)) return;
    f32x4 acc[2][2][4][2];
#pragma unroll
    for (int a = 0; a < 2; ++a)
#pragma unroll
        for (int b = 0; b < 2; ++b)
#pragma unroll
            for (int m = 0; m < 4; ++m)
#pragma unroll
                for (int n = 0; n < 2; ++n) acc[a][b][m][n] = (f32x4){0.f, 0.f, 0.f, 0.f};
    bf16x8 At[4][2], B0[2][2], B1[2][2];
    const char* cA = PG8_ABASE(cur); const char* cB = PG8_BBASE(cur);
    PG8_STAGE(PG8_SB(0, 0), cB, voffB); PG8_STAGE(PG8_SA(0, 0), cA, voffA); PG8_STAGE(PG8_SB(0, 1), cB + hstepB, voffB); PG8_STAGE(PG8_SA(0, 1), cA + hstepA, voffA);
    if (wr == 1) PG8_BAR;
    PG8_WAIT_V(4); PG8_BAR;
    PG8_STAGE(PG8_SB(1, 0), cB + kstep, voffB); PG8_STAGE(PG8_SA(1, 0), cA + kstep, voffA); PG8_STAGE(PG8_SB(1, 1), cB + hstepB + kstep, voffB);
    PG8_WAIT_V(6); PG8_BAR;
    for (;;) {
        const bool has_next = S.next(ui + 1, nxt);
        const char* nA = has_next ? PG8_ABASE(nxt) : cA; const char* nB = has_next ? PG8_BBASE(nxt) : cB;
        for (int t = 0; t < nt; t += 2) {
            const bool last = (t == nt - 2);
            const char* a1 = cA + (size_t)(t + 1) * kstep;
            const char* a2 = last ? nA : cA + (size_t)(t + 2) * kstep; const char* b2 = last ? nB : cB + (size_t)(t + 2) * kstep;
            const char* a3 = a2 + kstep; const char* b3 = b2 + kstep;
            PG8_LDB(B0, 0, 0); PG8_SCHED; PG8_LDA(At, 0, 0); PG8_STAGE(PG8_SA(1, 1), a1 + hstepA, voffA);
            PG8_WAIT_L(8); PG8_BAR; PG8_WAIT_L(0); PG8_MMA(0, 0, At, B0); PG8_BAR; PG8_SCHED;
            PG8_LDB(B1, 0, 1); PG8_STAGE(PG8_SB(0, 0), b2, voffB);
            PG8_BAR; PG8_WAIT_L(0); PG8_MMA(0, 1, At, B1); PG8_BAR;
            PG8_LDA(At, 0, 1); PG8_STAGE(PG8_SA(0, 0), a2, voffA);
            PG8_BAR; PG8_WAIT_L(0); PG8_MMA(1, 0, At, B0); PG8_BAR; PG8_SCHED;
            PG8_STAGE(PG8_SB(0, 1), b2 + hstepB, voffB);
            PG8_WAIT_V(6); PG8_BAR; PG8_MMA(1, 1, At, B1); PG8_BAR;
            PG8_LDB(B0, 1, 0); PG8_SCHED; PG8_LDA(At, 1, 0); PG8_STAGE(PG8_SA(0, 1), a2 + hstepA, voffA);
            PG8_WAIT_L(8); PG8_BAR; PG8_WAIT_L(0); PG8_MMA(0, 0, At, B0); PG8_BAR; PG8_SCHED;
            PG8_LDB(B1, 1, 1); PG8_STAGE(PG8_SB(1, 0), b3, voffB);
            PG8_BAR; PG8_WAIT_L(0); PG8_MMA(0, 1, At, B1); PG8_BAR;
            PG8_LDA(At, 1, 1); PG8_STAGE(PG8_SA(1, 0), a3, voffA);
            PG8_BAR; PG8_WAIT_L(0); PG8_MMA(1, 0, At, B0); PG8_BAR; PG8_SCHED;
            PG8_STAGE(PG8_SB(1, 1), b3 + hstepB, voffB);
            PG8_WAIT_V(6); PG8_BAR; PG8_MMA(1, 1, At, B1); PG8_BAR;
        }
        E(acc, cur, wr, wc, fr, fq);
        if (!has_next) break;
#pragma unroll
        for (int a = 0; a < 2; ++a)
#pragma unroll
            for (int b = 0; b < 2; ++b)
#pragma unroll
                for (int m = 0; m < 4; ++m)
#pragma unroll
                    for (int n = 0; n < 2; ++n) acc[a][b][m][n] = (f32x4){0.f, 0.f, 0.f, 0.f};
        cur = nxt; cA = nA; cB = nB; ++ui;
    }
    PG8_WAIT_V(0);
    if (wr == 0) PG8_BAR;
    PG8_BAR;
#undef PG8_SA
#undef PG8_SB
#undef PG8_STAGE
#undef PG8_LDA
#undef PG8_LDB
#undef PG8_MMA
#undef PG8_WAIT_V
#undef PG8_WAIT_L
#undef PG8_BAR
#undef PG8_SCHED
#undef PG8_BBASE
#undef PG8_ABASE
}
}
#define XB_TMO      128
#define XB_XCNT(j)  (256  + 64 * (j))
#define XB_XSUB(j)  (1280 + 64 * (j))
#define XB_XGEN(j)  (2304 + 64 * (j))
#define XB_TOP      3328
#define XB_TOPGEN   3392
#define XCD_BAR_WORDS 3456
#define XB_SPIN_CAP (1u << 22)
__device__ __forceinline__ unsigned xb_ld(unsigned* p)              { return __hip_atomic_load(p, __ATOMIC_RELAXED, __HIP_MEMORY_SCOPE_AGENT); }
__device__ __forceinline__ unsigned xb_add(unsigned* p, unsigned v) { return __hip_atomic_fetch_add(p, v, __ATOMIC_RELAXED, __HIP_MEMORY_SCOPE_AGENT); }
__device__ __forceinline__ unsigned xb_xcc_id() { return (unsigned)__builtin_amdgcn_s_getreg((3 << 11) | 20) & 0xFu; }
#define XB_SPIN(cond, bar) do { unsigned _sp = 0; while (cond) { __builtin_amdgcn_s_sleep(1); \
    if ((++_sp & 255u) == 0u) { if (xb_ld(&(bar)[XB_TMO])) break; if (_sp > XB_SPIN_CAP) { atomicAdd(&(bar)[XB_TMO], 1u); break; } } } } while (0)
struct XcdBarrier { unsigned* bar; unsigned x; volatile LAS unsigned* st; };
__device__ __forceinline__ XcdBarrier xcd_barrier_post(unsigned* bar, volatile LAS unsigned* st) {
    XcdBarrier b; b.bar = bar; b.x = xb_xcc_id(); b.st = st;
    if (threadIdx.x == 0) (void)xb_add(&bar[XB_XCNT(b.x)], 1u);
    return b;
}
__device__ __forceinline__ void xcd_barrier_complete(unsigned* bar, unsigned x, unsigned& nloc, unsigned& nx) {
    const unsigned G = gridDim.x * gridDim.y * gridDim.z;
    unsigned sum, cnt, mine, sp = 0u;
    for (;;) {
        sum = 0u; cnt = 0u; mine = 0u;
#pragma unroll
        for (unsigned j = 0; j < 16; ++j) { const unsigned c = xb_ld(&bar[XB_XCNT(j)]); sum += c; cnt += (c > 0u) ? 1u : 0u; mine = (j == x) ? c : mine; }
        if (sum == G) break;
        __builtin_amdgcn_s_sleep(1);
        if ((++sp & 255u) == 0u) { if (xb_ld(&bar[XB_TMO])) break; if (sp > XB_SPIN_CAP) { atomicAdd(&bar[XB_TMO], 1u); break; } }
    }
    nloc = mine > 0u ? mine : 1u; nx = cnt > 0u ? cnt : 1u;
}
__device__ __forceinline__ void xcd_barrier(const XcdBarrier& b) {
    asm volatile("s_waitcnt vmcnt(0)" ::: "memory");
    __syncthreads();
    if (threadIdx.x == 0) {
        unsigned* bar = b.bar;
        __builtin_amdgcn_s_waitcnt(0);
        unsigned nloc = b.st[0], nx = b.st[1];
        if (nloc == 0u) { xcd_barrier_complete(bar, b.x, nloc, nx); b.st[0] = nloc; b.st[1] = nx; }
        const unsigned old = xb_add(&bar[XB_XSUB(b.x)], 1u);
        const unsigned gen = old / nloc;
        if (old + 1u == (gen + 1u) * nloc) {
            __builtin_amdgcn_fence(__ATOMIC_RELEASE, "agent");
            asm volatile("s_waitcnt vmcnt(0)" ::: "memory");
            const unsigned og = xb_add(&bar[XB_TOP], 1u);
            const unsigned tg = og / nx;
            if (og + 1u == (tg + 1u) * nx) xb_add(&bar[XB_TOPGEN], 1u);
            else XB_SPIN(xb_ld(&bar[XB_TOPGEN]) == tg, bar);
            __builtin_amdgcn_fence(__ATOMIC_ACQUIRE, "agent");
            xb_add(&bar[XB_XGEN(b.x)], 1u);
            asm volatile("s_waitcnt vmcnt(0)" ::: "memory");
        } else {
            XB_SPIN(xb_ld(&bar[XB_XGEN(b.x)]) == gen, bar);
            __builtin_amdgcn_fence(__ATOMIC_ACQUIRE, "agent");
            asm volatile("s_waitcnt vmcnt(0)" ::: "memory");
        }
    }
    __syncthreads();
}

enum { EM_IN0 = 0, EM_PLAIN = 1, EM_S5A = 2, EM_S5B = 3, EM_GLU = 4, EM_OUT = 5, EM_IN1 = 6 };
template <int mode> struct EpiMulti {
    int ldc;
    bf16_t* o0; bf16_t* o1; float* f0;
    const bf16_t* i0; const bf16_t* i1; const float* c0; const float* c1;
    unsigned char* ws;
    struct Ld { u32x4 a[2], b[2]; };
    __device__ __forceinline__ void load_it(Ld& L, int it, int rowb, int colb) const {
        const int row = rowb + (it >> 2) * 128 + (it & 3) * 16;
        if constexpr (mode == EM_S5B) {
#pragma unroll
            for (int bj = 0; bj < 2; ++bj) { const size_t idx = (size_t)row * 512 + colb + bj * 128; L.a[bj] = *(const u32x4*)(i0 + idx); L.b[bj] = *(const u32x4*)(i1 + idx); }
        } else if constexpr (mode == EM_GLU) {
#pragma unroll
            for (int bj = 0; bj < 2; ++bj) { const int c = colb + bj * 128; L.a[bj] = *(const u32x4*)(i0 + (size_t)row * 512 + c); L.b[bj] = *(const u32x4*)(i1 + (size_t)row * 1536 + c); }
        } else if constexpr (mode == EM_IN1) {
            const int l = row & 2047, j0 = ((colb & 63) >> 3) * 4;
            L.a[0] = *(const u32x4*)(c0 + l * 32 + j0); L.b[0] = *(const u32x4*)(c1 + l * 32 + j0);
        }
    }
    __device__ __forceinline__ void operator()(const f32x4 (&acc)[2][2][4][2], const pg8::Unit& u, int wr, int wc, int fr, int fq) const {
        const int rowb = u.pm * 256 + wr * 64 + fr;
        const int colb = u.pn * 256 + wc * 32 + 8 * fq;
        constexpr bool HAS_LD = (mode == EM_S5B || mode == EM_GLU || mode == EM_IN1);
        Ld cur, nxt;
        if constexpr (HAS_LD) load_it(cur, 0, rowb, colb);
        f32x4 dsk0, dsk1;
        if constexpr (mode == EM_S5B) { const int g = rowb >> 10, ch = colb & 15; dsk0 = *(const f32x4*)(c0 + g * 16 + ch); dsk1 = *(const f32x4*)(c0 + g * 16 + ch + 4); }
#pragma unroll
        for (int it = 0; it < 8; ++it) {
            const int ai = it >> 2, m = it & 3;
            const int row = rowb + ai * 128 + m * 16;
            if constexpr (HAS_LD) { if (it + 1 < 8) load_it(nxt, it + 1, rowb, colb); asm volatile("" ::: "memory"); }
            float ssq = 0.f;
#pragma unroll
            for (int bj = 0; bj < 2; ++bj) {
                const int c = colb + bj * 128;
                f32x4 v0 = acc[ai][bj][m][0], v1 = acc[ai][bj][m][1];
                if constexpr (mode == EM_PLAIN) {
                    u32x4 w; w.x = cvt_pk_bf16(v0[0], v0[1]); w.y = cvt_pk_bf16(v0[2], v0[3]); w.z = cvt_pk_bf16(v1[0], v1[1]); w.w = cvt_pk_bf16(v1[2], v1[3]);
                    *(u32x4*)(o0 + (size_t)row * ldc + c) = w;
                } else if constexpr (mode == EM_IN0) {
                    u32x4 w; w.x = cvt_pk_bf16(v0[0], v0[1]); w.y = cvt_pk_bf16(v0[2], v0[3]); w.z = cvt_pk_bf16(v1[0], v1[1]); w.w = cvt_pk_bf16(v1[2], v1[3]);
                    if (c < 512) {
                        const int g = c >> 4, b = row >> 11, l = row & 2047;
                        *(u32x4*)(o1 + ((size_t)((g * 16 + b) * 2048 + l)) * 16 + (c & 15)) = w;
                    } else {
                        *(u32x4*)(o0 + (size_t)row * 1536 + (c - 512)) = w;
                    }
                } else if constexpr (mode == EM_S5A) {
                    if (c < 512) {
                        u32x4 w; w.x = cvt_pk_bf16(v0[0], v0[1]); w.y = cvt_pk_bf16(v0[2], v0[3]); w.z = cvt_pk_bf16(v1[0], v1[1]); w.w = cvt_pk_bf16(v1[2], v1[3]);
                        *(u32x4*)(o0 + (size_t)row * 512 + c) = w;
                    } else if (c < 640) {
                        float* p = f0 + (size_t)row * 128 + (c - 512);
                        *(f32x4*)p = v0; *(f32x4*)(p + 4) = v1;
                    }
                } else if constexpr (mode == EM_S5B) {
                    const u32x4 yl = cur.a[bj], uu = cur.b[bj];
                    const int g = row >> 10, b = (row >> 6) & 15, ck = row & 63, t = c >> 4, ch = c & 15;
                    float y[8];
                    y[0] = v0[0] + bflo(yl.x) + dsk0[0] * bflo(uu.x); y[1] = v0[1] + bfhi(yl.x) + dsk0[1] * bfhi(uu.x);
                    y[2] = v0[2] + bflo(yl.y) + dsk0[2] * bflo(uu.y); y[3] = v0[3] + bfhi(yl.y) + dsk0[3] * bfhi(uu.y);
                    y[4] = v1[0] + bflo(yl.z) + dsk1[0] * bflo(uu.z); y[5] = v1[1] + bfhi(yl.z) + dsk1[1] * bfhi(uu.z);
                    y[6] = v1[2] + bflo(yl.w) + dsk1[2] * bflo(uu.w); y[7] = v1[3] + bfhi(yl.w) + dsk1[3] * bfhi(uu.w);
#pragma unroll
                    for (int j = 0; j < 8; ++j) y[j] = gelu_tanh_f(y[j]);
                    u32x4 w; w.x = cvt_pk_bf16(y[0], y[1]); w.y = cvt_pk_bf16(y[2], y[3]); w.z = cvt_pk_bf16(y[4], y[5]); w.w = cvt_pk_bf16(y[6], y[7]);
                    const size_t tok = (size_t)b * 2048 + ck * 32 + t;
                    *(u32x4*)(o0 + tok * 512 + g * 16 + ch) = w;
                } else if constexpr (mode == EM_GLU) {
                    const u32x4 gg = cur.a[bj], zz = cur.b[bj];
                    const f32x4 b0 = *(const f32x4*)(c0 + c), b1 = *(const f32x4*)(c0 + c + 4);
                    float y[8];
                    y[0] = bflo(gg.x) * sigmoid_f(v0[0] + b0[0]) * silu_f(bflo(zz.x)); y[1] = bfhi(gg.x) * sigmoid_f(v0[1] + b0[1]) * silu_f(bfhi(zz.x));
                    y[2] = bflo(gg.y) * sigmoid_f(v0[2] + b0[2]) * silu_f(bflo(zz.y)); y[3] = bfhi(gg.y) * sigmoid_f(v0[3] + b0[3]) * silu_f(bfhi(zz.y));
                    y[4] = bflo(gg.z) * sigmoid_f(v1[0] + b1[0]) * silu_f(bflo(zz.z)); y[5] = bfhi(gg.z) * sigmoid_f(v1[1] + b1[1]) * silu_f(bfhi(zz.z));
                    y[6] = bflo(gg.w) * sigmoid_f(v1[2] + b1[2]) * silu_f(bflo(zz.w)); y[7] = bfhi(gg.w) * sigmoid_f(v1[3] + b1[3]) * silu_f(bfhi(zz.w));
                    u32x4 w; w.x = cvt_pk_bf16(y[0], y[1]); w.y = cvt_pk_bf16(y[2], y[3]); w.z = cvt_pk_bf16(y[4], y[5]); w.w = cvt_pk_bf16(y[6], y[7]);
                    *(u32x4*)(o0 + (size_t)row * 1024 + c) = w;
                } else if constexpr (mode == EM_OUT) {
                    u32x4 w; w.x = cvt_pk_bf16(v0[0], v0[1]); w.y = cvt_pk_bf16(v0[2], v0[3]); w.z = cvt_pk_bf16(v1[0], v1[1]); w.w = cvt_pk_bf16(v1[2], v1[3]);
                    *(u32x4*)(o0 + (size_t)row * 1024 + c) = w;
                    ssq += (v0[0] * v0[0] + v0[1] * v0[1]) + (v0[2] * v0[2] + v0[3] * v0[3]) + (v1[0] * v1[0] + v1[1] * v1[1]) + (v1[2] * v1[2] + v1[3] * v1[3]);
                } else {
                    const int blk = c >> 9, cc = c & 511, b = row >> 11, l = row & 2047;
                    f32x4 r0 = v0, r1 = v1;
                    if (blk == 0 || blk == 1 || blk == 4 || blk == 5) {
                        const f32x4 cs = __builtin_bit_cast(f32x4, cur.a[0]), sn = __builtin_bit_cast(f32x4, cur.b[0]);
#pragma unroll
                        for (int e = 0; e < 4; ++e) { r0[e] = v0[e] * cs[e] - v1[e] * sn[e]; r1[e] = v1[e] * cs[e] + v0[e] * sn[e]; }
                    }
                    u32x4 w; w.x = cvt_pk_bf16(r0[0], r0[1]); w.y = cvt_pk_bf16(r0[2], r0[3]); w.z = cvt_pk_bf16(r1[0], r1[1]); w.w = cvt_pk_bf16(r1[2], r1[3]);
                    if (blk == 3 || blk >= 6) {
                        bf16_t* base = (bf16_t*)(ws + (blk == 3 ? WS_CZ : blk == 6 ? WS_DVTMP : WS_DZ));
                        *(u32x4*)(base + (size_t)row * 512 + cc) = w;
                    } else {
                        bf16_t* base = (bf16_t*)(ws + (blk == 0 ? WS_CQ : blk == 1 ? WS_CK : blk == 2 ? WS_CVTMP : blk == 4 ? WS_DQ : WS_DK));
                        *(u32x4*)(base + ((size_t)((b * 8 + (cc >> 6)) * 2048 + l)) * 64 + (cc & 63)) = w;
                    }
                }
            }
            if constexpr (mode == EM_OUT) {
                ssq += __shfl_xor(ssq, 16); ssq += __shfl_xor(ssq, 32);
                if (fq == 0) f0[(size_t)row * 16 + u.pn * 4 + wc] = ssq;
            }
            if constexpr (HAS_LD) cur = nxt;
        }
    }
};

struct Params { const float* in[31]; float* out; unsigned char* ws; int ph_lo, ph_hi; int rep_mask, pad; };
struct Ctx {
    const float* const* in; float* out; unsigned char* ws;
    LAS unsigned char* lds; int tid, lane, wid, G, bid;
};
#define WSP(T, off) ((T*)(C.ws + (off)))

DEVI void rows_pass(const Ctx& C, int mode) {
    const float* x = C.in[0];
    const float* pre = C.in[1]; const float* post = C.in[2];
    const bf16_t* Y0 = WSP(const bf16_t, WS_Y0); const bf16_t* Y1 = WSP(const bf16_t, WS_Y1);
    const float* SS0 = WSP(const float, WS_SS0); const float* SS1 = WSP(const float, WS_SS1);
    bf16_t* XN = (mode == 0) ? WSP(bf16_t, WS_XN) : WSP(bf16_t, WS_XN1);
    const int gw = C.bid * 8 + C.wid, nw = C.G * 8, lane = C.lane;
    for (int r = gw; r < NT; r += nw) {
        f32x4 v[4];
#pragma unroll
        for (int i = 0; i < 4; ++i) v[i] = *(const f32x4*)(x + (size_t)r * 1024 + i * 256 + lane * 4);
        if (mode >= 1) {
            float s0 = (lane < 16) ? SS0[(size_t)r * 16 + lane] : 0.f; s0 = wave_sum(s0);
            const float rs0 = rsqrtf(s0 * (1.0f / 1024.0f) + 1e-6f);
#pragma unroll
            for (int i = 0; i < 4; ++i) {
                const u32x2 y = *(const u32x2*)(Y0 + (size_t)r * 1024 + i * 256 + lane * 4);
                const f32x4 gp = *(const f32x4*)(post + i * 256 + lane * 4);
                v[i][0] += bflo(y.x) * rs0 * gp[0]; v[i][1] += bfhi(y.x) * rs0 * gp[1]; v[i][2] += bflo(y.y) * rs0 * gp[2]; v[i][3] += bfhi(y.y) * rs0 * gp[3];
            }
        }
        if (mode == 2) {
            float s1 = (lane < 16) ? SS1[(size_t)r * 16 + lane] : 0.f; s1 = wave_sum(s1);
            const float rs1 = rsqrtf(s1 * (1.0f / 1024.0f) + 1e-6f);
#pragma unroll
            for (int i = 0; i < 4; ++i) {
                const u32x2 y = *(const u32x2*)(Y1 + (size_t)r * 1024 + i * 256 + lane * 4);
                const f32x4 gp = *(const f32x4*)(post + 1024 + i * 256 + lane * 4);
                f32x4 o = v[i];
                o[0] += bflo(y.x) * rs1 * gp[0]; o[1] += bfhi(y.x) * rs1 * gp[1]; o[2] += bflo(y.y) * rs1 * gp[2]; o[3] += bfhi(y.y) * rs1 * gp[3];
                *(f32x4*)(C.out + (size_t)r * 1024 + i * 256 + lane * 4) = o;
            }
        } else {
            float ss = 0.f;
#pragma unroll
            for (int i = 0; i < 4; ++i) ss += (v[i][0] * v[i][0] + v[i][1] * v[i][1]) + (v[i][2] * v[i][2] + v[i][3] * v[i][3]);
            ss = wave_sum(ss);
            const float rs = rsqrtf(ss * (1.0f / 1024.0f) + 1e-6f);
            const float* gpre = pre + (mode == 0 ? 0 : 1024);
#pragma unroll
            for (int i = 0; i < 4; ++i) {
                const f32x4 gp = *(const f32x4*)(gpre + i * 256 + lane * 4);
                u32x2 w; w.x = cvt_pk_bf16(v[i][0] * rs * gp[0], v[i][1] * rs * gp[1]); w.y = cvt_pk_bf16(v[i][2] * rs * gp[2], v[i][3] * rs * gp[3]);
                *(u32x2*)(XN + (size_t)r * 1024 + i * 256 + lane * 4) = w;
            }
        }
    }
}

DEVI int rope_dim(int p) { return ((p & 7) < 4) ? (4 * (p >> 3) + (p & 7)) : (32 + 4 * (p >> 3) + ((p & 7) - 4)); }
DEVI void wt_tile(const Ctx& C, const float* W, int K, int N, bf16_t* Wt, int tile, bool rope_perm) {
    LAS float* T = (LAS float*)C.lds;
    const int ntn = N / 64, tk = tile / ntn, tn = tile % ntn, k0 = tk * 64, n0 = tn * 64, tid = C.tid;
    __syncthreads();
#pragma unroll
    for (int i = 0; i < 2; ++i) { const int e = tid + i * 512, r = e >> 4, c4 = (e & 15) * 4;
        const f32x4 v = *(const f32x4*)(W + (size_t)(k0 + r) * N + n0 + c4);
        T[r * 65 + c4 + 0] = v[0]; T[r * 65 + c4 + 1] = v[1]; T[r * 65 + c4 + 2] = v[2]; T[r * 65 + c4 + 3] = v[3]; }
    __syncthreads();
    const int nn = tid >> 3, kc = (tid & 7) * 8;
    bool perm = false;
    if (rope_perm) { const int blk = n0 >> 9; perm = (blk == 0 || blk == 1 || blk == 4 || blk == 5); }
    const int src = perm ? rope_dim(nn) : nn;
    float f[8];
#pragma unroll
    for (int j = 0; j < 8; ++j) f[j] = T[(kc + j) * 65 + src];
    u32x4 w; w.x = cvt_pk_bf16(f[0], f[1]); w.y = cvt_pk_bf16(f[2], f[3]); w.z = cvt_pk_bf16(f[4], f[5]); w.w = cvt_pk_bf16(f[6], f[7]);
    *(u32x4*)(Wt + (size_t)(n0 + nn) * K + k0 + kc) = w;
}

DEVI void s5_tables(const Ctx& C, int g, int part) {
    LAS float* APr = (LAS float*)C.lds;
    LAS float* APi = APr + 64 * 33;
    LAS float* BBr = APi + 64 * 33;
    LAS float* BBi = BBr + 1024;
    LAS float* Cr = BBi + 1024;
    LAS float* Ci = Cr + 1024;
    LAS float* KL = Ci + 1024;
    const int tid = C.tid;
    const float* lre = C.in[4]; const float* lim = C.in[5]; const float* ldt = C.in[6];
    const float* bre = C.in[7]; const float* bim = C.in[8]; const float* cre = C.in[9]; const float* cim = C.in[10];
    __syncthreads();
    if (tid < 64) {
        const int p = tid;
        const float lr = lre[g * 64 + p], li = lim[g * 64 + p], dt = expf(ldt[g]);
        const float mag = expf(lr * dt);
        const float ar = mag * cosf(li * dt), ai = mag * sinf(li * dt);
        const float den = lr * lr + li * li;
        const float fr = ((ar - 1.0f) * lr + ai * li) / den, fi = (ai * lr - (ar - 1.0f) * li) / den;
        double pr = 1.0, pi = 0.0;
        for (int k = 0; k <= 32; ++k) { APr[p * 33 + k] = (float)pr; APi[p * 33 + k] = (float)pi; const double nr = pr * (double)ar - pi * (double)ai, ni = pr * (double)ai + pi * (double)ar; pr = nr; pi = ni; }
        for (int c = 0; c < 16; ++c) { const float br = bre[(g * 64 + p) * 16 + c], bi = bim[(g * 64 + p) * 16 + c]; BBr[p * 16 + c] = fr * br - fi * bi; BBi[p * 16 + c] = fr * bi + fi * br; }
    }
    for (int e = tid; e < 1024; e += 512) { Cr[e] = cre[g * 1024 + e]; Ci[e] = cim[g * 1024 + e]; }
    __syncthreads();
    bf16_t* A5 = WSP(bf16_t, WS_BT5A) + (size_t)g * 768 * 512;
    bf16_t* B5 = WSP(bf16_t, WS_BT5B) + (size_t)g * 512 * 256;
    float* KLg = WSP(float, WS_KL) + (size_t)g * 8192;
    for (int e = tid; e < 1024; e += 512) {
        const int k = part * 4 + (e >> 8), c = (e >> 4) & 15, cp = e & 15; float s = 0.f;
        for (int p = 0; p < 64; ++p) { const float a_r = APr[p * 33 + k], a_i = APi[p * 33 + k], c_r = Cr[c * 64 + p], c_i = Ci[c * 64 + p];
            const float car = c_r * a_r - c_i * a_i, cai = c_r * a_i + c_i * a_r; s += car * BBr[p * 16 + cp] - cai * BBi[p * 16 + cp]; }
        KLg[k * 256 + (e & 255)] = s;
    }
    for (int e = tid; e < 32 * 64; e += 512) {
        const int R = 512 + part * 32 + (e >> 6), col0 = (e & 63) * 8; float f[8];
        if (R < 640) { const int pp = R - 512, p = pp >> 1, ri = pp & 1, s = col0 >> 4, cp0 = col0 & 15;
            const float a_r = APr[p * 33 + (31 - s)], a_i = APi[p * 33 + (31 - s)];
#pragma unroll
            for (int j = 0; j < 8; ++j) { const float b_r = BBr[p * 16 + cp0 + j], b_i = BBi[p * 16 + cp0 + j]; f[j] = ri ? (a_r * b_i + a_i * b_r) : (a_r * b_r - a_i * b_i); }
        } else {
#pragma unroll
            for (int j = 0; j < 8; ++j) f[j] = 0.f;
        }
        *(u32x4*)(A5 + (size_t)R * 512 + col0) = pack8(f);
    }
    for (int e = tid; e < 64 * 32; e += 512) {
        const int R = part * 64 + (e >> 5), col0 = (e & 31) * 8, t = R >> 4, c = R & 15; float f[8];
        if (col0 < 128) {
#pragma unroll
            for (int j = 0; j < 4; ++j) { const int p = (col0 >> 1) + j; const float a_r = APr[p * 33 + t + 1], a_i = APi[p * 33 + t + 1], c_r = Cr[c * 64 + p], c_i = Ci[c * 64 + p];
                f[2 * j] = c_r * a_r - c_i * a_i; f[2 * j + 1] = -(c_r * a_i + c_i * a_r); }
        } else {
#pragma unroll
            for (int j = 0; j < 8; ++j) f[j] = 0.f;
        }
        *(u32x4*)(B5 + (size_t)R * 256 + col0) = pack8(f);
    }
    if (part == 0 && tid < 64) { f32x2 a; a.x = APr[tid * 33 + 32]; a.y = APi[tid * 33 + 32]; WSP(f32x2, WS_A32)[g * 64 + tid] = a; }
}


DEVI void s5_fill_t0(const Ctx& C) {
    LAS float* KL = (LAS float*)C.lds;
    for (int job = C.bid; job < 256; job += C.G) {
        const int g = job >> 3, part = job & 7;
        __syncthreads();
        for (int e = C.tid; e < 8192; e += 512) KL[e] = WSP(const float, WS_KL)[(size_t)g * 8192 + e];
        __syncthreads();
        bf16_t* A5 = WSP(bf16_t, WS_BT5A) + (size_t)g * 768 * 512;
        for (int e = C.tid; e < 64 * 64; e += 512) {
            const int R = part * 64 + (e >> 6), col0 = (e & 63) * 8, t = R >> 4, c = R & 15, s = col0 >> 4, cp0 = col0 & 15; float f[8];
#pragma unroll
            for (int j = 0; j < 8; ++j) f[j] = (s <= t) ? KL[(t - s) * 256 + c * 16 + cp0 + j] : 0.f;
            *(u32x4*)(A5 + (size_t)R * 512 + col0) = pack8(f);
        }
    }
}


DEVI void phase_prologue(const Ctx& C) {
    const int tid = C.tid, G = C.G, bid = C.bid;
    {
        const int t0 = 16 * 32, t1 = t0 + 16 * 16, t2 = t1 + 16 * 64, t3 = t2 + 16 * 16, t4 = t3 + 8 * 8;
        for (int j = bid; j < t4; j += G) {
            if (j < t0) wt_tile(C, C.in[3], 1024, 2048, WSP(bf16_t, WS_WIN0), j, false);
            else if (j < t1) wt_tile(C, C.in[23], 1024, 1024, WSP(bf16_t, WS_WOUT0), j - t0, false);
            else if (j < t2) wt_tile(C, C.in[24], 1024, 4096, WSP(bf16_t, WS_WIN1), j - t1, true);
            else if (j < t3) wt_tile(C, C.in[30], 1024, 1024, WSP(bf16_t, WS_WOUT1), j - t2, false);
            else wt_tile(C, C.in[12], 512, 512, WSP(bf16_t, WS_GLU), j - t3, false);
        }
    }
    for (int j = bid; j < 256; j += G) s5_tables(C, j >> 3, j & 7);
    const int gt = bid * 512 + tid, ngt = G * 512;
    {
        const float* wq = C.in[16]; const float* wk = C.in[17]; const float* wv = C.in[18];
        bf16_t* WQK = WSP(bf16_t, WS_WQK); bf16_t* WV = WSP(bf16_t, WS_WV);
        for (int e = gt; e < 1536 * 512; e += ngt) {
            const int n = e >> 9, k = e & 511; const int nn = n & 511, h = nn >> 7, ee = nn & 127; float v = 0.f;
            if ((k >> 7) == h) { const int d = k & 127; const size_t wi = ((size_t)h * 128 + d) * 128 + ee;
                v = (n < 512) ? wq[wi] : (n < 1024) ? wk[wi] * 0.08838834764831845f : wv[wi]; }
            if (n < 1024) WQK[(size_t)n * 512 + k] = f2bf(v); else WV[(size_t)(n - 1024) * 512 + k] = f2bf(v);
        }
        const float* gw = C.in[19]; float* GF = WSP(float, WS_GF);
        for (int e = bid * 8 + C.wid; e < 1024 * 8; e += G * 8) {
            const int rr = e >> 3, j = e & 7, ch = rr & 511, h = ch >> 7, d = ch & 127; float s = 0.f;
#pragma unroll
            for (int q2 = 0; q2 < 2; ++q2) { const int ee = C.lane + 64 * q2; const size_t wi = ((size_t)h * 128 + d) * 128 + ee;
                if (rr < 512) s += wq[wi] * gw[(size_t)(h * 128 + ee) * 8 + j] + wk[wi] * gw[(size_t)(512 + h * 128 + ee) * 8 + j];
                else s += wv[wi] * gw[(size_t)(1024 + h * 128 + ee) * 8 + j]; }
            s = wave_sum(s);
            if (C.lane == 0) GF[e] = s;
        }
    }
    {
        float* RC = WSP(float, WS_ROPE_C); float* RS = WSP(float, WS_ROPE_S);
        for (int e = gt; e < 2048 * 32; e += ngt) { const int pos = e >> 5, j = e & 31; const float inv = powf(10000.0f, -(float)(2 * j) / 64.0f); const float ang = (float)pos * inv; RC[e] = cosf(ang); RS[e] = sinf(ang); }
    }
    if (bid == 0 && tid < 64) {
        const float s1 = wave_sum(C.in[25][tid] * C.in[26][tid]), s2 = wave_sum(C.in[27][tid] * C.in[28][tid]);
        if (tid == 0) WSP(float, WS_LAM)[0] = expf(s1) - expf(s2) + (0.8f - 0.6f * expf(-0.3f));
    }
    rows_pass(C, 0);
}

DEVI void phase_conv_gates(const Ctx& C) {
    const bf16_t* PZ = WSP(const bf16_t, WS_PZ); bf16_t* XC = WSP(bf16_t, WS_XC);
    float* LI = WSP(float, WS_LI); float* LF = WSP(float, WS_LF);
    const float* cw = C.in[14]; const float* cb = C.in[15]; const float* gb = C.in[20];
    LAS float* GFs = (LAS float*)C.lds;
    __syncthreads();
    for (int e = C.tid; e < 8192; e += 512) {
        const int rr = e >> 3, j = e & 7, ch = rr & 511, part = (rr >> 9) * 2 + (j >> 2);
        GFs[((part * 8 + (ch & 7)) * 64 + (ch >> 3)) * 4 + (j & 3)] = WSP(const float, WS_GF)[e]; }
    __syncthreads();
    const int lane = C.lane, ch0 = lane * 8;
    float w[4][8], bb[8];
#pragma unroll
    for (int j = 0; j < 4; ++j)
#pragma unroll
        for (int i = 0; i < 8; ++i) w[j][i] = cw[j * 512 + ch0 + i];
#pragma unroll
    for (int i = 0; i < 8; ++i) bb[i] = cb[ch0 + i];
    const int gw = C.bid * 8 + C.wid, nw = C.G * 8;
    for (int chunk = gw; chunk < NT / 16; chunk += nw) {
        const int r0 = chunk * 16, l0 = r0 & 2047;
        float xs[4][8];
#pragma unroll
        for (int j = 0; j < 3; ++j) {
            const int dl = 3 - j;
            if (l0 - dl >= 0) { const u32x4 q = *(const u32x4*)(PZ + (size_t)(r0 - dl) * 1536 + 512 + ch0); unpack8(q, xs[j]); }
            else {
#pragma unroll
                for (int i = 0; i < 8; ++i) xs[j][i] = 0.f; }
        }
        u32x4 nxt = *(const u32x4*)(PZ + (size_t)r0 * 1536 + 512 + ch0);
        for (int tk = 0; tk < 16; ++tk) {
            const int r = r0 + tk, l = l0 + tk;
            unpack8(nxt, xs[3]);
            if (tk + 1 < 16) nxt = *(const u32x4*)(PZ + (size_t)(r + 1) * 1536 + 512 + ch0);
            float xc[8];
#pragma unroll
            for (int i = 0; i < 8; ++i) { const float a = bb[i] + xs[0][i] * w[0][i] + xs[1][i] * w[1][i] + xs[2][i] * w[2][i] + xs[3][i] * w[3][i]; xc[i] = silu_f(a); }
            *(u32x4*)(XC + (size_t)r * 512 + ch0) = pack8(xc);
            float gt8[8];
#pragma unroll
            for (int j = 0; j < 8; ++j) gt8[j] = 0.f;
#pragma unroll
            for (int i = 0; i < 8; ++i) {
                const f32x4 a0 = *(const LAS f32x4*)(GFs + ((0 * 8 + i) * 64 + lane) * 4), a1 = *(const LAS f32x4*)(GFs + ((1 * 8 + i) * 64 + lane) * 4);
                const f32x4 b0 = *(const LAS f32x4*)(GFs + ((2 * 8 + i) * 64 + lane) * 4), b1 = *(const LAS f32x4*)(GFs + ((3 * 8 + i) * 64 + lane) * 4);
                const float xcv = xc[i], xmv = xs[3][i];
                gt8[0] += xcv * a0[0] + xmv * b0[0]; gt8[1] += xcv * a0[1] + xmv * b0[1]; gt8[2] += xcv * a0[2] + xmv * b0[2]; gt8[3] += xcv * a0[3] + xmv * b0[3];
                gt8[4] += xcv * a1[0] + xmv * b1[0]; gt8[5] += xcv * a1[1] + xmv * b1[1]; gt8[6] += xcv * a1[2] + xmv * b1[2]; gt8[7] += xcv * a1[3] + xmv * b1[3];
            }
            float gsel;
            { const bool h32 = lane >= 32, h16 = (lane >> 4) & 1, h8 = (lane >> 3) & 1;
              float a4[4], b2[2];
#pragma unroll
              for (int k = 0; k < 4; ++k) { const float keep = h32 ? gt8[4 + k] : gt8[k], send = h32 ? gt8[k] : gt8[4 + k]; a4[k] = keep + __shfl_xor(send, 32); }
#pragma unroll
              for (int k = 0; k < 2; ++k) { const float keep = h16 ? a4[2 + k] : a4[k], send = h16 ? a4[k] : a4[2 + k]; b2[k] = keep + __shfl_xor(send, 16); }
              const float keep = h8 ? b2[1] : b2[0], send = h8 ? b2[0] : b2[1];
              gsel = sum8_dpp(keep + dpp_f<0x128>(send)); }
            if ((lane & 7) == 0) {
                const int gj = lane >> 3;
                gsel += gb[gj];
                const int b = r >> 11;
                if (gj < 4) LI[(size_t)(b * 4 + gj) * 2048 + l] = gsel;
                else { const float ax = fabsf(gsel); const float ls = fminf(gsel, 0.f) - log1pf(expf(-ax)); LF[(size_t)(b * 4 + gj - 4) * 2048 + l] = ls; }
            }
#pragma unroll
            for (int i = 0; i < 8; ++i) { xs[0][i] = xs[1][i]; xs[1][i] = xs[2][i]; xs[2][i] = xs[3][i]; }
        }
    }
}

DEVI void phase_cumsum(const Ctx& C) {
    const int gw = C.bid * 8 + C.wid, lane = C.lane;
    if (gw < 64) {
        const float* LF = WSP(const float, WS_LF) + (size_t)gw * 2048; const float* LI = WSP(const float, WS_LI) + (size_t)gw * 2048;
        float* BC = WSP(float, WS_BC) + (size_t)gw * 2048; float* DS = WSP(float, WS_DS) + (size_t)gw * 2048;
        float tot = 0.f;
        for (int j = 0; j < 32; ++j) tot += LF[lane * 32 + j];
        float inc = tot;
#pragma unroll
        for (int d = 1; d < 64; d <<= 1) { const float o = __shfl_up(inc, d); if (lane >= d) inc += o; }
        float run = inc - tot;
        for (int j = 0; j < 32; ++j) { run += LF[lane * 32 + j]; BC[lane * 32 + j] = run; DS[lane * 32 + j] = LI[lane * 32 + j] - run; }
    }
}

DEVI void s5_scan_panel(const Ctx& C, int pm) {
    const float* XLOC = WSP(const float, WS_XLOC); bf16_t* XST = WSP(bf16_t, WS_XST); const f32x2* A32 = WSP(const f32x2, WS_A32);
    if (C.tid < 256) {
        const int p = C.tid & 63, gb = pm * 4 + (C.tid >> 6), g = gb >> 4;
        const f32x2 a = A32[g * 64 + p]; float xr = 0.f, xi = 0.f;
        for (int ib = 0; ib < 8; ++ib) {
            f32x2 lc[8];
#pragma unroll
            for (int k = 0; k < 8; ++k) lc[k] = *(const f32x2*)(XLOC + ((size_t)gb * 64 + ib * 8 + k) * 128 + 2 * p);
#pragma unroll
            for (int k = 0; k < 8; ++k) {
                const size_t n = (size_t)gb * 64 + ib * 8 + k;
                *(unsigned*)(XST + n * 256 + 2 * p) = cvt_pk_bf16(xr, xi);
                *(unsigned*)(XST + n * 256 + 128 + 2 * p) = 0u;
                const float nr = a.x * xr - a.y * xi + lc[k].x, ni = a.x * xi + a.y * xr + lc[k].y; xr = nr; xi = ni;
            }
        }
    }
    asm volatile("s_waitcnt vmcnt(0)" ::: "memory");
}
constexpr float NEG_INF = -__builtin_inff();
typedef float f32x16 __attribute__((ext_vector_type(16)));
typedef short s16x4 __attribute__((ext_vector_type(4)));
DEVI f32x16 mfma32(bf16x8 a, bf16x8 b, f32x16 c) { return __builtin_amdgcn_mfma_f32_32x32x16_bf16(a, b, c, 0, 0, 0); }
DEVI s16x4 tr_read(const LAS unsigned char* p) { return __builtin_amdgcn_ds_read_tr16_b64_v4i16((LAS s16x4*)p); }

template <int DQK, int DV, int MODE, int NG>
DEVI void flash_core(const Ctx& C, const bf16_t* Qg0, const bf16_t* Kg0, const bf16_t* Vg0, const bf16_t* Qg1, const bf16_t* Kg1, const bf16_t* Vg1,
                     int ldq, int ldk, int ldv, int qb, int t_lo, int t_hi, int W, float sc,
                     const float* BCs, const float* DSs, f32x16 (&o)[DV / 32], float& lsum, float& m) {
    constexpr int NKS = DQK / 16, NDT = DV / 32, KROW = (DQK + 8) * 2, KBUF = 64 * KROW, VROW = DV * 2 + 64, VBUF = 64 * VROW, NKC = DQK / 8, NVC = DV / 8;
    constexpr int TG = 512 / NG, KLD = (64 * NKC) / TG, VLD = (64 * NVC) / TG, GSZ = 2 * KBUF + 2 * VBUF + 512;
    const int tid = C.tid, lane = C.lane, w = C.wid, ql = lane & 31, h = lane >> 5;
    const int grp = (NG == 2) ? (w >> 2) : 0, wg = (NG == 2) ? (w & 3) : w, tg = (NG == 2) ? (tid & 255) : tid;
    const bf16_t* Qg = (NG == 2 && grp) ? Qg1 : Qg0; const bf16_t* Kg = (NG == 2 && grp) ? Kg1 : Kg0; const bf16_t* Vg = (NG == 2 && grp) ? Vg1 : Vg0;
    LAS unsigned char* lds = C.lds + grp * GSZ;
    const int q0w = qb + 32 * wg, q = q0w + ql;
    bf16x8 qf[NKS];
#pragma unroll
    for (int ks = 0; ks < NKS; ++ks) qf[ks] = *(const bf16x8*)(Qg + (size_t)q * ldq + 16 * ks + 8 * h);
#pragma unroll
    for (int d = 0; d < NDT; ++d)
#pragma unroll
        for (int r = 0; r < 16; ++r) o[d][r] = 0.f;
    m = NEG_INF; lsum = 0.f;
    const float bcq = MODE ? BCs[q] : 0.f;
    u32x4 kreg[KLD], vreg[VLD]; float cfreg = 0.f;
#define FL_LOAD(t) do { \
        _Pragma("unroll") for (int i_ = 0; i_ < KLD; ++i_) { const int idx_ = tg + TG * i_, key_ = idx_ / NKC, ch_ = idx_ % NKC; kreg[i_] = *(const u32x4*)(Kg + (size_t)(64 * (t) + key_) * ldk + ch_ * 8); } \
        _Pragma("unroll") for (int i_ = 0; i_ < VLD; ++i_) { const int idx_ = tg + TG * i_, key_ = idx_ / NVC, ch_ = idx_ % NVC; vreg[i_] = *(const u32x4*)(Vg + (size_t)(64 * (t) + key_) * ldv + ch_ * 8); } \
        if (MODE && tid < 64) cfreg = fast_exp2((BCs[64 * (t)] + DSs[64 * (t) + tid]) * LOG2E); } while (0)
#define FL_STORE(b) do { \
        _Pragma("unroll") for (int i_ = 0; i_ < KLD; ++i_) { const int idx_ = tg + TG * i_, key_ = idx_ / NKC, ch_ = idx_ % NKC; *(LAS u32x4*)(lds + (b) * KBUF + key_ * KROW + ch_ * 16) = kreg[i_]; } \
        _Pragma("unroll") for (int i_ = 0; i_ < VLD; ++i_) { const int idx_ = tg + TG * i_, key_ = idx_ / NVC, ch_ = idx_ % NVC; *(LAS u32x4*)(lds + 2 * KBUF + (b) * VBUF + key_ * VROW + ch_ * 16) = vreg[i_]; } \
        if (MODE && tid < 64) *(LAS float*)(lds + 2 * KBUF + 2 * VBUF + (b) * 256 + tid * 4) = cfreg; } while (0)
    __syncthreads();
    FL_LOAD(t_lo); FL_STORE(0);
    __syncthreads();
    const int li = lane & 15, qq = li >> 2, pp = li & 3, g2 = (lane >> 4) & 1;
    for (int t = t_lo; t < t_hi; ++t) {
        const int buf = (t - t_lo) & 1, k0 = 64 * t;
        if (t + 1 < t_hi) FL_LOAD(t + 1);
        if (k0 <= q0w + 31 && k0 + 63 >= q0w - W) {
            f32x16 st[2];
#pragma unroll
            for (int kt = 0; kt < 2; ++kt) {
#pragma unroll
                for (int r = 0; r < 16; ++r) st[kt][r] = 0.f;
                const LAS unsigned char* kb = lds + buf * KBUF + (32 * kt + ql) * KROW + 16 * h;
#pragma unroll
                for (int ks = 0; ks < NKS; ++ks) st[kt] = mfma32(*(const LAS bf16x8*)(kb + ks * 32), qf[ks], st[kt]);
            }
            const bool diag = (k0 + 63 > q0w) || (k0 < q0w + 31 - W);
            if (diag) {
#pragma unroll
                for (int kt = 0; kt < 2; ++kt)
#pragma unroll
                    for (int r = 0; r < 16; ++r) { const int key = k0 + 32 * kt + (r & 3) + 8 * (r >> 2) + 4 * h; const bool ok = (key <= q) && (q - key <= W);
                        st[kt][r] = ok ? st[kt][r] : (MODE == 0 ? NEG_INF : 0.f); }
            }
            float nmref = 0.f, rowf = 1.f;
            if (MODE == 0) {
                float rmax0 = max3f(st[0][0], st[1][0], st[0][1]), rmax1 = max3f(st[1][1], st[0][2], st[1][2]);
#pragma unroll
                for (int r = 3; r < 15; r += 2) { rmax0 = max3f(rmax0, st[0][r], st[1][r]); rmax1 = max3f(rmax1, st[0][r + 1], st[1][r + 1]); }
                float rmax = max3f(rmax0, rmax1, st[0][15]); rmax = fmaxf(rmax, st[1][15]); rmax = fmaxf(rmax, __shfl_xor(rmax, 32));
                const float smax = rmax * sc;
                if (!__all(smax <= m + 8.0f || smax == NEG_INF)) {
                    const float mn = fmaxf(m, smax), alpha = (mn == NEG_INF) ? 1.0f : fast_exp2(m - mn);
#pragma unroll
                    for (int d = 0; d < NDT; ++d) o[d] *= alpha;
                    lsum *= alpha; m = mn;
                }
                nmref = (m == NEG_INF) ? 0.f : -m;
            } else {
                rowf = fast_exp2((bcq - BCs[k0]) * LOG2E);
            }
            const LAS unsigned char* vl = lds + 2 * KBUF + buf * VBUF + (4 * h + qq) * VROW + (16 * g2 + 4 * pp) * 2;
            const LAS unsigned char* cfb = lds + 2 * KBUF + 2 * VBUF + buf * 256;
#pragma unroll
            for (int u = 0; u < 4; ++u) {
                const int kt = u >> 1, r0 = 8 * (u & 1);
                float pv_[8];
                if (MODE == 0) {
#pragma unroll
                    for (int e_ = 0; e_ < 8; ++e_) { pv_[e_] = fast_exp2(__builtin_fmaf(st[kt][r0 + e_], sc, nmref)); }
                } else {
                    const f32x4 c4a = *(const LAS f32x4*)(cfb + (32 * kt + 8 * (r0 >> 2) + 4 * h) * 4), c4b = *(const LAS f32x4*)(cfb + (32 * kt + 8 * ((r0 >> 2) + 1) + 4 * h) * 4);
#pragma unroll
                    for (int e_ = 0; e_ < 4; ++e_) { pv_[e_] = st[kt][r0 + e_] * (rowf * c4a[e_]); pv_[4 + e_] = st[kt][r0 + 4 + e_] * (rowf * c4b[e_]); }
                }
                lsum += ((pv_[0] + pv_[1]) + (pv_[2] + pv_[3])) + ((pv_[4] + pv_[5]) + (pv_[6] + pv_[7]));
                u32x4 wv; wv.x = cvt_pk_bf16(pv_[0], pv_[1]); wv.y = cvt_pk_bf16(pv_[2], pv_[3]); wv.z = cvt_pk_bf16(pv_[4], pv_[5]); wv.w = cvt_pk_bf16(pv_[6], pv_[7]);
                const bf16x8 pfu = __builtin_bit_cast(bf16x8, wv);
                __builtin_amdgcn_s_setprio(1);
#pragma unroll
                for (int d = 0; d < NDT; ++d) {
                    const s16x4 lo = tr_read(vl + u * 16 * VROW + d * 64), hi = tr_read(vl + u * 16 * VROW + 8 * VROW + d * 64);
                    bf16x8 vf; vf[0] = lo[0]; vf[1] = lo[1]; vf[2] = lo[2]; vf[3] = lo[3]; vf[4] = hi[0]; vf[5] = hi[1]; vf[6] = hi[2]; vf[7] = hi[3];
                    o[d] = mfma32(vf, pfu, o[d]);
                }
                __builtin_amdgcn_s_setprio(0);
            }
        }
        if (t + 1 < t_hi) FL_STORE(buf ^ 1);
        __syncthreads();
    }
#undef FL_LOAD
#undef FL_STORE
}

template <int DV> struct WTile { static constexpr int RS = DV * 2 + 16, BYTES = 32 * RS; };
template <int DV>
DEVI void wt_write(LAS unsigned char* wt, const f32x16 (&o)[DV / 32], float a, float bsub, int ql, int h2) {
#pragma unroll
    for (int d = 0; d < DV / 32; ++d)
#pragma unroll
        for (int g = 0; g < 4; ++g) {
            u32x2 wv; wv.x = cvt_pk_bf16((o[d][4 * g] - bsub) * a, (o[d][4 * g + 1] - bsub) * a); wv.y = cvt_pk_bf16((o[d][4 * g + 2] - bsub) * a, (o[d][4 * g + 3] - bsub) * a);
            *(LAS u32x2*)(wt + ql * WTile<DV>::RS + (32 * d + 8 * g + 4 * h2) * 2) = wv;
        }
    asm volatile("" ::: "memory");
}

DEVI void phase_mlstm_blk(const Ctx& C) {
    const bf16_t* QK = WSP(const bf16_t, WS_QK); const bf16_t* V = WSP(const bf16_t, WS_VTMP);
    const float* BC = WSP(const float, WS_BC); const float* DS = WSP(const float, WS_DS);
    const bf16_t* XC = WSP(const bf16_t, WS_XC); const bf16_t* PZ = WSP(const bf16_t, WS_PZ);
    bf16_t* AB = WSP(bf16_t, WS_AB);
    const float* ng = C.in[21]; const float* sk = C.in[22];
    const int lane = C.lane, ql = lane & 31, h2 = lane >> 5;
    LAS unsigned char* wt = C.lds + C.wid * WTile<128>::BYTES;
    for (int task = C.bid; task < 512; task += C.G) {
        const int rr = task >> 8, xx = task & 7, lix = (task >> 3) & 31, seq = 32 * rr + 4 * xx + (lix >> 3), j = rr ? 7 - (lix & 7) : (lix & 7);
        const int b = seq >> 2, h = seq & 3;
        const bf16_t* Qg = QK + (size_t)b * 2048 * 1024 + h * 128;
        f32x16 o[4]; float dsum, mdummy;
        { const bf16_t* Vg = V + (size_t)b * 2048 * 512 + h * 128;
          flash_core<128, 128, 1, 1>(C, Qg, Qg + 512, Vg, Qg, Qg + 512, Vg, 1024, 1024, 512, 256 * j, 0, 4 * (j + 1), 1 << 20, 1.0f, BC + (size_t)seq * 2048, DS + (size_t)seq * 2048, o, dsum, mdummy); }
        dsum += __shfl_xor(dsum, 32);
        const float rden = 1.0f / fmaxf(fabsf(dsum), 1.0f);
        float su = 0.f;
#pragma unroll
        for (int d = 0; d < 4; ++d) { o[d] *= rden;
#pragma unroll
            for (int r = 0; r < 16; ++r) su += o[d][r]; }
        su += __shfl_xor(su, 32);
        const float mu = su * (1.0f / 128.0f);
        float sv = 0.f;
#pragma unroll
        for (int d = 0; d < 4; ++d)
#pragma unroll
            for (int r = 0; r < 16; ++r) { const float dd = o[d][r] - mu; sv += dd * dd; }
        sv += __shfl_xor(sv, 32);
        const float rstd = rsqrtf(sv * (1.0f / 128.0f) + 1e-5f);
        wt_write<128>(wt, o, rstd, mu, ql, h2);
        const size_t row0 = (size_t)b * 2048 + 256 * j + 32 * C.wid;
#pragma unroll 2
        for (int it = 0; it < 8; ++it) {
            const int idx = it * 64 + lane, rl_ = idx >> 4, c8 = idx & 15, ch = h * 128 + c8 * 8; const size_t row = row0 + rl_;
            float v[8], xc[8], zz[8], y[8];
            unpack8(*(const LAS u32x4*)(wt + rl_ * WTile<128>::RS + c8 * 16), v);
            unpack8(*(const u32x4*)(XC + row * 512 + ch), xc); unpack8(*(const u32x4*)(PZ + row * 1536 + 1024 + ch), zz);
            const f32x4 g0 = *(const f32x4*)(ng + ch), g1 = *(const f32x4*)(ng + ch + 4), s0 = *(const f32x4*)(sk + ch), s1 = *(const f32x4*)(sk + ch + 4);
#pragma unroll
            for (int e = 0; e < 4; ++e) { y[e] = (v[e] * g0[e] + s0[e] * xc[e]) * silu_f(zz[e]); y[4 + e] = (v[4 + e] * g1[e] + s1[e] * xc[4 + e]) * silu_f(zz[4 + e]); }
            *(u32x4*)(AB + row * 1024 + 512 + ch) = pack8(y);
        }
    }
}

DEVI void phase_diff_blk(const Ctx& C) {
    const bf16_t* DQ = WSP(const bf16_t, WS_DQ); const bf16_t* DK = WSP(const bf16_t, WS_DK); const bf16_t* DV = WSP(const bf16_t, WS_DVTMP);
    const bf16_t* DZ = WSP(const bf16_t, WS_DZ); bf16_t* CD = WSP(bf16_t, WS_CD);
    const float* dn = C.in[29];
    const float lam = WSP(const float, WS_LAM)[0];
    const float lam_init = 0.8f - 0.6f * 0.7408182206817179f;
    const int lane = C.lane, ql = lane & 31, h2 = lane >> 5;
    const float sc = 0.125f * LOG2E;
    LAS unsigned char* wt = C.lds + 59904 + C.wid * WTile<128>::BYTES;
    for (int task = C.bid; task < 512; task += C.G) {
        const int rr = task >> 8, xx = task & 7, lix = (task >> 3) & 31, seq = 32 * rr + 4 * xx + (lix >> 3), j = rr ? 7 - (lix & 7) : (lix & 7);
        const int b = seq >> 2, h = seq & 3;
        const bf16_t* Vg = DV + (size_t)b * 2048 * 512 + h * 128;
        f32x16 o[4]; float l;
#pragma unroll 1
        for (int comp = 0; comp < 2; ++comp) {
            const size_t hb = ((size_t)(b * 8 + 2 * h + comp)) * 2048 * 64;
            float mdummy;
            flash_core<64, 128, 0, 1>(C, DQ + hb, DK + hb, Vg, DQ + hb, DK + hb, Vg, 64, 64, 512, 256 * j, 0, 4 * (j + 1), 1 << 20, sc, nullptr, nullptr, o, l, mdummy);
            l += __shfl_xor(l, 32);
            if (comp == 0) {
                wt_write<128>(wt, o, 1.0f / l, 0.f, ql, h2);
            } else {
                const float rl = lam / l; float ss = 0.f;
#pragma unroll
                for (int d = 0; d < 4; ++d)
#pragma unroll
                    for (int g = 0; g < 4; ++g) {
                        const u32x2 q0 = *(const LAS u32x2*)(wt + ql * WTile<128>::RS + (32 * d + 8 * g + 4 * h2) * 2);
                        const float a0[4] = {bflo(q0.x), bfhi(q0.x), bflo(q0.y), bfhi(q0.y)};
#pragma unroll
                        for (int e = 0; e < 4; ++e) { const float r_ = a0[e] - o[d][4 * g + e] * rl; o[d][4 * g + e] = r_; ss += r_ * r_; }
                    }
                ss += __shfl_xor(ss, 32);
                const float rn = rsqrtf(ss * (1.0f / 128.0f) + 1e-5f) * (1.0f - lam_init);
                wt_write<128>(wt, o, rn, 0.f, ql, h2);
            }
        }
        const size_t row0 = (size_t)b * 2048 + 256 * j + 32 * C.wid;
#pragma unroll 2
        for (int it = 0; it < 8; ++it) {
            const int idx = it * 64 + lane, rl_ = idx >> 4, c8 = idx & 15, dv = c8 * 8, ch = h * 128 + dv; const size_t row = row0 + rl_;
            float v[8], zz[8], y[8];
            unpack8(*(const LAS u32x4*)(wt + rl_ * WTile<128>::RS + c8 * 16), v);
            unpack8(*(const u32x4*)(DZ + row * 512 + ch), zz);
            const f32x4 g0 = *(const f32x4*)(dn + dv), g1 = *(const f32x4*)(dn + dv + 4);
#pragma unroll
            for (int e = 0; e < 4; ++e) { y[e] = v[e] * g0[e] * silu_f(zz[e]); y[4 + e] = v[4 + e] * g1[e] * silu_f(zz[4 + e]); }
            *(u32x4*)(CD + row * 1024 + 512 + ch) = pack8(y);
        }
    }
}

DEVI void phase_dil23(const Ctx& C) {
    const bf16_t* CQ = WSP(const bf16_t, WS_CQ); const bf16_t* CK = WSP(const bf16_t, WS_CK); const bf16_t* CV = WSP(const bf16_t, WS_CVTMP);
    bf16_t* O2 = WSP(bf16_t, WS_CVT); bf16_t* CD = WSP(bf16_t, WS_CD);
    float* LSE2 = WSP(float, WS_LI); float* LSE3 = WSP(float, WS_BC);
    const int lane = C.lane, ql = lane & 31, h2 = lane >> 5, w = C.wid;
    const float sc = 0.125f * LOG2E;
    LAS unsigned char* wt = C.lds + w * WTile<64>::BYTES;
    for (int task = C.bid; task < 1024; task += C.G) {
        const int jb = (task < 512) ? 1 : 0, r4 = task & 3, h = (task >> 2) & 7, b = (task >> 5) & 15;
        const size_t base = ((size_t)(b * 8 + h) * 2048 + r4) * 64;
        f32x16 o[2]; float l, m;
        flash_core<64, 64, 0, 1>(C, CQ + base, CK + base, CV + base, CQ + base, CK + base, CV + base, 256, 256, 256, 256 * jb, jb ? 2 : 0, jb ? 8 : 4, 128, sc, nullptr, nullptr, o, l, m);
        l += __shfl_xor(l, 32);
        wt_write<64>(wt, o, 1.0f / l, 0.f, ql, h2);
        const size_t tokb = (size_t)b * 2048 + 4 * (256 * jb + 32 * w) + r4;
        if (h2 == 0) LSE2[(tokb + 4 * ql) * 8 + h] = m + __log2f(l);
#pragma unroll
        for (int it = 0; it < 4; ++it) { const int idx = it * 64 + lane, rl_ = idx >> 3, c8 = idx & 7;
            *(u32x4*)(O2 + (tokb + 4 * rl_) * 512 + h * 64 + c8 * 8) = *(const LAS u32x4*)(wt + rl_ * WTile<64>::RS + c8 * 16); }
    }
    for (int task = C.bid; task < 1024; task += C.G) {
        const int cp = task & 7, h = (task >> 3) & 7, b = (task >> 6) & 15;
        const size_t base0 = ((size_t)(b * 8 + h) * 2048 + 2 * cp) * 64, base1 = base0 + 64;
        f32x16 o[2]; float l, m;
        flash_core<64, 64, 0, 2>(C, CQ + base0, CK + base0, CV + base0, CQ + base1, CK + base1, CV + base1, 1024, 1024, 1024, 0, 0, 2, 1 << 20, sc, nullptr, nullptr, o, l, m);
        l += __shfl_xor(l, 32);
        wt_write<64>(wt, o, 1.0f / l, 0.f, ql, h2);
        const size_t tokb = (size_t)b * 2048 + 16 * (32 * (w & 3)) + 2 * cp + (w >> 2);
        if (h2 == 0) LSE3[(tokb + 16 * ql) * 8 + h] = m + __log2f(l);
#pragma unroll
        for (int it = 0; it < 4; ++it) { const int idx = it * 64 + lane, rl_ = idx >> 3, c8 = idx & 7;
            *(u32x4*)(CD + (tokb + 16 * rl_) * 1024 + h * 64 + c8 * 8) = *(const LAS u32x4*)(wt + rl_ * WTile<64>::RS + c8 * 16); }
    }
}

DEVI void phase_dil1(const Ctx& C) {
    const bf16_t* CQ = WSP(const bf16_t, WS_CQ); const bf16_t* CK = WSP(const bf16_t, WS_CK); const bf16_t* CV = WSP(const bf16_t, WS_CVTMP);
    const bf16_t* O2 = WSP(const bf16_t, WS_CVT); bf16_t* CD = WSP(bf16_t, WS_CD); const bf16_t* CZ = WSP(const bf16_t, WS_CZ);
    const float* LSE2 = WSP(const float, WS_LI); const float* LSE3 = WSP(const float, WS_BC);
    const int lane = C.lane, ql = lane & 31, h2 = lane >> 5, w = C.wid;
    const float sc = 0.125f * LOG2E;
    LAS unsigned char* wt = C.lds + w * (WTile<64>::BYTES + 256);
    LAS float* wsc = (LAS float*)(wt + WTile<64>::BYTES);
    for (int task = C.bid; task < 1024; task += C.G) {
        const int j = 7 - (task & 7), h = (task >> 3) & 7, b = (task >> 6) & 15;
        const size_t base = (size_t)(b * 8 + h) * 2048 * 64;
        f32x16 o[2]; float l, m;
        flash_core<64, 64, 0, 1>(C, CQ + base, CK + base, CV + base, CQ + base, CK + base, CV + base, 64, 64, 64, 256 * j, (4 * j - 2) < 0 ? 0 : (4 * j - 2), 4 * j + 4, 128, sc, nullptr, nullptr, o, l, m);
        l += __shfl_xor(l, 32);
        const size_t tok0 = (size_t)b * 2048 + 256 * j + 32 * w;
        {
            const size_t tok = tok0 + ql;
            const float lse1 = m + __log2f(l), lse2 = LSE2[tok * 8 + h], lse3 = LSE3[tok * 8 + h];
            const float M = fmaxf(lse1, fmaxf(lse2, lse3));
            const float e1 = fast_exp2(lse1 - M), w2 = fast_exp2(lse2 - M), w3 = fast_exp2(lse3 - M);
            const float rden = 1.0f / (e1 + w2 + w3);
            wt_write<64>(wt, o, e1 * rden / l, 0.f, ql, h2);
            if (h2 == 0) { wsc[2 * ql] = w2 * rden; wsc[2 * ql + 1] = w3 * rden; }
            asm volatile("" ::: "memory");
        }
#pragma unroll 2
        for (int it = 0; it < 4; ++it) {
            const int idx = it * 64 + lane, rl_ = idx >> 3, c8 = idx & 7, ch = h * 64 + c8 * 8; const size_t tok = tok0 + rl_;
            float v[8], p2[8], p3[8], zz[8], y[8];
            unpack8(*(const LAS u32x4*)(wt + rl_ * WTile<64>::RS + c8 * 16), v);
            const float a2 = wsc[2 * rl_], a3 = wsc[2 * rl_ + 1];
            unpack8(*(const u32x4*)(O2 + tok * 512 + ch), p2); unpack8(*(const u32x4*)(CD + tok * 1024 + ch), p3); unpack8(*(const u32x4*)(CZ + tok * 512 + ch), zz);
#pragma unroll
            for (int e = 0; e < 8; ++e) y[e] = (v[e] + p2[e] * a2 + p3[e] * a3) * silu_f(zz[e]);
            *(u32x4*)(CD + tok * 1024 + ch) = pack8(y);
        }
    }
}
constexpr int N_STEPS = 17;
constexpr int LDS_BYTES = pg8::STAGE_BYTES + 256;

template <int MODE>
DEVI void run_gemm(const Ctx& C, const EpiMulti<MODE>& E, const bf16_t* A, int lda, const bf16_t* Bt, int ldb, int N, int K, int grp_shift, size_t grp_bbytes, int kdiag = 0) {
    pg8::Gemm g; g.A = A; g.Bt = Bt; g.M = NT; g.N = N; g.K = K; g.lda = lda; g.ldb = ldb; g.grp_shift = grp_shift; g.grp_bbytes = grp_bbytes; g.kdiag = kdiag;
    pg8::StaticOrder S; S.init(NT, N, C.G, C.bid);
    pg8::gemm_phase<EpiMulti<MODE>>(C.lds, g, S, E);
}
template <int MODE> DEVI EpiMulti<MODE> mk_epi(const Ctx& C) { EpiMulti<MODE> E; E.ldc = 0; E.o0 = nullptr; E.o1 = nullptr; E.f0 = nullptr; E.i0 = nullptr; E.i1 = nullptr; E.c0 = nullptr; E.c1 = nullptr; E.ws = C.ws; return E; }

__global__ void __launch_bounds__(512, 2) mega_fwd(Params P) {
    extern __shared__ __attribute__((aligned(16))) unsigned char lds_raw[];
    Ctx C;
    C.in = P.in;
    C.out = P.out; C.ws = P.ws; C.lds = (LAS unsigned char*)lds_raw;
    C.tid = threadIdx.x; C.lane = C.tid & 63; C.wid = __builtin_amdgcn_readfirstlane(C.tid >> 6); C.G = gridDim.x; C.bid = blockIdx.x;
    volatile LAS unsigned* bst = (volatile LAS unsigned*)(C.lds + pg8::STAGE_BYTES);
    if (C.tid < 4) bst[C.tid] = 0u;
    __syncthreads();
    XcdBarrier bar = xcd_barrier_post((unsigned*)(C.ws + WS_CTL), bst);
#define ON(k) (P.ph_lo <= (k) && (k) < P.ph_hi)
#define STEP(k, ...) if (ON(k)) { __VA_ARGS__ }
#define BAR(k) do { if (ON(k) && (k) + 1 < P.ph_hi) xcd_barrier(bar); } while (0)
    STEP(0, phase_prologue(C);)
    BAR(0);
    STEP(1, { auto E = mk_epi<EM_IN0>(C); E.o0 = WSP(bf16_t, WS_PZ); E.o1 = WSP(bf16_t, WS_U5);
        run_gemm(C, E, WSP(const bf16_t, WS_XN), 1024, WSP(const bf16_t, WS_WIN0), 1024, 2048, 1024, 0, 0); })
    BAR(1);
    STEP(2, { phase_conv_gates(C); s5_fill_t0(C); })
    BAR(2);
    STEP(3, { auto E = mk_epi<EM_PLAIN>(C); E.o0 = WSP(bf16_t, WS_QK); E.ldc = 1024;
        run_gemm(C, E, WSP(const bf16_t, WS_XC), 512, WSP(const bf16_t, WS_WQK), 512, 1024, 256, 0, 0, 256); })
    STEP(4, { auto E = mk_epi<EM_PLAIN>(C); E.o0 = WSP(bf16_t, WS_VTMP); E.ldc = 512;
        run_gemm(C, E, WSP(const bf16_t, WS_PZ) + 512, 1536, WSP(const bf16_t, WS_WV), 512, 512, 256, 0, 0, 256); })
    STEP(5, { auto E = mk_epi<EM_S5A>(C); E.o0 = WSP(bf16_t, WS_YLOC); E.f0 = WSP(float, WS_XLOC);
        run_gemm(C, E, WSP(const bf16_t, WS_U5), 512, WSP(const bf16_t, WS_BT5A), 512, 768, 512, 2, (size_t)768 * 512 * 2); })
    STEP(6, phase_cumsum(C);)
    BAR(6);
    STEP(7, phase_mlstm_blk(C);)
    STEP(8, { { pg8::StaticOrder S_; S_.init(NT, 512, C.G, C.bid); pg8::Unit u_; for (int i_ = 0; S_.next(i_, u_); ++i_) s5_scan_panel(C, u_.pm); }
        auto E = mk_epi<EM_S5B>(C); E.o0 = WSP(bf16_t, WS_G5); E.i0 = WSP(const bf16_t, WS_YLOC); E.i1 = WSP(const bf16_t, WS_U5); E.c0 = C.in[11];
        run_gemm(C, E, WSP(const bf16_t, WS_XST), 256, WSP(const bf16_t, WS_BT5B), 256, 512, 256, 2, (size_t)512 * 256 * 2); })
    BAR(8);
    STEP(9, { auto E = mk_epi<EM_GLU>(C); E.o0 = WSP(bf16_t, WS_AB); E.i0 = WSP(const bf16_t, WS_G5); E.i1 = WSP(const bf16_t, WS_PZ); E.c0 = C.in[13];
        run_gemm(C, E, WSP(const bf16_t, WS_G5), 512, WSP(const bf16_t, WS_GLU), 512, 512, 512, 0, 0); })
    BAR(9);
    STEP(10, { auto E = mk_epi<EM_OUT>(C); E.o0 = WSP(bf16_t, WS_Y0); E.f0 = WSP(float, WS_SS0);
        run_gemm(C, E, WSP(const bf16_t, WS_AB), 1024, WSP(const bf16_t, WS_WOUT0), 1024, 1024, 1024, 0, 0); })
    BAR(10);
    STEP(11, rows_pass(C, 1);)
    BAR(11);
    STEP(12, { auto E = mk_epi<EM_IN1>(C); E.c0 = WSP(const float, WS_ROPE_C); E.c1 = WSP(const float, WS_ROPE_S);
        run_gemm(C, E, WSP(const bf16_t, WS_XN1), 1024, WSP(const bf16_t, WS_WIN1), 1024, 4096, 1024, 0, 0); })
    BAR(12);
    STEP(13, { phase_diff_blk(C); phase_dil23(C); })
    BAR(13);
    STEP(14, phase_dil1(C);)
    BAR(14);
    STEP(15, { auto E = mk_epi<EM_OUT>(C); E.o0 = WSP(bf16_t, WS_Y1); E.f0 = WSP(float, WS_SS1);
        run_gemm(C, E, WSP(const bf16_t, WS_CD), 1024, WSP(const bf16_t, WS_WOUT1), 1024, 1024, 1024, 0, 0); })
    BAR(15);
    STEP(16, rows_pass(C, 2);)
#undef ON
#undef BAR
#undef STEP
}

#ifndef MK_SPLIT
#define MK_SPLIT 0
#endif
extern "C" void kernel_launch(void* const* d_in, const int* in_sizes, int n_in, void* d_out, int out_size, void* d_ws, size_t ws_size, hipStream_t stream) {
    static int grid = 0;
    if (grid == 0) {
        int dev = 0, cus = 0, per_cu = 0;
        (void)hipGetDevice(&dev);
        (void)hipDeviceGetAttribute(&cus, hipDeviceAttributeMultiprocessorCount, dev);
        (void)hipFuncSetAttribute((const void*)mega_fwd, hipFuncAttributeMaxDynamicSharedMemorySize, LDS_BYTES);
        (void)hipOccupancyMaxActiveBlocksPerMultiprocessor(&per_cu, (const void*)mega_fwd, 512, LDS_BYTES);
        if (per_cu < 1) per_cu = 1;
        if (per_cu > 1) per_cu = 1;
        grid = cus * per_cu;
        if (n_in != 31 || ws_size < WS_END) { fprintf(stderr, "kernel_launch: unexpected n_in %d or ws_size %zu (< %zu)\n", n_in, ws_size, (size_t)WS_END); }
        (void)hipGetLastError();
    }
    (void)hipMemsetAsync((char*)d_ws + WS_CTL, 0, 16384, stream);
    Params p{};
    for (int i = 0; i < 31; ++i) p.in[i] = (const float*)d_in[i];
    p.out = (float*)d_out; p.ws = (unsigned char*)d_ws;
#if MK_SPLIT
    for (int st = 0; st < N_STEPS; ++st) {
        p.ph_lo = st; p.ph_hi = st + 1;
        hipLaunchKernelGGL(mega_fwd, dim3(grid), dim3(512), LDS_BYTES, stream, p);
    }
#else
    p.ph_lo = 0; p.ph_hi = N_STEPS;
    void* args[] = {&p};
    hipError_t e = hipLaunchCooperativeKernel((const void*)mega_fwd, dim3(grid), dim3(512), args, LDS_BYTES, stream);
    if (e != hipSuccess) fprintf(stderr, "cooperative launch failed: %s (grid %d)\n", hipGetErrorString(e), grid);
#endif
}
```

```cpp
#include <hip/hip_runtime.h>
#include <stdint.h>
#include <stdio.h>

typedef unsigned short bf16_t;
typedef short bf16x8 __attribute__((ext_vector_type(8)));
typedef short bf16x4 __attribute__((ext_vector_type(4)));
typedef float f32x4 __attribute__((ext_vector_type(4)));
typedef float f32x2 __attribute__((ext_vector_type(2)));
typedef unsigned u32x4 __attribute__((ext_vector_type(4)));
typedef unsigned u32x2 __attribute__((ext_vector_type(2)));
#define LAS __attribute__((address_space(3)))
#define DEVI __device__ __forceinline__

constexpr int NB = 16, SEQ = 2048, DM = 1024, NT = NB * SEQ;
constexpr float LOG2E = 1.4426950408889634f;
constexpr size_t MiB = 1024ull * 1024ull;

constexpr size_t WS_CTL = 0;
constexpr size_t WS_LAM = 64 * 1024;
constexpr size_t WS_ROPE_C = 128 * 1024;
constexpr size_t WS_ROPE_S = 384 * 1024;
constexpr size_t WS_GF = 640 * 1024;
constexpr size_t WS_A32 = 704 * 1024;
constexpr size_t WS_WIN0 = 1 * MiB;
constexpr size_t WS_WOUT0 = 5 * MiB;
constexpr size_t WS_WIN1 = 7 * MiB;
constexpr size_t WS_WOUT1 = 15 * MiB;
constexpr size_t WS_GLU = 17 * MiB;
constexpr size_t WS_WQK = 17 * MiB + 512 * 1024;
constexpr size_t WS_WV = 18 * MiB + 512 * 1024;
constexpr size_t WS_BT5A = 19 * MiB;
constexpr size_t WS_BT5B = 43 * MiB;
constexpr size_t WS_KL = 51 * MiB;
constexpr size_t WS_R1 = 52 * MiB;
constexpr size_t WS_R2 = 116 * MiB;
constexpr size_t WS_R3 = 372 * MiB;
constexpr size_t WS_R4 = 436 * MiB;
constexpr size_t WS_R5 = 500 * MiB;
constexpr size_t WS_END = 506 * MiB;
constexpr size_t WS_PZ = WS_R2;
constexpr size_t WS_U5 = WS_R2 + 96 * MiB;
constexpr size_t WS_XC = WS_R2 + 128 * MiB;
constexpr size_t WS_VTMP = WS_R2 + 160 * MiB;
constexpr size_t WS_SST = WS_R2 + 192 * MiB;
constexpr size_t WS_NST = WS_R2 + 208 * MiB;
constexpr size_t WS_YLOC = WS_R2 + 224 * MiB;
constexpr size_t WS_CQ = WS_R2;
constexpr size_t WS_CK = WS_R2 + 32 * MiB;
constexpr size_t WS_CVTMP = WS_R2 + 64 * MiB;
constexpr size_t WS_CZ = WS_R2 + 96 * MiB;
constexpr size_t WS_DQ = WS_R2 + 128 * MiB;
constexpr size_t WS_DK = WS_R2 + 160 * MiB;
constexpr size_t WS_DVTMP = WS_R2 + 192 * MiB;
constexpr size_t WS_DZ = WS_R2 + 224 * MiB;
constexpr size_t WS_Y1 = WS_R2;
constexpr size_t WS_XN = WS_R1;
constexpr size_t WS_QK = WS_R1;
constexpr size_t WS_Y0 = WS_R1;
constexpr size_t WS_AB = WS_R3;
constexpr size_t WS_XN1 = WS_R3;
constexpr size_t WS_CD = WS_R3;
constexpr size_t WS_XLOC = WS_R4;
constexpr size_t WS_XST = WS_R4 + 16 * MiB;
constexpr size_t WS_G5 = WS_R4 + 32 * MiB;
constexpr size_t WS_CVT = WS_R4;
constexpr size_t WS_DVT = WS_R4 + 32 * MiB;
constexpr size_t WS_LI = WS_R5;
constexpr size_t WS_LF = WS_R5 + 512 * 1024;
constexpr size_t WS_BC = WS_R5 + 1024 * 1024;
constexpr size_t WS_DS = WS_R5 + 1536 * 1024;
constexpr size_t WS_SS0 = WS_R5 + 2 * MiB;
constexpr size_t WS_SS1 = WS_R5 + 4 * MiB;

DEVI unsigned cvt_pk_bf16(float lo, float hi) { unsigned r; asm("v_cvt_pk_bf16_f32 %0, %1, %2" : "=v"(r) : "v"(lo), "v"(hi)); return r; }
DEVI float bf2f(unsigned v16) { return __uint_as_float(v16 << 16); }
DEVI float bflo(unsigned w) { return __uint_as_float(w << 16); }
DEVI float bfhi(unsigned w) { return __uint_as_float(w & 0xffff0000u); }
DEVI bf16_t f2bf(float f) { return (bf16_t)(cvt_pk_bf16(f, 0.f) & 0xffffu); }
template <int CTRL> DEVI float dpp_f(float v) { return __int_as_float(__builtin_amdgcn_update_dpp(0, __float_as_int(v), CTRL, 0xF, 0xF, true)); }
DEVI float sum8_dpp(float v) { v += dpp_f<0xB1>(v); v += dpp_f<0x4E>(v); v += dpp_f<0x141>(v); return v; }
DEVI float wave_sum(float v) { v = sum8_dpp(v); v += dpp_f<0x140>(v)  ; v += __shfl_xor(v, 16); v += __shfl_xor(v, 32); return v; }
DEVI float fast_exp2(float x) { return __builtin_amdgcn_exp2f(x); }
DEVI float silu_f(float x) { return x * __builtin_amdgcn_rcpf(1.0f + __expf(-x)); }
DEVI float sigmoid_f(float x) { return __builtin_amdgcn_rcpf(1.0f + __expf(-x)); }
DEVI float gelu_tanh_f(float x) { const float u2 = 1.5957691216057308f * (x + 0.044715f * x * x * x); return x * __builtin_amdgcn_rcpf(1.0f + __expf(-u2)); }
DEVI float max3f(float a, float b, float c) { float r; asm("v_max3_f32 %0, %1, %2, %3" : "=v"(r) : "v"(a), "v"(b), "v"(c)); return r; }
DEVI f32x4 mfma16(bf16x8 a, bf16x8 b, f32x4 c) { return __builtin_amdgcn_mfma_f32_16x16x32_bf16(a, b, c, 0, 0, 0); }
DEVI void unpack8(const u32x4 q, float (&f)[8]) { f[0] = bflo(q.x); f[1] = bfhi(q.x); f[2] = bflo(q.y); f[3] = bfhi(q.y); f[4] = bflo(q.z); f[5] = bfhi(q.z); f[6] = bflo(q.w); f[7] = bfhi(q.w); }
DEVI u32x4 pack8(const float (&y)[8]) { u32x4 w; w.x = cvt_pk_bf16(y[0], y[1]); w.y = cvt_pk_bf16(y[2], y[3]); w.z = cvt_pk_bf16(y[4], y[5]); w.w = cvt_pk_bf16(y[6], y[7]); return w; }
namespace pg8 {
constexpr int BM = 256, BK = 64, HALF = 128, HTB = HALF * BK * 2  , STAGE_BYTES = 8 * HTB, NXCD = 8, WGM = 8;

__host__ __device__ __forceinline__ int lds_byte(int r, int c) { const int st = (r >> 4) * 2 + (c >> 5), rr = r & 15, cc = c & 31, ob = rr * 64 + cc * 2; return st * 1024 + (ob ^ (((ob >> 9) & 1) << 5)); }
__host__ __device__ __forceinline__ void stage_rc(int b, int& R, int& C) { const int st = b / 1024, sb = b % 1024, swz = sb ^ (((sb >> 9) & 1) << 5); R = (st >> 1) * 16 + swz / 64; C = (st & 1) * 32 + (swz % 64) / 2; }
__host__ __device__ __forceinline__ int perm32(int rho) { const int n = rho >> 4, i = rho & 15; return 8 * (i >> 2) + 4 * n + (i & 3); }

struct Unit { int pm, pn; };
struct Gemm { const bf16_t* A; const bf16_t* Bt; int M, N, K, lda, ldb, grp_shift; size_t grp_bbytes; int kdiag; int a_grp16; };

struct StaticOrder {
    int nM, nN, nwg, G, c;
    __host__ __device__ __forceinline__ void init(int M, int N, int G_, int c_) { nM = M / BM; nN = N / BM; nwg = nM * nN; G = G_; c = c_; }
    __host__ __device__ __forceinline__ bool next(int i, Unit& u) const {
        const long L = (long)i * G + c; if (L >= nwg) return false;
        int wgid = (int)L; { const int q = nwg / NXCD, r = nwg % NXCD, xcd = wgid % NXCD, off = wgid / NXCD; wgid = (xcd < r ? xcd * (q + 1) : r * (q + 1) + (xcd - r) * q) + off; }
        const int nig = WGM * nN, gid = wgid / nig, fm = gid * WGM, gsz = (nM - fm) < WGM ? (nM - fm) : WGM;
        u.pm = fm + ((wgid % nig) % gsz); u.pn = (wgid % nig) / gsz; return true;
    }
};

template <class Epi>
__device__ __forceinline__ void gemm_phase(LAS unsigned char* lds, const Gemm g, const StaticOrder& S, const Epi& E) {
    const int tid = threadIdx.x, wid = __builtin_amdgcn_readfirstlane(tid >> 6), lane = tid & 63, wr = wid >> 2, wc = wid & 3, fr = lane & 15, fq = lane >> 4;
    int nt = g.K / BK; asm volatile("" : "+s"(nt));
    unsigned voffA[2], voffB[2];
#pragma unroll
    for (int i = 0; i < 2; ++i) { int R, C; stage_rc(tid * 16 + i * 8192, R, C); const int Rb = (R & ~31) + perm32(R & 31);
        voffA[i] = g.a_grp16 ? (unsigned)(C >> 4) * (unsigned)(g.M * 32) + (unsigned)(R * 32 + (C & 15) * 2) : (unsigned)(R * g.lda + C) * 2u; voffB[i] = (unsigned)(Rb * g.ldb + C) * 2u; }
    const size_t kstep = (size_t)(BK * 2);
    const size_t kstepA = g.a_grp16 ? (size_t)(BK / 16) * (size_t)g.M * 32 : kstep;
    const size_t hstepA = g.a_grp16 ? (size_t)HALF * 32 : (size_t)HALF * g.lda * 2, hstepB = (size_t)HALF * g.ldb * 2;
    const size_t tstepA = 2 * hstepA, tstepB = 2 * hstepB;
    const unsigned ldsw = (unsigned)wid * 1024u;
    const int aoff = lds_byte(wr * 64 + fr, fq * 8), boff = lds_byte(wc * 32 + fr, fq * 8);
#define PG8_SA(b, h) (((b) * 2 + (h)) * HTB)
#define PG8_SB(b, h) ((4 + (b) * 2 + (h)) * HTB)
#define PG8_STAGE(bufoff, gbase, voff) do { _Pragma("unroll") for (int _i = 0; _i < 2; ++_i) \
        __builtin_amdgcn_global_load_lds((const unsigned*)((const char*)(gbase) + (voff)[_i]), (LAS unsigned*)(lds + (bufoff) + ldsw + _i * 8192), 16, 0, 0); } while (0)
#define PG8_LDA(dst, b, h) do { _Pragma("unroll") for (int m = 0; m < 4; ++m) _Pragma("unroll") for (int k = 0; k < 2; ++k) dst[m][k] = *(const LAS bf16x8*)(lds + PG8_SA(b, h) + aoff + m * 2048 + k * 1024); } while (0)
#define PG8_LDB(dst, b, h) do { _Pragma("unroll") for (int n = 0; n < 2; ++n) _Pragma("unroll") for (int k = 0; k < 2; ++k) dst[n][k] = *(const LAS bf16x8*)(lds + PG8_SB(b, h) + boff + n * 2048 + k * 1024); } while (0)
#define PG8_MMA(ai, bj, At, Bt) do { __builtin_amdgcn_s_setprio(1); _Pragma("unroll") for (int m = 0; m < 4; ++m) _Pragma("unroll") for (int n = 0; n < 2; ++n) _Pragma("unroll") for (int k = 0; k < 2; ++k) \
        acc[ai][bj][m][n] = __builtin_amdgcn_mfma_f32_16x16x32_bf16(Bt[n][k], At[m][k], acc[ai][bj][m][n], 0, 0, 0); __builtin_amdgcn_s_setprio(0); } while (0)
#define PG8_WAIT_V(n) asm volatile("s_waitcnt vmcnt(" #n ")" ::: "memory")
#define PG8_WAIT_L(n) asm volatile("s_waitcnt lgkmcnt(" #n ")" ::: "memory")
#define PG8_BAR __builtin_amdgcn_s_barrier()
#define PG8_SCHED __builtin_amdgcn_sched_barrier(0)
#define PG8_BBASE(u) ((const char*)g.Bt + (size_t)((u).pm >> g.grp_shift) * g.grp_bbytes + (size_t)(u).pn * tstepB + (size_t)(g.kdiag * ((u).pn & 1)) * 2)
#define PG8_ABASE(u) ((const char*)g.A + (size_t)(u).pm * tstepA + (size_t)(g.kdiag * ((u).pn & 1)) * 2)
    Unit cur, nxt; int ui = 0;
    __syncthreads();
    if (!S.next(0, cur)) return;
    f32x4 acc[2][2][4][2];
#pragma unroll
    for (int a = 0; a < 2; ++a)
#pragma unroll
        for (int b = 0; b < 2; ++b)
#pragma unroll
            for (int m = 0; m < 4; ++m)
#pragma unroll
                for (int n = 0; n < 2; ++n) acc[a][b][m][n] = (f32x4){0.f, 0.f, 0.f, 0.f};
    bf16x8 At[4][2], B0[2][2], B1[2][2];
    const char* cA = PG8_ABASE(cur); const char* cB = PG8_BBASE(cur);
    PG8_STAGE(PG8_SB(0, 0), cB, voffB); PG8_STAGE(PG8_SA(0, 0), cA, voffA); PG8_STAGE(PG8_SB(0, 1), cB + hstepB, voffB); PG8_STAGE(PG8_SA(0, 1), cA + hstepA, voffA);
    if (wr == 1) PG8_BAR;
    PG8_WAIT_V(4); PG8_BAR;
    PG8_STAGE(PG8_SB(1, 0), cB + kstep, voffB); PG8_STAGE(PG8_SA(1, 0), cA + kstepA, voffA); PG8_STAGE(PG8_SB(1, 1), cB + hstepB + kstep, voffB);
    PG8_WAIT_V(6); PG8_BAR;
    for (;;) {
        const bool has_next = S.next(ui + 1, nxt);
        const char* nA = has_next ? PG8_ABASE(nxt) : cA; const char* nB = has_next ? PG8_BBASE(nxt) : cB;
        for (int t = 0; t < nt; t += 2) {
            const bool last = (t == nt - 2);
            const char* a1 = cA + (size_t)(t + 1) * kstepA;
            const char* a2 = last ? nA : cA + (size_t)(t + 2) * kstepA; const char* b2 = last ? nB : cB + (size_t)(t + 2) * kstep;
            const char* a3 = a2 + kstepA; const char* b3 = b2 + kstep;
            PG8_LDB(B0, 0, 0); PG8_SCHED; PG8_LDA(At, 0, 0); PG8_STAGE(PG8_SA(1, 1), a1 + hstepA, voffA);
            PG8_WAIT_L(8); PG8_BAR; PG8_WAIT_L(0); PG8_MMA(0, 0, At, B0); PG8_BAR; PG8_SCHED;
            PG8_LDB(B1, 0, 1); PG8_STAGE(PG8_SB(0, 0), b2, voffB);
            PG8_BAR; PG8_WAIT_L(0); PG8_MMA(0, 1, At, B1); PG8_BAR;
            PG8_LDA(At, 0, 1); PG8_STAGE(PG8_SA(0, 0), a2, voffA);
            PG8_BAR; PG8_WAIT_L(0); PG8_MMA(1, 0, At, B0); PG8_BAR; PG8_SCHED;
            PG8_STAGE(PG8_SB(0, 1), b2 + hstepB, voffB);
            PG8_WAIT_V(6); PG8_BAR; PG8_MMA(1, 1, At, B1); PG8_BAR;
            PG8_LDB(B0, 1, 0); PG8_SCHED; PG8_LDA(At, 1, 0); PG8_STAGE(PG8_SA(0, 1), a2 + hstepA, voffA);
            PG8_WAIT_L(8); PG8_BAR; PG8_WAIT_L(0); PG8_MMA(0, 0, At, B0); PG8_BAR; PG8_SCHED;
            PG8_LDB(B1, 1, 1); PG8_STAGE(PG8_SB(1, 0), b3, voffB);
            PG8_BAR; PG8_WAIT_L(0); PG8_MMA(0, 1, At, B1); PG8_BAR;
            PG8_LDA(At, 1, 1); PG8_STAGE(PG8_SA(1, 0), a3, voffA);
            PG8_BAR; PG8_WAIT_L(0); PG8_MMA(1, 0, At, B0); PG8_BAR; PG8_SCHED;
            PG8_STAGE(PG8_SB(1, 1), b3 + hstepB, voffB);
            PG8_WAIT_V(6); PG8_BAR; PG8_MMA(1, 1, At, B1); PG8_BAR;
        }
        E(acc, cur, wr, wc, fr, fq);
        if (!has_next) break;
#pragma unroll
        for (int a = 0; a < 2; ++a)
#pragma unroll
            for (int b = 0; b < 2; ++b)
#pragma unroll
                for (int m = 0; m < 4; ++m)
#pragma unroll
                    for (int n = 0; n < 2; ++n) acc[a][b][m][n] = (f32x4){0.f, 0.f, 0.f, 0.f};
        cur = nxt; cA = nA; cB = nB; ++ui;
    }
    PG8_WAIT_V(0);
    if (wr == 0) PG8_BAR;
    PG8_BAR;
#undef PG8_SA
#undef PG8_SB
#undef PG8_STAGE
#undef PG8_LDA
#undef PG8_LDB
#undef PG8_MMA
#undef PG8_WAIT_V
#undef PG8_WAIT_L
#undef PG8_BAR
#undef PG8_SCHED
#undef PG8_BBASE
#undef PG8_ABASE
}
}
#define XB_TMO      128
#define XB_XCNT(j)  (256  + 64 * (j))
#define XB_XSUB(j)  (1280 + 64 * (j))
#define XB_XGEN(j)  (2304 + 64 * (j))
#define XB_TOP      3328
#define XB_TOPGEN   3392
#define XCD_BAR_WORDS 3456
#define XB_SPIN_CAP (1u << 22)
__device__ __forceinline__ unsigned xb_ld(unsigned* p)              { return __hip_atomic_load(p, __ATOMIC_RELAXED, __HIP_MEMORY_SCOPE_AGENT); }
__device__ __forceinline__ unsigned xb_add(unsigned* p, unsigned v) { return __hip_atomic_fetch_add(p, v, __ATOMIC_RELAXED, __HIP_MEMORY_SCOPE_AGENT); }
__device__ __forceinline__ unsigned xb_xcc_id() { return (unsigned)__builtin_amdgcn_s_getreg((3 << 11) | 20) & 0xFu; }
#define XB_SPIN(cond, bar) do { unsigned _sp = 0; while (cond) { __builtin_amdgcn_s_sleep(1); \
    if ((++_sp & 255u) == 0u) { if (xb_ld(&(bar)[XB_TMO])) break; if (_sp > XB_SPIN_CAP) { atomicAdd(&(bar)[XB_TMO], 1u); break; } } } } while (0)
struct XcdBarrier { unsigned* bar; unsigned x; volatile LAS unsigned* st; };
__device__ __forceinline__ XcdBarrier xcd_barrier_post(unsigned* bar, volatile LAS unsigned* st) {
    XcdBarrier b; b.bar = bar; b.x = xb_xcc_id(); b.st = st;
    if (threadIdx.x == 0) (void)xb_add(&bar[XB_XCNT(b.x)], 1u);
    return b;
}
__device__ __forceinline__ void xcd_barrier_complete(unsigned* bar, unsigned x, unsigned& nloc, unsigned& nx) {
    const unsigned G = gridDim.x * gridDim.y * gridDim.z;
    unsigned sum, cnt, mine, sp = 0u;
    for (;;) {
        sum = 0u; cnt = 0u; mine = 0u;
#pragma unroll
        for (unsigned j = 0; j < 16; ++j) { const unsigned c = xb_ld(&bar[XB_XCNT(j)]); sum += c; cnt += (c > 0u) ? 1u : 0u; mine = (j == x) ? c : mine; }
        if (sum == G) break;
        __builtin_amdgcn_s_sleep(1);
        if ((++sp & 255u) == 0u) { if (xb_ld(&bar[XB_TMO])) break; if (sp > XB_SPIN_CAP) { atomicAdd(&bar[XB_TMO], 1u); break; } }
    }
    nloc = mine > 0u ? mine : 1u; nx = cnt > 0u ? cnt : 1u;
}
__device__ __forceinline__ void xcd_barrier(const XcdBarrier& b) {
    asm volatile("s_waitcnt vmcnt(0)" ::: "memory");
    __syncthreads();
    if (threadIdx.x == 0) {
        unsigned* bar = b.bar;
        __builtin_amdgcn_s_waitcnt(0);
        unsigned nloc = b.st[0], nx = b.st[1];
        if (nloc == 0u) { xcd_barrier_complete(bar, b.x, nloc, nx); b.st[0] = nloc; b.st[1] = nx; }
        const unsigned old = xb_add(&bar[XB_XSUB(b.x)], 1u);
        const unsigned gen = old / nloc;
        if (old + 1u == (gen + 1u) * nloc) {
            __builtin_amdgcn_fence(__ATOMIC_RELEASE, "agent");
            asm volatile("s_waitcnt vmcnt(0)" ::: "memory");
            const unsigned og = xb_add(&bar[XB_TOP], 1u);
            const unsigned tg = og / nx;
            if (og + 1u == (tg + 1u) * nx) xb_add(&bar[XB_TOPGEN], 1u);
            else XB_SPIN(xb_ld(&bar[XB_TOPGEN]) == tg, bar);
            __builtin_amdgcn_fence(__ATOMIC_ACQUIRE, "agent");
            xb_add(&bar[XB_XGEN(b.x)], 1u);
            asm volatile("s_waitcnt vmcnt(0)" ::: "memory");
        } else {
            XB_SPIN(xb_ld(&bar[XB_XGEN(b.x)]) == gen, bar);
            __builtin_amdgcn_fence(__ATOMIC_ACQUIRE, "agent");
            asm volatile("s_waitcnt vmcnt(0)" ::: "memory");
        }
    }
    __syncthreads();
}

enum { EM_IN0 = 0, EM_PLAIN = 1, EM_S5A = 2, EM_S5B = 3, EM_GLU = 4, EM_OUT = 5, EM_IN1 = 6 };
template <int mode> struct EpiMulti {
    int ldc;
    bf16_t* o0; bf16_t* o1; float* f0;
    const bf16_t* i0; const bf16_t* i1; const float* c0; const float* c1;
    unsigned char* ws;
    struct Ld { u32x4 a[2], b[2]; };
    __device__ __forceinline__ void load_it(Ld& L, int it, int rowb, int colb) const {
        const int row = rowb + (it >> 2) * 128 + (it & 3) * 16;
        if constexpr (mode == EM_S5B) {
#pragma unroll
            for (int bj = 0; bj < 2; ++bj) { const size_t idx = (size_t)row * 512 + colb + bj * 128; L.a[bj] = *(const u32x4*)(i0 + idx); L.b[bj] = *(const u32x4*)(i1 + idx); }
        } else if constexpr (mode == EM_GLU) {
#pragma unroll
            for (int bj = 0; bj < 2; ++bj) { const int c = colb + bj * 128; L.a[bj] = *(const u32x4*)(i0 + (size_t)(c >> 4) * ((size_t)NT * 16) + (size_t)row * 16 + (c & 15)); L.b[bj] = *(const u32x4*)(i1 + (size_t)row * 1536 + c); }
        } else if constexpr (mode == EM_IN1) {
            const int l = row & 2047, j0 = ((colb & 63) >> 3) * 4;
            L.a[0] = *(const u32x4*)(c0 + l * 32 + j0); L.b[0] = *(const u32x4*)(c1 + l * 32 + j0);
        }
    }
    __device__ __forceinline__ void operator()(const f32x4 (&acc)[2][2][4][2], const pg8::Unit& u, int wr, int wc, int fr, int fq) const {
        const int rowb = u.pm * 256 + wr * 64 + fr;
        const int colb = u.pn * 256 + wc * 32 + 8 * fq;
        constexpr bool HAS_LD = (mode == EM_S5B || mode == EM_GLU || mode == EM_IN1);
        Ld cur, nxt;
        if constexpr (HAS_LD) load_it(cur, 0, rowb, colb);
        f32x4 dsk0, dsk1;
        if constexpr (mode == EM_S5B) { const int g = rowb >> 10, ch = colb & 15; dsk0 = *(const f32x4*)(c0 + g * 16 + ch); dsk1 = *(const f32x4*)(c0 + g * 16 + ch + 4); }
#pragma unroll
        for (int it = 0; it < 8; ++it) {
            const int ai = it >> 2, m = it & 3;
            const int row = rowb + ai * 128 + m * 16;
            if constexpr (HAS_LD) { if (it + 1 < 8) load_it(nxt, it + 1, rowb, colb); asm volatile("" ::: "memory"); }
            float ssq = 0.f;
#pragma unroll
            for (int bj = 0; bj < 2; ++bj) {
                const int c = colb + bj * 128;
                f32x4 v0 = acc[ai][bj][m][0], v1 = acc[ai][bj][m][1];
                if constexpr (mode == EM_PLAIN) {
                    u32x4 w; w.x = cvt_pk_bf16(v0[0], v0[1]); w.y = cvt_pk_bf16(v0[2], v0[3]); w.z = cvt_pk_bf16(v1[0], v1[1]); w.w = cvt_pk_bf16(v1[2], v1[3]);
                    *(u32x4*)(o0 + (size_t)row * ldc + c) = w;
                } else if constexpr (mode == EM_IN0) {
                    u32x4 w; w.x = cvt_pk_bf16(v0[0], v0[1]); w.y = cvt_pk_bf16(v0[2], v0[3]); w.z = cvt_pk_bf16(v1[0], v1[1]); w.w = cvt_pk_bf16(v1[2], v1[3]);
                    if (c < 512) {
                        const int g = c >> 4, b = row >> 11, l = row & 2047;
                        *(u32x4*)(o1 + ((size_t)((g * 16 + b) * 2048 + l)) * 16 + (c & 15)) = w;
                    } else {
                        *(u32x4*)(o0 + (size_t)row * 1536 + (c - 512)) = w;
                    }
                } else if constexpr (mode == EM_S5A) {
                    if (c < 512) {
                        u32x4 w; w.x = cvt_pk_bf16(v0[0], v0[1]); w.y = cvt_pk_bf16(v0[2], v0[3]); w.z = cvt_pk_bf16(v1[0], v1[1]); w.w = cvt_pk_bf16(v1[2], v1[3]);
                        *(u32x4*)(o0 + (size_t)row * 512 + c) = w;
                    } else if (c < 640) {
                        float* p = f0 + (size_t)row * 128 + (c - 512);
                        *(f32x4*)p = v0; *(f32x4*)(p + 4) = v1;
                    }
                } else if constexpr (mode == EM_S5B) {
                    const u32x4 yl = cur.a[bj], uu = cur.b[bj];
                    float y[8];
                    y[0] = v0[0] + bflo(yl.x) + dsk0[0] * bflo(uu.x); y[1] = v0[1] + bfhi(yl.x) + dsk0[1] * bfhi(uu.x);
                    y[2] = v0[2] + bflo(yl.y) + dsk0[2] * bflo(uu.y); y[3] = v0[3] + bfhi(yl.y) + dsk0[3] * bfhi(uu.y);
                    y[4] = v1[0] + bflo(yl.z) + dsk1[0] * bflo(uu.z); y[5] = v1[1] + bfhi(yl.z) + dsk1[1] * bfhi(uu.z);
                    y[6] = v1[2] + bflo(yl.w) + dsk1[2] * bflo(uu.w); y[7] = v1[3] + bfhi(yl.w) + dsk1[3] * bfhi(uu.w);
#pragma unroll
                    for (int j = 0; j < 8; ++j) y[j] = gelu_tanh_f(y[j]);
                    u32x4 w; w.x = cvt_pk_bf16(y[0], y[1]); w.y = cvt_pk_bf16(y[2], y[3]); w.z = cvt_pk_bf16(y[4], y[5]); w.w = cvt_pk_bf16(y[6], y[7]);
                    *(u32x4*)(o0 + (size_t)row * 512 + c) = w;
                } else if constexpr (mode == EM_GLU) {
                    const u32x4 gg = cur.a[bj], zz = cur.b[bj];
                    const f32x4 b0 = *(const f32x4*)(c0 + c), b1 = *(const f32x4*)(c0 + c + 4);
                    float y[8];
                    y[0] = bflo(gg.x) * sigmoid_f(v0[0] + b0[0]) * silu_f(bflo(zz.x)); y[1] = bfhi(gg.x) * sigmoid_f(v0[1] + b0[1]) * silu_f(bfhi(zz.x));
                    y[2] = bflo(gg.y) * sigmoid_f(v0[2] + b0[2]) * silu_f(bflo(zz.y)); y[3] = bfhi(gg.y) * sigmoid_f(v0[3] + b0[3]) * silu_f(bfhi(zz.y));
                    y[4] = bflo(gg.z) * sigmoid_f(v1[0] + b1[0]) * silu_f(bflo(zz.z)); y[5] = bfhi(gg.z) * sigmoid_f(v1[1] + b1[1]) * silu_f(bfhi(zz.z));
                    y[6] = bflo(gg.w) * sigmoid_f(v1[2] + b1[2]) * silu_f(bflo(zz.w)); y[7] = bfhi(gg.w) * sigmoid_f(v1[3] + b1[3]) * silu_f(bfhi(zz.w));
                    u32x4 w; w.x = cvt_pk_bf16(y[0], y[1]); w.y = cvt_pk_bf16(y[2], y[3]); w.z = cvt_pk_bf16(y[4], y[5]); w.w = cvt_pk_bf16(y[6], y[7]);
                    *(u32x4*)(o0 + (size_t)row * 1024 + c) = w;
                } else if constexpr (mode == EM_OUT) {
                    u32x4 w; w.x = cvt_pk_bf16(v0[0], v0[1]); w.y = cvt_pk_bf16(v0[2], v0[3]); w.z = cvt_pk_bf16(v1[0], v1[1]); w.w = cvt_pk_bf16(v1[2], v1[3]);
                    *(u32x4*)(o0 + (size_t)row * 1024 + c) = w;
                    ssq += (v0[0] * v0[0] + v0[1] * v0[1]) + (v0[2] * v0[2] + v0[3] * v0[3]) + (v1[0] * v1[0] + v1[1] * v1[1]) + (v1[2] * v1[2] + v1[3] * v1[3]);
                } else {
                    const int blk = c >> 9, cc = c & 511, b = row >> 11, l = row & 2047;
                    f32x4 r0 = v0, r1 = v1;
                    if (blk == 0 || blk == 1 || blk == 4 || blk == 5) {
                        const f32x4 cs = __builtin_bit_cast(f32x4, cur.a[0]), sn = __builtin_bit_cast(f32x4, cur.b[0]);
#pragma unroll
                        for (int e = 0; e < 4; ++e) { r0[e] = v0[e] * cs[e] - v1[e] * sn[e]; r1[e] = v1[e] * cs[e] + v0[e] * sn[e]; }
                    }
                    u32x4 w; w.x = cvt_pk_bf16(r0[0], r0[1]); w.y = cvt_pk_bf16(r0[2], r0[3]); w.z = cvt_pk_bf16(r1[0], r1[1]); w.w = cvt_pk_bf16(r1[2], r1[3]);
                    if (blk == 3 || blk >= 6) {
                        bf16_t* base = (bf16_t*)(ws + (blk == 3 ? WS_CZ : blk == 6 ? WS_DVTMP : WS_DZ));
                        *(u32x4*)(base + (size_t)row * 512 + cc) = w;
                    } else {
                        bf16_t* base = (bf16_t*)(ws + (blk == 0 ? WS_CQ : blk == 1 ? WS_CK : blk == 2 ? WS_CVTMP : blk == 4 ? WS_DQ : WS_DK));
                        *(u32x4*)(base + ((size_t)((b * 8 + (cc >> 6)) * 2048 + l)) * 64 + (cc & 63)) = w;
                    }
                }
            }
            if constexpr (mode == EM_OUT) {
                ssq += __shfl_xor(ssq, 16); ssq += __shfl_xor(ssq, 32);
                if (fq == 0) f0[(size_t)row * 16 + u.pn * 4 + wc] = ssq;
            }
            if constexpr (HAS_LD) cur = nxt;
        }
    }
};

struct Params { const float* in[31]; float* out; unsigned char* ws; int ph_lo, ph_hi; int rep_mask, pad; };
struct Ctx {
    const float* const* in; float* out; unsigned char* ws;
    LAS unsigned char* lds; int tid, lane, wid, G, bid;
};
#define WSP(T, off) ((T*)(C.ws + (off)))

DEVI void rows_pass(const Ctx& C, int mode) {
    const float* x = C.in[0];
    const float* pre = C.in[1]; const float* post = C.in[2];
    const bf16_t* Y0 = WSP(const bf16_t, WS_Y0); const bf16_t* Y1 = WSP(const bf16_t, WS_Y1);
    const float* SS0 = WSP(const float, WS_SS0); const float* SS1 = WSP(const float, WS_SS1);
    bf16_t* XN = (mode == 0) ? WSP(bf16_t, WS_XN) : WSP(bf16_t, WS_XN1);
    const int gw = C.bid * 8 + C.wid, nw = C.G * 8, lane = C.lane;
    for (int r = gw; r < NT; r += nw) {
        f32x4 v[4];
#pragma unroll
        for (int i = 0; i < 4; ++i) v[i] = *(const f32x4*)(x + (size_t)r * 1024 + i * 256 + lane * 4);
        if (mode >= 1) {
            float s0 = (lane < 16) ? SS0[(size_t)r * 16 + lane] : 0.f; s0 = wave_sum(s0);
            const float rs0 = rsqrtf(s0 * (1.0f / 1024.0f) + 1e-6f);
#pragma unroll
            for (int i = 0; i < 4; ++i) {
                const u32x2 y = *(const u32x2*)(Y0 + (size_t)r * 1024 + i * 256 + lane * 4);
                const f32x4 gp = *(const f32x4*)(post + i * 256 + lane * 4);
                v[i][0] += bflo(y.x) * rs0 * gp[0]; v[i][1] += bfhi(y.x) * rs0 * gp[1]; v[i][2] += bflo(y.y) * rs0 * gp[2]; v[i][3] += bfhi(y.y) * rs0 * gp[3];
            }
        }
        if (mode == 2) {
            float s1 = (lane < 16) ? SS1[(size_t)r * 16 + lane] : 0.f; s1 = wave_sum(s1);
            const float rs1 = rsqrtf(s1 * (1.0f / 1024.0f) + 1e-6f);
#pragma unroll
            for (int i = 0; i < 4; ++i) {
                const u32x2 y = *(const u32x2*)(Y1 + (size_t)r * 1024 + i * 256 + lane * 4);
                const f32x4 gp = *(const f32x4*)(post + 1024 + i * 256 + lane * 4);
                f32x4 o = v[i];
                o[0] += bflo(y.x) * rs1 * gp[0]; o[1] += bfhi(y.x) * rs1 * gp[1]; o[2] += bflo(y.y) * rs1 * gp[2]; o[3] += bfhi(y.y) * rs1 * gp[3];
                *(f32x4*)(C.out + (size_t)r * 1024 + i * 256 + lane * 4) = o;
            }
        } else {
            float ss = 0.f;
#pragma unroll
            for (int i = 0; i < 4; ++i) ss += (v[i][0] * v[i][0] + v[i][1] * v[i][1]) + (v[i][2] * v[i][2] + v[i][3] * v[i][3]);
            ss = wave_sum(ss);
            const float rs = rsqrtf(ss * (1.0f / 1024.0f) + 1e-6f);
            const float* gpre = pre + (mode == 0 ? 0 : 1024);
#pragma unroll
            for (int i = 0; i < 4; ++i) {
                const f32x4 gp = *(const f32x4*)(gpre + i * 256 + lane * 4);
                u32x2 w; w.x = cvt_pk_bf16(v[i][0] * rs * gp[0], v[i][1] * rs * gp[1]); w.y = cvt_pk_bf16(v[i][2] * rs * gp[2], v[i][3] * rs * gp[3]);
                *(u32x2*)(XN + (size_t)r * 1024 + i * 256 + lane * 4) = w;
            }
        }
    }
}

DEVI int rope_dim(int p) { return ((p & 7) < 4) ? (4 * (p >> 3) + (p & 7)) : (32 + 4 * (p >> 3) + ((p & 7) - 4)); }
DEVI void wt_tile(const Ctx& C, const float* W, int K, int N, bf16_t* Wt, int tile, bool rope_perm) {
    LAS float* T = (LAS float*)C.lds;
    const int ntn = N / 64, tk = tile / ntn, tn = tile % ntn, k0 = tk * 64, n0 = tn * 64, tid = C.tid;
    __syncthreads();
#pragma unroll
    for (int i = 0; i < 2; ++i) { const int e = tid + i * 512, r = e >> 4, c4 = (e & 15) * 4;
        const f32x4 v = *(const f32x4*)(W + (size_t)(k0 + r) * N + n0 + c4);
        T[r * 65 + c4 + 0] = v[0]; T[r * 65 + c4 + 1] = v[1]; T[r * 65 + c4 + 2] = v[2]; T[r * 65 + c4 + 3] = v[3]; }
    __syncthreads();
    const int nn = tid >> 3, kc = (tid & 7) * 8;
    bool perm = false;
    if (rope_perm) { const int blk = n0 >> 9; perm = (blk == 0 || blk == 1 || blk == 4 || blk == 5); }
    const int src = perm ? rope_dim(nn) : nn;
    float f[8];
#pragma unroll
    for (int j = 0; j < 8; ++j) f[j] = T[(kc + j) * 65 + src];
    u32x4 w; w.x = cvt_pk_bf16(f[0], f[1]); w.y = cvt_pk_bf16(f[2], f[3]); w.z = cvt_pk_bf16(f[4], f[5]); w.w = cvt_pk_bf16(f[6], f[7]);
    *(u32x4*)(Wt + (size_t)(n0 + nn) * K + k0 + kc) = w;
}

DEVI void s5_tables(const Ctx& C, int g, int part) {
    LAS float* APr = (LAS float*)C.lds;
    LAS float* APi = APr + 64 * 33;
    LAS float* BBr = APi + 64 * 33;
    LAS float* BBi = BBr + 1024;
    LAS float* Cr = BBi + 1024;
    LAS float* Ci = Cr + 1024;
    LAS float* KL = Ci + 1024;
    const int tid = C.tid;
    const float* lre = C.in[4]; const float* lim = C.in[5]; const float* ldt = C.in[6];
    const float* bre = C.in[7]; const float* bim = C.in[8]; const float* cre = C.in[9]; const float* cim = C.in[10];
    __syncthreads();
    if (tid < 64) {
        const int p = tid;
        const float lr = lre[g * 64 + p], li = lim[g * 64 + p], dt = expf(ldt[g]);
        const float mag = expf(lr * dt);
        const float ar = mag * cosf(li * dt), ai = mag * sinf(li * dt);
        const float den = lr * lr + li * li;
        const float fr = ((ar - 1.0f) * lr + ai * li) / den, fi = (ai * lr - (ar - 1.0f) * li) / den;
        double pr = 1.0, pi = 0.0;
        for (int k = 0; k <= 32; ++k) { APr[p * 33 + k] = (float)pr; APi[p * 33 + k] = (float)pi; const double nr = pr * (double)ar - pi * (double)ai, ni = pr * (double)ai + pi * (double)ar; pr = nr; pi = ni; }
        for (int c = 0; c < 16; ++c) { const float br = bre[(g * 64 + p) * 16 + c], bi = bim[(g * 64 + p) * 16 + c]; BBr[p * 16 + c] = fr * br - fi * bi; BBi[p * 16 + c] = fr * bi + fi * br; }
    }
    for (int e = tid; e < 1024; e += 512) { Cr[e] = cre[g * 1024 + e]; Ci[e] = cim[g * 1024 + e]; }
    __syncthreads();
    bf16_t* A5 = WSP(bf16_t, WS_BT5A) + (size_t)g * 768 * 512;
    bf16_t* B5 = WSP(bf16_t, WS_BT5B) + (size_t)g * 512 * 256;
    float* KLg = WSP(float, WS_KL) + (size_t)g * 8192;
    for (int e = tid; e < 1024; e += 512) {
        const int k = part * 4 + (e >> 8), c = (e >> 4) & 15, cp = e & 15; float s = 0.f;
        for (int p = 0; p < 64; ++p) { const float a_r = APr[p * 33 + k], a_i = APi[p * 33 + k], c_r = Cr[c * 64 + p], c_i = Ci[c * 64 + p];
            const float car = c_r * a_r - c_i * a_i, cai = c_r * a_i + c_i * a_r; s += car * BBr[p * 16 + cp] - cai * BBi[p * 16 + cp]; }
        KLg[k * 256 + (e & 255)] = s;
    }
    for (int e = tid; e < 32 * 64; e += 512) {
        const int R = 512 + part * 32 + (e >> 6), col0 = (e & 63) * 8; float f[8];
        if (R < 640) { const int pp = R - 512, p = pp >> 1, ri = pp & 1, s = col0 >> 4, cp0 = col0 & 15;
            const float a_r = APr[p * 33 + (31 - s)], a_i = APi[p * 33 + (31 - s)];
#pragma unroll
            for (int j = 0; j < 8; ++j) { const float b_r = BBr[p * 16 + cp0 + j], b_i = BBi[p * 16 + cp0 + j]; f[j] = ri ? (a_r * b_i + a_i * b_r) : (a_r * b_r - a_i * b_i); }
        } else {
#pragma unroll
            for (int j = 0; j < 8; ++j) f[j] = 0.f;
        }
        *(u32x4*)(A5 + (size_t)R * 512 + col0) = pack8(f);
    }
    for (int e = tid; e < 64 * 32; e += 512) {
        const int R = part * 64 + (e >> 5), col0 = (e & 31) * 8, t = R >> 4, c = R & 15; float f[8];
        if (col0 < 128) {
#pragma unroll
            for (int j = 0; j < 4; ++j) { const int p = (col0 >> 1) + j; const float a_r = APr[p * 33 + t + 1], a_i = APi[p * 33 + t + 1], c_r = Cr[c * 64 + p], c_i = Ci[c * 64 + p];
                f[2 * j] = c_r * a_r - c_i * a_i; f[2 * j + 1] = -(c_r * a_i + c_i * a_r); }
        } else {
#pragma unroll
            for (int j = 0; j < 8; ++j) f[j] = 0.f;
        }
        *(u32x4*)(B5 + (size_t)R * 256 + col0) = pack8(f);
    }
    if (part == 0 && tid < 64) { f32x2 a; a.x = APr[tid * 33 + 32]; a.y = APi[tid * 33 + 32]; WSP(f32x2, WS_A32)[g * 64 + tid] = a; }
}


DEVI void s5_fill_t0(const Ctx& C) {
    LAS float* KL = (LAS float*)C.lds;
    for (int job = C.bid; job < 256; job += C.G) {
        const int g = job >> 3, part = job & 7;
        __syncthreads();
        for (int e = C.tid; e < 8192; e += 512) KL[e] = WSP(const float, WS_KL)[(size_t)g * 8192 + e];
        __syncthreads();
        bf16_t* A5 = WSP(bf16_t, WS_BT5A) + (size_t)g * 768 * 512;
        for (int e = C.tid; e < 64 * 64; e += 512) {
            const int R = part * 64 + (e >> 6), col0 = (e & 63) * 8, t = R >> 4, c = R & 15, s = col0 >> 4, cp0 = col0 & 15; float f[8];
#pragma unroll
            for (int j = 0; j < 8; ++j) f[j] = (s <= t) ? KL[(t - s) * 256 + c * 16 + cp0 + j] : 0.f;
            *(u32x4*)(A5 + (size_t)R * 512 + col0) = pack8(f);
        }
    }
}


DEVI void phase_prologue(const Ctx& C) {
    const int tid = C.tid, G = C.G, bid = C.bid;
    {
        const int t0 = 16 * 32, t1 = t0 + 16 * 16, t2 = t1 + 16 * 64, t3 = t2 + 16 * 16, t4 = t3 + 8 * 8;
        for (int j = bid; j < t4; j += G) {
            if (j < t0) wt_tile(C, C.in[3], 1024, 2048, WSP(bf16_t, WS_WIN0), j, false);
            else if (j < t1) wt_tile(C, C.in[23], 1024, 1024, WSP(bf16_t, WS_WOUT0), j - t0, false);
            else if (j < t2) wt_tile(C, C.in[24], 1024, 4096, WSP(bf16_t, WS_WIN1), j - t1, true);
            else if (j < t3) wt_tile(C, C.in[30], 1024, 1024, WSP(bf16_t, WS_WOUT1), j - t2, false);
            else wt_tile(C, C.in[12], 512, 512, WSP(bf16_t, WS_GLU), j - t3, false);
        }
    }
    for (int j = bid; j < 256; j += G) s5_tables(C, j >> 3, j & 7);
    const int gt = bid * 512 + tid, ngt = G * 512;
    {
        const float* wq = C.in[16]; const float* wk = C.in[17]; const float* wv = C.in[18];
        bf16_t* WQK = WSP(bf16_t, WS_WQK); bf16_t* WV = WSP(bf16_t, WS_WV);
        for (int e = gt; e < 1536 * 512; e += ngt) {
            const int n = e >> 9, k = e & 511; const int nn = n & 511, h = nn >> 7, ee = nn & 127; float v = 0.f;
            if ((k >> 7) == h) { const int d = k & 127; const size_t wi = ((size_t)h * 128 + d) * 128 + ee;
                v = (n < 512) ? wq[wi] : (n < 1024) ? wk[wi] * 0.08838834764831845f : wv[wi]; }
            if (n < 1024) WQK[(size_t)n * 512 + k] = f2bf(v); else WV[(size_t)(n - 1024) * 512 + k] = f2bf(v);
        }
        const float* gw = C.in[19]; float* GF = WSP(float, WS_GF);
        for (int e = bid * 8 + C.wid; e < 1024 * 8; e += G * 8) {
            const int rr = e >> 3, j = e & 7, ch = rr & 511, h = ch >> 7, d = ch & 127; float s = 0.f;
#pragma unroll
            for (int q2 = 0; q2 < 2; ++q2) { const int ee = C.lane + 64 * q2; const size_t wi = ((size_t)h * 128 + d) * 128 + ee;
                if (rr < 512) s += wq[wi] * gw[(size_t)(h * 128 + ee) * 8 + j] + wk[wi] * gw[(size_t)(512 + h * 128 + ee) * 8 + j];
                else s += wv[wi] * gw[(size_t)(1024 + h * 128 + ee) * 8 + j]; }
            s = wave_sum(s);
            if (C.lane == 0) GF[e] = s;
        }
    }
    {
        float* RC = WSP(float, WS_ROPE_C); float* RS = WSP(float, WS_ROPE_S);
        for (int e = gt; e < 2048 * 32; e += ngt) { const int pos = e >> 5, j = e & 31; const float inv = powf(10000.0f, -(float)(2 * j) / 64.0f); const float ang = (float)pos * inv; RC[e] = cosf(ang); RS[e] = sinf(ang); }
    }
    if (bid == 0 && tid < 64) {
        const float s1 = wave_sum(C.in[25][tid] * C.in[26][tid]), s2 = wave_sum(C.in[27][tid] * C.in[28][tid]);
        if (tid == 0) WSP(float, WS_LAM)[0] = expf(s1) - expf(s2) + (0.8f - 0.6f * expf(-0.3f));
    }
    rows_pass(C, 0);
}

DEVI void phase_conv_gates(const Ctx& C) {
    const bf16_t* PZ = WSP(const bf16_t, WS_PZ); bf16_t* XC = WSP(bf16_t, WS_XC);
    float* LI = WSP(float, WS_LI); float* LF = WSP(float, WS_LF);
    const float* cw = C.in[14]; const float* cb = C.in[15]; const float* gb = C.in[20];
    LAS float* GFs = (LAS float*)C.lds;
    __syncthreads();
    for (int e = C.tid; e < 8192; e += 512) {
        const int rr = e >> 3, j = e & 7, ch = rr & 511, part = (rr >> 9) * 2 + (j >> 2);
        GFs[((part * 8 + (ch & 7)) * 64 + (ch >> 3)) * 4 + (j & 3)] = WSP(const float, WS_GF)[e]; }
    __syncthreads();
    const int lane = C.lane, ch0 = lane * 8;
    float w[4][8], bb[8];
#pragma unroll
    for (int j = 0; j < 4; ++j)
#pragma unroll
        for (int i = 0; i < 8; ++i) w[j][i] = cw[j * 512 + ch0 + i];
#pragma unroll
    for (int i = 0; i < 8; ++i) bb[i] = cb[ch0 + i];
    const int gw = C.bid * 8 + C.wid, nw = C.G * 8;
    for (int chunk = gw; chunk < NT / 16; chunk += nw) {
        const int r0 = chunk * 16, l0 = r0 & 2047;
        float xs[4][8];
#pragma unroll
        for (int j = 0; j < 3; ++j) {
            const int dl = 3 - j;
            if (l0 - dl >= 0) { const u32x4 q = *(const u32x4*)(PZ + (size_t)(r0 - dl) * 1536 + 512 + ch0); unpack8(q, xs[j]); }
            else {
#pragma unroll
                for (int i = 0; i < 8; ++i) xs[j][i] = 0.f; }
        }
        u32x4 nxt = *(const u32x4*)(PZ + (size_t)r0 * 1536 + 512 + ch0);
        for (int tk = 0; tk < 16; ++tk) {
            const int r = r0 + tk, l = l0 + tk;
            unpack8(nxt, xs[3]);
            if (tk + 1 < 16) nxt = *(const u32x4*)(PZ + (size_t)(r + 1) * 1536 + 512 + ch0);
            float xc[8];
#pragma unroll
            for (int i = 0; i < 8; ++i) { const float a = bb[i] + xs[0][i] * w[0][i] + xs[1][i] * w[1][i] + xs[2][i] * w[2][i] + xs[3][i] * w[3][i]; xc[i] = silu_f(a); }
            *(u32x4*)(XC + (size_t)r * 512 + ch0) = pack8(xc);
            float gt8[8];
#pragma unroll
            for (int j = 0; j < 8; ++j) gt8[j] = 0.f;
#pragma unroll
            for (int i = 0; i < 8; ++i) {
                const f32x4 a0 = *(const LAS f32x4*)(GFs + ((0 * 8 + i) * 64 + lane) * 4), a1 = *(const LAS f32x4*)(GFs + ((1 * 8 + i) * 64 + lane) * 4);
                const f32x4 b0 = *(const LAS f32x4*)(GFs + ((2 * 8 + i) * 64 + lane) * 4), b1 = *(const LAS f32x4*)(GFs + ((3 * 8 + i) * 64 + lane) * 4);
                const float xcv = xc[i], xmv = xs[3][i];
                gt8[0] += xcv * a0[0] + xmv * b0[0]; gt8[1] += xcv * a0[1] + xmv * b0[1]; gt8[2] += xcv * a0[2] + xmv * b0[2]; gt8[3] += xcv * a0[3] + xmv * b0[3];
                gt8[4] += xcv * a1[0] + xmv * b1[0]; gt8[5] += xcv * a1[1] + xmv * b1[1]; gt8[6] += xcv * a1[2] + xmv * b1[2]; gt8[7] += xcv * a1[3] + xmv * b1[3];
            }
            float gsel;
            { const bool h32 = lane >= 32, h16 = (lane >> 4) & 1, h8 = (lane >> 3) & 1;
              float a4[4], b2[2];
#pragma unroll
              for (int k = 0; k < 4; ++k) { const float keep = h32 ? gt8[4 + k] : gt8[k], send = h32 ? gt8[k] : gt8[4 + k]; a4[k] = keep + __shfl_xor(send, 32); }
#pragma unroll
              for (int k = 0; k < 2; ++k) { const float keep = h16 ? a4[2 + k] : a4[k], send = h16 ? a4[k] : a4[2 + k]; b2[k] = keep + __shfl_xor(send, 16); }
              const float keep = h8 ? b2[1] : b2[0], send = h8 ? b2[0] : b2[1];
              gsel = sum8_dpp(keep + dpp_f<0x128>(send)); }
            if ((lane & 7) == 0) {
                const int gj = lane >> 3;
                gsel += gb[gj];
                const int b = r >> 11;
                if (gj < 4) LI[(size_t)(b * 4 + gj) * 2048 + l] = gsel;
                else { const float ax = fabsf(gsel); const float ls = fminf(gsel, 0.f) - log1pf(expf(-ax)); LF[(size_t)(b * 4 + gj - 4) * 2048 + l] = ls; }
            }
#pragma unroll
            for (int i = 0; i < 8; ++i) { xs[0][i] = xs[1][i]; xs[1][i] = xs[2][i]; xs[2][i] = xs[3][i]; }
        }
    }
}

DEVI void phase_cumsum(const Ctx& C) {
    const int gw = C.bid * 8 + C.wid, lane = C.lane;
    if (gw < 64) {
        const float* LF = WSP(const float, WS_LF) + (size_t)gw * 2048; const float* LI = WSP(const float, WS_LI) + (size_t)gw * 2048;
        float* BC = WSP(float, WS_BC) + (size_t)gw * 2048; float* DS = WSP(float, WS_DS) + (size_t)gw * 2048;
        float tot = 0.f;
        for (int j = 0; j < 32; ++j) tot += LF[lane * 32 + j];
        float inc = tot;
#pragma unroll
        for (int d = 1; d < 64; d <<= 1) { const float o = __shfl_up(inc, d); if (lane >= d) inc += o; }
        float run = inc - tot;
        for (int j = 0; j < 32; ++j) { run += LF[lane * 32 + j]; BC[lane * 32 + j] = run; DS[lane * 32 + j] = LI[lane * 32 + j] - run; }
    }
}

DEVI void s5_scan_panel(const Ctx& C, int pm) {
    const float* XLOC = WSP(const float, WS_XLOC); bf16_t* XST = WSP(bf16_t, WS_XST); const f32x2* A32 = WSP(const f32x2, WS_A32);
    if (C.tid < 256) {
        const int p = C.tid & 63, gb = pm * 4 + (C.tid >> 6), g = gb >> 4;
        const f32x2 a = A32[g * 64 + p]; float xr = 0.f, xi = 0.f;
        for (int ib = 0; ib < 8; ++ib) {
            f32x2 lc[8];
#pragma unroll
            for (int k = 0; k < 8; ++k) lc[k] = *(const f32x2*)(XLOC + ((size_t)gb * 64 + ib * 8 + k) * 128 + 2 * p);
#pragma unroll
            for (int k = 0; k < 8; ++k) {
                const size_t n = (size_t)gb * 64 + ib * 8 + k;
                *(unsigned*)(XST + n * 256 + 2 * p) = cvt_pk_bf16(xr, xi);
                *(unsigned*)(XST + n * 256 + 128 + 2 * p) = 0u;
                const float nr = a.x * xr - a.y * xi + lc[k].x, ni = a.x * xi + a.y * xr + lc[k].y; xr = nr; xi = ni;
            }
        }
    }
    asm volatile("s_waitcnt vmcnt(0)" ::: "memory");
}
constexpr float NEG_INF = -__builtin_inff();
typedef float f32x16 __attribute__((ext_vector_type(16)));
typedef short s16x4 __attribute__((ext_vector_type(4)));
DEVI f32x16 mfma32(bf16x8 a, bf16x8 b, f32x16 c) { return __builtin_amdgcn_mfma_f32_32x32x16_bf16(a, b, c, 0, 0, 0); }
DEVI s16x4 tr_read(const LAS unsigned char* p) { return __builtin_amdgcn_ds_read_tr16_b64_v4i16((LAS s16x4*)p); }

template <int DQK, int DV, int MODE, int NG, int NS = 1>
DEVI void flash_core(const Ctx& C, const bf16_t* Qg0, const bf16_t* Kg0, const bf16_t* Vg0, const bf16_t* Qg1, const bf16_t* Kg1, const bf16_t* Vg1,
                     int ldq, int ldk, int ldv, int qb, int t_lo, int t_hi, int W, float sc,
                     const float* BCs, const float* DSs, f32x16 (&o)[DV / 32], float& lsum, float& m,
                     const bf16_t* Sinit = nullptr, const float* Ninit = nullptr, float bend_prev = 0.f) {
    constexpr int NKS = DQK / 16, NDT = DV / 32, KROW = (DQK + 8) * 2, KBUF = 64 * NS * KROW, VROW = DV * 2 + 64, VBUF = 64 * NS * VROW, NKC = DQK / 8, NVC = DV / 8;
    constexpr int TG = 512 / NG, KLD = (64 * NS * NKC) / TG, VLD = (64 * NS * NVC) / TG, GSZ = 2 * KBUF + 2 * VBUF + 512;
    static_assert(MODE == 0 || NS == 1, "decay mode stages 64 keys");
    const int tid = C.tid, lane = C.lane, w = C.wid, ql = lane & 31, h = lane >> 5;
    const int grp = (NG == 2) ? (w >> 2) : 0, wg = (NG == 2) ? (w & 3) : w, tg = (NG == 2) ? (tid & 255) : tid;
    const bf16_t* Qg = (NG == 2 && grp) ? Qg1 : Qg0; const bf16_t* Kg = (NG == 2 && grp) ? Kg1 : Kg0; const bf16_t* Vg = (NG == 2 && grp) ? Vg1 : Vg0;
    LAS unsigned char* lds = C.lds + grp * GSZ;
    const int q0w = qb + 32 * wg, q = q0w + ql;
    bf16x8 qf[NKS];
#pragma unroll
    for (int ks = 0; ks < NKS; ++ks) qf[ks] = *(const bf16x8*)(Qg + (size_t)q * ldq + 16 * ks + 8 * h);
#pragma unroll
    for (int d = 0; d < NDT; ++d)
#pragma unroll
        for (int r = 0; r < 16; ++r) o[d][r] = 0.f;
    m = NEG_INF; lsum = 0.f;
    const float bcq = MODE ? BCs[q] : 0.f;
    u32x4 kreg[KLD], vreg[VLD]; float cfreg = 0.f;
#define FL_LOAD(t) do { \
        _Pragma("unroll") for (int i_ = 0; i_ < KLD; ++i_) { const int idx_ = tg + TG * i_, key_ = idx_ / NKC, ch_ = idx_ % NKC; kreg[i_] = *(const u32x4*)(Kg + (size_t)(64 * NS * (t) + key_) * ldk + ch_ * 8); } \
        _Pragma("unroll") for (int i_ = 0; i_ < VLD; ++i_) { const int idx_ = tg + TG * i_, key_ = idx_ / NVC, ch_ = idx_ % NVC; vreg[i_] = *(const u32x4*)(Vg + (size_t)(64 * NS * (t) + key_) * ldv + ch_ * 8); } \
        if (MODE && tid < 64) cfreg = fast_exp2((BCs[64 * (t)] + DSs[64 * (t) + tid]) * LOG2E); } while (0)
#define FL_STORE(b) do { \
        _Pragma("unroll") for (int i_ = 0; i_ < KLD; ++i_) { const int idx_ = tg + TG * i_, key_ = idx_ / NKC, ch_ = idx_ % NKC; *(LAS u32x4*)(lds + (b) * KBUF + key_ * KROW + ch_ * 16) = kreg[i_]; } \
        _Pragma("unroll") for (int i_ = 0; i_ < VLD; ++i_) { const int idx_ = tg + TG * i_, key_ = idx_ / NVC, ch_ = idx_ % NVC; *(LAS u32x4*)(lds + 2 * KBUF + (b) * VBUF + key_ * VROW + ch_ * 16) = vreg[i_]; } \
        if (MODE && tid < 64) *(LAS float*)(lds + 2 * KBUF + 2 * VBUF + (b) * 256 + tid * 4) = cfreg; } while (0)
    __syncthreads();
    if (MODE == 1 && DQK == 128 && DV == 128 && Sinit != nullptr) {
#pragma unroll
        for (int i_ = 0; i_ < 4; ++i_) { const int idx_ = tid + 512 * i_, row_ = idx_ >> 4, ch_ = idx_ & 15;
            *(LAS u32x4*)(lds + row_ * KROW + ch_ * 16) = *(const u32x4*)(Sinit + (size_t)row_ * 128 + ch_ * 8); }
        if (tid < 128) *(LAS float*)(lds + 2 * KBUF + 2 * VBUF + tid * 4) = Ninit[tid];
        __syncthreads();
        const float rowf0 = fast_exp2((bcq - bend_prev) * LOG2E);
#pragma unroll
        for (int d = 0; d < NDT; ++d) {
            const LAS unsigned char* sb = lds + (32 * d + ql) * KROW + 16 * h;
#pragma unroll
            for (int ks = 0; ks < NKS; ++ks) o[d] = mfma32(*(const LAS bf16x8*)(sb + ks * 32), qf[ks], o[d]);
        }
        float dn_ = 0.f;
        const LAS float* nl = (const LAS float*)(lds + 2 * KBUF + 2 * VBUF);
#pragma unroll
        for (int ks = 0; ks < NKS; ++ks) {
            const f32x4 n0 = *(const LAS f32x4*)(nl + 16 * ks + 8 * h), n1 = *(const LAS f32x4*)(nl + 16 * ks + 8 * h + 4);
            const u32x4 qw = __builtin_bit_cast(u32x4, qf[ks]);
            dn_ += bflo(qw.x) * n0[0] + bfhi(qw.x) * n0[1] + bflo(qw.y) * n0[2] + bfhi(qw.y) * n0[3] + bflo(qw.z) * n1[0] + bfhi(qw.z) * n1[1] + bflo(qw.w) * n1[2] + bfhi(qw.w) * n1[3];
        }
        lsum = dn_ * rowf0;
#pragma unroll
        for (int d = 0; d < NDT; ++d) o[d] *= rowf0;
        __syncthreads();
    }
    FL_LOAD(t_lo); FL_STORE(0);
    __syncthreads();
    const int li = lane & 15, qq = li >> 2, pp = li & 3, g2 = (lane >> 4) & 1;
    for (int t = t_lo; t < t_hi; ++t) {
        const int buf = (t - t_lo) & 1;
        if (t + 1 < t_hi) FL_LOAD(t + 1);
#pragma unroll
        for (int sub = 0; sub < NS; ++sub) {
        const int k0 = 64 * (NS * t + sub);
        if (k0 <= q0w + 31 && k0 + 63 >= q0w - W) {
            f32x16 st[2];
#pragma unroll
            for (int kt = 0; kt < 2; ++kt) {
#pragma unroll
                for (int r = 0; r < 16; ++r) st[kt][r] = 0.f;
                const LAS unsigned char* kb = lds + buf * KBUF + (64 * sub + 32 * kt + ql) * KROW + 16 * h;
#pragma unroll
                for (int ks = 0; ks < NKS; ++ks) st[kt] = mfma32(*(const LAS bf16x8*)(kb + ks * 32), qf[ks], st[kt]);
            }
            const bool diag = (k0 + 63 > q0w) || (k0 < q0w + 31 - W);
            if (diag) {
#pragma unroll
                for (int kt = 0; kt < 2; ++kt)
#pragma unroll
                    for (int r = 0; r < 16; ++r) { const int key = k0 + 32 * kt + (r & 3) + 8 * (r >> 2) + 4 * h; const bool ok = (key <= q) && (q - key <= W);
                        st[kt][r] = ok ? st[kt][r] : (MODE == 0 ? NEG_INF : 0.f); }
            }
            float nmref = 0.f, rowf = 1.f;
            if (MODE == 0) {
                float rmax0 = max3f(st[0][0], st[1][0], st[0][1]), rmax1 = max3f(st[1][1], st[0][2], st[1][2]);
#pragma unroll
                for (int r = 3; r < 15; r += 2) { rmax0 = max3f(rmax0, st[0][r], st[1][r]); rmax1 = max3f(rmax1, st[0][r + 1], st[1][r + 1]); }
                float rmax = max3f(rmax0, rmax1, st[0][15]); rmax = fmaxf(rmax, st[1][15]); rmax = fmaxf(rmax, __shfl_xor(rmax, 32));
                const float smax = rmax * sc;
                if (!__all(smax <= m + 8.0f || smax == NEG_INF)) {
                    const float mn = fmaxf(m, smax), alpha = (mn == NEG_INF) ? 1.0f : fast_exp2(m - mn);
#pragma unroll
                    for (int d = 0; d < NDT; ++d) o[d] *= alpha;
                    lsum *= alpha; m = mn;
                }
                nmref = (m == NEG_INF) ? 0.f : -m;
            } else {
                rowf = fast_exp2((bcq - BCs[k0]) * LOG2E);
            }
            const LAS unsigned char* vl = lds + 2 * KBUF + buf * VBUF + (64 * sub + 4 * h + qq) * VROW + (16 * g2 + 4 * pp) * 2;
            const LAS unsigned char* cfb = lds + 2 * KBUF + 2 * VBUF + buf * 256;
#pragma unroll
            for (int u = 0; u < 4; ++u) {
                const int kt = u >> 1, r0 = 8 * (u & 1);
                float pv_[8];
                if (MODE == 0) {
#pragma unroll
                    for (int e_ = 0; e_ < 8; ++e_) { pv_[e_] = fast_exp2(__builtin_fmaf(st[kt][r0 + e_], sc, nmref)); }
                } else {
                    const f32x4 c4a = *(const LAS f32x4*)(cfb + (32 * kt + 8 * (r0 >> 2) + 4 * h) * 4), c4b = *(const LAS f32x4*)(cfb + (32 * kt + 8 * ((r0 >> 2) + 1) + 4 * h) * 4);
#pragma unroll
                    for (int e_ = 0; e_ < 4; ++e_) { pv_[e_] = st[kt][r0 + e_] * (rowf * c4a[e_]); pv_[4 + e_] = st[kt][r0 + 4 + e_] * (rowf * c4b[e_]); }
                }
                lsum += ((pv_[0] + pv_[1]) + (pv_[2] + pv_[3])) + ((pv_[4] + pv_[5]) + (pv_[6] + pv_[7]));
                u32x4 wv; wv.x = cvt_pk_bf16(pv_[0], pv_[1]); wv.y = cvt_pk_bf16(pv_[2], pv_[3]); wv.z = cvt_pk_bf16(pv_[4], pv_[5]); wv.w = cvt_pk_bf16(pv_[6], pv_[7]);
                const bf16x8 pfu = __builtin_bit_cast(bf16x8, wv);
                __builtin_amdgcn_s_setprio(1);
#pragma unroll
                for (int d = 0; d < NDT; ++d) {
                    const s16x4 lo = tr_read(vl + u * 16 * VROW + d * 64), hi = tr_read(vl + u * 16 * VROW + 8 * VROW + d * 64);
                    bf16x8 vf; vf[0] = lo[0]; vf[1] = lo[1]; vf[2] = lo[2]; vf[3] = lo[3]; vf[4] = hi[0]; vf[5] = hi[1]; vf[6] = hi[2]; vf[7] = hi[3];
                    o[d] = mfma32(vf, pfu, o[d]);
                }
                __builtin_amdgcn_s_setprio(0);
            }
        }
        }
        if (t + 1 < t_hi) FL_STORE(buf ^ 1);
        __syncthreads();
    }
#undef FL_LOAD
#undef FL_STORE
}

template <int DV> struct WTile { static constexpr int RS = DV * 2 + 16, BYTES = 32 * RS; };
template <int DV>
DEVI void wt_write(LAS unsigned char* wt, const f32x16 (&o)[DV / 32], float a, float bsub, int ql, int h2) {
#pragma unroll
    for (int d = 0; d < DV / 32; ++d)
#pragma unroll
        for (int g = 0; g < 4; ++g) {
            u32x2 wv; wv.x = cvt_pk_bf16((o[d][4 * g] - bsub) * a, (o[d][4 * g + 1] - bsub) * a); wv.y = cvt_pk_bf16((o[d][4 * g + 2] - bsub) * a, (o[d][4 * g + 3] - bsub) * a);
            *(LAS u32x2*)(wt + ql * WTile<DV>::RS + (32 * d + 8 * g + 4 * h2) * 2) = wv;
        }
    asm volatile("" ::: "memory");
}


DEVI void phase_mlstm_state(const Ctx& C, int nblk, int blk) {
    const bf16_t* QK = WSP(const bf16_t, WS_QK); const bf16_t* V = WSP(const bf16_t, WS_VTMP);
    const float* BC = WSP(const float, WS_BC); const float* DS = WSP(const float, WS_DS);
    bf16_t* SST = WSP(bf16_t, WS_SST); float* NST = WSP(float, WS_NST);
    constexpr int KR = 320, VR = 192, KB = 128 * KR, VB = 128 * VR, BUFB = KB + VB, WOFF = 2 * BUFB + 256;
    const int tid = C.tid, lane = C.lane, w = C.wid, ql = lane & 31, h = lane >> 5;
    const int li = lane & 15, qq = li >> 2, pp = li & 3, g2 = (lane >> 4) & 1;
    const int dkt = w >> 1, dvt = w & 1;
    for (int task = blk; task < 128; task += nblk) {
        const int seq = task >> 1, half = task & 1, b = seq >> 2, hh = seq & 3;
        const bf16_t* Kg = QK + (size_t)b * 2048 * 1024 + 512 + hh * 128;
        const bf16_t* Vg = V + (size_t)b * 2048 * 512 + hh * 128 + 64 * half;
        const float* BCs = BC + (size_t)seq * 2048; const float* DSs = DS + (size_t)seq * 2048;
        f32x16 acc, nacc;
#pragma unroll
        for (int r = 0; r < 16; ++r) { acc[r] = 0.f; nacc[r] = 0.f; }
        u32x4 kregA[4], vregA[2], kregB[4], vregB[2]; float wregA[2], wregB[2];
#define ST_LOAD(t, KR_, VR_, WR_) do { const float bend_ = BCs[((t) >> 1) * 256 + 255]; \
            _Pragma("unroll") for (int i_ = 0; i_ < 4; ++i_) { const int idx_ = tid + 512 * i_, key_ = idx_ >> 4, ch_ = idx_ & 15; KR_[i_] = *(const u32x4*)(Kg + (size_t)(128 * (t) + key_) * 1024 + ch_ * 8); } \
            _Pragma("unroll") for (int i_ = 0; i_ < 2; ++i_) { const int idx_ = tid + 512 * i_, key_ = idx_ >> 3, ch_ = idx_ & 7; VR_[i_] = *(const u32x4*)(Vg + (size_t)(128 * (t) + key_) * 512 + ch_ * 8); \
                WR_[i_] = fast_exp2((bend_ + DSs[128 * (t) + key_]) * LOG2E); } } while (0)
#define ST_STORE(bf, KR_, VR_, WR_) do { LAS unsigned char* sb_ = C.lds + (bf) * BUFB; \
            _Pragma("unroll") for (int i_ = 0; i_ < 4; ++i_) { const int idx_ = tid + 512 * i_, key_ = idx_ >> 4, ch_ = idx_ & 15; *(LAS u32x4*)(sb_ + key_ * KR + ch_ * 16) = KR_[i_]; } \
            _Pragma("unroll") for (int i_ = 0; i_ < 2; ++i_) { const int idx_ = tid + 512 * i_, key_ = idx_ >> 3, ch_ = idx_ & 7; float f_[8]; unpack8(VR_[i_], f_); \
                _Pragma("unroll") for (int e_ = 0; e_ < 8; ++e_) f_[e_] *= WR_[i_]; \
                *(LAS u32x4*)(sb_ + KB + key_ * VR + ch_ * 16) = pack8(f_); if (ch_ == 0) *(LAS float*)(C.lds + WOFF + (bf) * 512 + key_ * 4) = WR_[i_]; } } while (0)
#define ST_ITER(t, CK_, CV_, CW_, NK_, NV_, NW_) do { \
            const int buf = (t) & 1; \
            if ((t) + 2 < 14) ST_LOAD((t) + 2, CK_, CV_, CW_); \
            if (((t) & 1) == 0 && (t) > 0) { const float dj = fast_exp2((BCs[((t) >> 1) * 256 + 255] - BCs[((t) >> 1) * 256 - 1]) * LOG2E); acc *= dj; nacc *= dj; } \
            const LAS unsigned char* sb = C.lds + buf * BUFB; \
            const LAS unsigned char* kl = sb + (4 * h + qq) * KR + (16 * g2 + 4 * pp) * 2 + dkt * 64; \
            const LAS unsigned char* vl = sb + KB + (4 * h + qq) * VR + (16 * g2 + 4 * pp) * 2 + dvt * 64; \
            const LAS float* wl = (const LAS float*)(C.lds + WOFF + buf * 512); \
            _Pragma("unroll") for (int u = 0; u < 8; ++u) { \
                const s16x4 alo = tr_read(kl + u * 16 * KR), ahi = tr_read(kl + u * 16 * KR + 8 * KR); \
                const s16x4 blo = tr_read(vl + u * 16 * VR), bhi = tr_read(vl + u * 16 * VR + 8 * VR); \
                bf16x8 af, bfr; af[0] = alo[0]; af[1] = alo[1]; af[2] = alo[2]; af[3] = alo[3]; af[4] = ahi[0]; af[5] = ahi[1]; af[6] = ahi[2]; af[7] = ahi[3]; \
                bfr[0] = blo[0]; bfr[1] = blo[1]; bfr[2] = blo[2]; bfr[3] = blo[3]; bfr[4] = bhi[0]; bfr[5] = bhi[1]; bfr[6] = bhi[2]; bfr[7] = bhi[3]; \
                acc = mfma32(af, bfr, acc); \
                if (dvt == 0 && half == 0) { \
                    const f32x4 w0 = *(const LAS f32x4*)(wl + 16 * u + 4 * h), w1 = *(const LAS f32x4*)(wl + 16 * u + 8 + 4 * h); \
                    u32x4 wv; wv.x = cvt_pk_bf16(w0[0], w0[1]); wv.y = cvt_pk_bf16(w0[2], w0[3]); wv.z = cvt_pk_bf16(w1[0], w1[1]); wv.w = cvt_pk_bf16(w1[2], w1[3]); \
                    nacc = mfma32(af, __builtin_bit_cast(bf16x8, wv), nacc); } } \
            if (((t) & 1) == 1) { const int j1 = (t) >> 1; \
                bf16_t* dst = SST + ((size_t)(seq * 7 + j1) * 128 + 64 * half + 32 * dvt + ql) * 128 + 32 * dkt + 4 * h; \
                _Pragma("unroll") for (int g = 0; g < 4; ++g) { u32x2 wv; wv.x = cvt_pk_bf16(acc[4 * g], acc[4 * g + 1]); wv.y = cvt_pk_bf16(acc[4 * g + 2], acc[4 * g + 3]); *(u32x2*)(dst + 8 * g) = wv; } \
                if (dvt == 0 && half == 0 && ql == 0) { float* nd = NST + (size_t)(seq * 7 + j1) * 128 + 32 * dkt + 4 * h; \
                    _Pragma("unroll") for (int g = 0; g < 4; ++g) { f32x4 v4; v4[0] = nacc[4 * g]; v4[1] = nacc[4 * g + 1]; v4[2] = nacc[4 * g + 2]; v4[3] = nacc[4 * g + 3]; *(f32x4*)(nd + 8 * g) = v4; } } } \
            if ((t) + 1 < 14) ST_STORE(buf ^ 1, NK_, NV_, NW_); \
            __syncthreads(); } while (0)
        __syncthreads();
        ST_LOAD(0, kregA, vregA, wregA); ST_STORE(0, kregA, vregA, wregA);
        ST_LOAD(1, kregB, vregB, wregB);
        __syncthreads();
        for (int t = 0; t < 14; t += 2) {
            ST_ITER(t, kregA, vregA, wregA, kregB, vregB, wregB);
            ST_ITER(t + 1, kregB, vregB, wregB, kregA, vregA, wregA);
        }
#undef ST_ITER
#undef ST_LOAD
#undef ST_STORE
    }
}

DEVI void phase_mlstm_blk(const Ctx& C) {
    const bf16_t* QK = WSP(const bf16_t, WS_QK); const bf16_t* V = WSP(const bf16_t, WS_VTMP);
    const float* BC = WSP(const float, WS_BC); const float* DS = WSP(const float, WS_DS);
    const bf16_t* XC = WSP(const bf16_t, WS_XC); const bf16_t* PZ = WSP(const bf16_t, WS_PZ);
    bf16_t* AB = WSP(bf16_t, WS_AB);
    const float* ng = C.in[21]; const float* sk = C.in[22];
    const int lane = C.lane, ql = lane & 31, h2 = lane >> 5;
    LAS unsigned char* wt = C.lds + C.wid * WTile<128>::BYTES;
    for (int task = C.bid; task < 512; task += C.G) {
        const int rr = task >> 8, xx = task & 7, lix = (task >> 3) & 31, seq = 32 * rr + 4 * xx + (lix >> 3), j = rr ? 7 - (lix & 7) : (lix & 7);
        const int b = seq >> 2, h = seq & 3;
        const bf16_t* Qg = QK + (size_t)b * 2048 * 1024 + h * 128;
        f32x16 o[4]; float dsum, mdummy;
        { const bf16_t* Vg = V + (size_t)b * 2048 * 512 + h * 128;
          const float* BCs_ = BC + (size_t)seq * 2048;
          flash_core<128, 128, 1, 1>(C, Qg, Qg + 512, Vg, Qg, Qg + 512, Vg, 1024, 1024, 512, 256 * j, 4 * j, 4 * (j + 1), 1 << 20, 1.0f, BCs_, DS + (size_t)seq * 2048, o, dsum, mdummy,
                                     j ? WSP(const bf16_t, WS_SST) + (size_t)(seq * 7 + j - 1) * 128 * 128 : nullptr, j ? WSP(const float, WS_NST) + (size_t)(seq * 7 + j - 1) * 128 : nullptr, j ? BCs_[256 * j - 1] : 0.f); }
        dsum += __shfl_xor(dsum, 32);
        const float rden = 1.0f / fmaxf(fabsf(dsum), 1.0f);
        float su = 0.f;
#pragma unroll
        for (int d = 0; d < 4; ++d) { o[d] *= rden;
#pragma unroll
            for (int r = 0; r < 16; ++r) su += o[d][r]; }
        su += __shfl_xor(su, 32);
        const float mu = su * (1.0f / 128.0f);
        float sv = 0.f;
#pragma unroll
        for (int d = 0; d < 4; ++d)
#pragma unroll
            for (int r = 0; r < 16; ++r) { const float dd = o[d][r] - mu; sv += dd * dd; }
        sv += __shfl_xor(sv, 32);
        const float rstd = rsqrtf(sv * (1.0f / 128.0f) + 1e-5f);
        wt_write<128>(wt, o, rstd, mu, ql, h2);
        const size_t row0 = (size_t)b * 2048 + 256 * j + 32 * C.wid;
#pragma unroll 2
        for (int it = 0; it < 8; ++it) {
            const int idx = it * 64 + lane, rl_ = idx >> 4, c8 = idx & 15, ch = h * 128 + c8 * 8; const size_t row = row0 + rl_;
            float v[8], xc[8], zz[8], y[8];
            unpack8(*(const LAS u32x4*)(wt + rl_ * WTile<128>::RS + c8 * 16), v);
            unpack8(*(const u32x4*)(XC + row * 512 + ch), xc); unpack8(*(const u32x4*)(PZ + row * 1536 + 1024 + ch), zz);
            const f32x4 g0 = *(const f32x4*)(ng + ch), g1 = *(const f32x4*)(ng + ch + 4), s0 = *(const f32x4*)(sk + ch), s1 = *(const f32x4*)(sk + ch + 4);
#pragma unroll
            for (int e = 0; e < 4; ++e) { y[e] = (v[e] * g0[e] + s0[e] * xc[e]) * silu_f(zz[e]); y[4 + e] = (v[4 + e] * g1[e] + s1[e] * xc[4 + e]) * silu_f(zz[4 + e]); }
            *(u32x4*)(AB + row * 1024 + 512 + ch) = pack8(y);
        }
    }
}

DEVI void phase_diff_blk(const Ctx& C) {
    const bf16_t* DQ = WSP(const bf16_t, WS_DQ); const bf16_t* DK = WSP(const bf16_t, WS_DK); const bf16_t* DV = WSP(const bf16_t, WS_DVTMP);
    const bf16_t* DZ = WSP(const bf16_t, WS_DZ); bf16_t* CD = WSP(bf16_t, WS_CD);
    const float* dn = C.in[29];
    const float lam = WSP(const float, WS_LAM)[0];
    const float lam_init = 0.8f - 0.6f * 0.7408182206817179f;
    const int lane = C.lane, ql = lane & 31, h2 = lane >> 5;
    const float sc = 0.125f * LOG2E;
    LAS unsigned char* wt = C.lds + 59904 + C.wid * WTile<128>::BYTES;
    for (int task = C.bid; task < 512; task += C.G) {
        const int rr = task >> 8, xx = task & 7, lix = (task >> 3) & 31, seq = 32 * rr + 4 * xx + (lix >> 3), j = rr ? 7 - (lix & 7) : (lix & 7);
        const int b = seq >> 2, h = seq & 3;
        const bf16_t* Vg = DV + (size_t)b * 2048 * 512 + h * 128;
        f32x16 o[4]; float l;
#pragma unroll 1
        for (int comp = 0; comp < 2; ++comp) {
            const size_t hb = ((size_t)(b * 8 + 2 * h + comp)) * 2048 * 64;
            float mdummy;
            flash_core<64, 128, 0, 1>(C, DQ + hb, DK + hb, Vg, DQ + hb, DK + hb, Vg, 64, 64, 512, 256 * j, 0, 4 * (j + 1), 1 << 20, sc, nullptr, nullptr, o, l, mdummy);
            l += __shfl_xor(l, 32);
            if (comp == 0) {
                wt_write<128>(wt, o, 1.0f / l, 0.f, ql, h2);
            } else {
                const float rl = lam / l; float ss = 0.f;
#pragma unroll
                for (int d = 0; d < 4; ++d)
#pragma unroll
                    for (int g = 0; g < 4; ++g) {
                        const u32x2 q0 = *(const LAS u32x2*)(wt + ql * WTile<128>::RS + (32 * d + 8 * g + 4 * h2) * 2);
                        const float a0[4] = {bflo(q0.x), bfhi(q0.x), bflo(q0.y), bfhi(q0.y)};
#pragma unroll
                        for (int e = 0; e < 4; ++e) { const float r_ = a0[e] - o[d][4 * g + e] * rl; o[d][4 * g + e] = r_; ss += r_ * r_; }
                    }
                ss += __shfl_xor(ss, 32);
                const float rn = rsqrtf(ss * (1.0f / 128.0f) + 1e-5f) * (1.0f - lam_init);
                wt_write<128>(wt, o, rn, 0.f, ql, h2);
            }
        }
        const size_t row0 = (size_t)b * 2048 + 256 * j + 32 * C.wid;
#pragma unroll 2
        for (int it = 0; it < 8; ++it) {
            const int idx = it * 64 + lane, rl_ = idx >> 4, c8 = idx & 15, dv = c8 * 8, ch = h * 128 + dv; const size_t row = row0 + rl_;
            float v[8], zz[8], y[8];
            unpack8(*(const LAS u32x4*)(wt + rl_ * WTile<128>::RS + c8 * 16), v);
            unpack8(*(const u32x4*)(DZ + row * 512 + ch), zz);
            const f32x4 g0 = *(const f32x4*)(dn + dv), g1 = *(const f32x4*)(dn + dv + 4);
#pragma unroll
            for (int e = 0; e < 4; ++e) { y[e] = v[e] * g0[e] * silu_f(zz[e]); y[4 + e] = v[4 + e] * g1[e] * silu_f(zz[4 + e]); }
            *(u32x4*)(CD + row * 1024 + 512 + ch) = pack8(y);
        }
    }
}

DEVI void phase_dil23(const Ctx& C) {
    const bf16_t* CQ = WSP(const bf16_t, WS_CQ); const bf16_t* CK = WSP(const bf16_t, WS_CK); const bf16_t* CV = WSP(const bf16_t, WS_CVTMP);
    bf16_t* O2 = WSP(bf16_t, WS_CVT); bf16_t* CD = WSP(bf16_t, WS_CD);
    float* LSE2 = WSP(float, WS_LI); float* LSE3 = WSP(float, WS_BC);
    const int lane = C.lane, ql = lane & 31, h2 = lane >> 5, w = C.wid;
    const float sc = 0.125f * LOG2E;
    LAS unsigned char* wt = C.lds + w * WTile<64>::BYTES;
    for (int task = C.bid; task < 1024; task += C.G) {
        const int jb = (task < 512) ? 1 : 0, r4 = task & 3, h = (task >> 2) & 7, b = (task >> 5) & 15;
        const size_t base = ((size_t)(b * 8 + h) * 2048 + r4) * 64;
        f32x16 o[2]; float l, m;
        flash_core<64, 64, 0, 1, 2>(C, CQ + base, CK + base, CV + base, CQ + base, CK + base, CV + base, 256, 256, 256, 256 * jb, jb ? 1 : 0, jb ? 4 : 2, 128, sc, nullptr, nullptr, o, l, m);
        l += __shfl_xor(l, 32);
        wt_write<64>(wt, o, 1.0f / l, 0.f, ql, h2);
        const size_t tokb = (size_t)b * 2048 + 4 * (256 * jb + 32 * w) + r4;
        if (h2 == 0) LSE2[(tokb + 4 * ql) * 8 + h] = m + __log2f(l);
#pragma unroll
        for (int it = 0; it < 4; ++it) { const int idx = it * 64 + lane, rl_ = idx >> 3, c8 = idx & 7;
            *(u32x4*)(O2 + (tokb + 4 * rl_) * 512 + h * 64 + c8 * 8) = *(const LAS u32x4*)(wt + rl_ * WTile<64>::RS + c8 * 16); }
    }
    for (int task = C.bid; task < 1024; task += C.G) {
        const int cp = task & 7, h = (task >> 3) & 7, b = (task >> 6) & 15;
        const size_t base0 = ((size_t)(b * 8 + h) * 2048 + 2 * cp) * 64, base1 = base0 + 64;
        f32x16 o[2]; float l, m;
        flash_core<64, 64, 0, 2>(C, CQ + base0, CK + base0, CV + base0, CQ + base1, CK + base1, CV + base1, 1024, 1024, 1024, 0, 0, 2, 1 << 20, sc, nullptr, nullptr, o, l, m);
        l += __shfl_xor(l, 32);
        wt_write<64>(wt, o, 1.0f / l, 0.f, ql, h2);
        const size_t tokb = (size_t)b * 2048 + 16 * (32 * (w & 3)) + 2 * cp + (w >> 2);
        if (h2 == 0) LSE3[(tokb + 16 * ql) * 8 + h] = m + __log2f(l);
#pragma unroll
        for (int it = 0; it < 4; ++it) { const int idx = it * 64 + lane, rl_ = idx >> 3, c8 = idx & 7;
            *(u32x4*)(CD + (tokb + 16 * rl_) * 1024 + h * 64 + c8 * 8) = *(const LAS u32x4*)(wt + rl_ * WTile<64>::RS + c8 * 16); }
    }
}

DEVI void phase_dil1(const Ctx& C) {
    const bf16_t* CQ = WSP(const bf16_t, WS_CQ); const bf16_t* CK = WSP(const bf16_t, WS_CK); const bf16_t* CV = WSP(const bf16_t, WS_CVTMP);
    const bf16_t* O2 = WSP(const bf16_t, WS_CVT); bf16_t* CD = WSP(bf16_t, WS_CD); const bf16_t* CZ = WSP(const bf16_t, WS_CZ);
    const float* LSE2 = WSP(const float, WS_LI); const float* LSE3 = WSP(const float, WS_BC);
    const int lane = C.lane, ql = lane & 31, h2 = lane >> 5, w = C.wid;
    const float sc = 0.125f * LOG2E;
    LAS unsigned char* wt = C.lds + w * (WTile<64>::BYTES + 256);
    LAS float* wsc = (LAS float*)(wt + WTile<64>::BYTES);
    for (int task = C.bid; task < 1024; task += C.G) {
        const int j = 7 - (task & 7), h = (task >> 3) & 7, b = (task >> 6) & 15;
        const size_t base = (size_t)(b * 8 + h) * 2048 * 64;
        f32x16 o[2]; float l, m;
        flash_core<64, 64, 0, 1, 2>(C, CQ + base, CK + base, CV + base, CQ + base, CK + base, CV + base, 64, 64, 64, 256 * j, (2 * j - 1) < 0 ? 0 : (2 * j - 1), 2 * j + 2, 128, sc, nullptr, nullptr, o, l, m);
        l += __shfl_xor(l, 32);
        const size_t tok0 = (size_t)b * 2048 + 256 * j + 32 * w;
        {
            const size_t tok = tok0 + ql;
            const float lse1 = m + __log2f(l), lse2 = LSE2[tok * 8 + h], lse3 = LSE3[tok * 8 + h];
            const float M = fmaxf(lse1, fmaxf(lse2, lse3));
            const float e1 = fast_exp2(lse1 - M), w2 = fast_exp2(lse2 - M), w3 = fast_exp2(lse3 - M);
            const float rden = 1.0f / (e1 + w2 + w3);
            wt_write<64>(wt, o, e1 * rden / l, 0.f, ql, h2);
            if (h2 == 0) { wsc[2 * ql] = w2 * rden; wsc[2 * ql + 1] = w3 * rden; }
            asm volatile("" ::: "memory");
        }
#pragma unroll 2
        for (int it = 0; it < 4; ++it) {
            const int idx = it * 64 + lane, rl_ = idx >> 3, c8 = idx & 7, ch = h * 64 + c8 * 8; const size_t tok = tok0 + rl_;
            float v[8], p2[8], p3[8], zz[8], y[8];
            unpack8(*(const LAS u32x4*)(wt + rl_ * WTile<64>::RS + c8 * 16), v);
            const float a2 = wsc[2 * rl_], a3 = wsc[2 * rl_ + 1];
            unpack8(*(const u32x4*)(O2 + tok * 512 + ch), p2); unpack8(*(const u32x4*)(CD + tok * 1024 + ch), p3); unpack8(*(const u32x4*)(CZ + tok * 512 + ch), zz);
#pragma unroll
            for (int e = 0; e < 8; ++e) y[e] = (v[e] + p2[e] * a2 + p3[e] * a3) * silu_f(zz[e]);
            *(u32x4*)(CD + tok * 1024 + ch) = pack8(y);
        }
    }
}
constexpr int N_STEPS = 17;
constexpr int LDS_BYTES = pg8::STAGE_BYTES + 256 + 1024;

template <int MODE>
DEVI void run_gemm(const Ctx& C, const EpiMulti<MODE>& E, const bf16_t* A, int lda, const bf16_t* Bt, int ldb, int N, int K, int grp_shift, size_t grp_bbytes, int kdiag = 0, int a_grp16 = 0) {
    pg8::Gemm g; g.A = A; g.Bt = Bt; g.M = NT; g.N = N; g.K = K; g.lda = lda; g.ldb = ldb; g.grp_shift = grp_shift; g.grp_bbytes = grp_bbytes; g.kdiag = kdiag; g.a_grp16 = a_grp16;
    pg8::StaticOrder S; S.init(NT, N, C.G, C.bid);
    pg8::gemm_phase<EpiMulti<MODE>>(C.lds, g, S, E);
}
template <int MODE> DEVI EpiMulti<MODE> mk_epi(const Ctx& C) { EpiMulti<MODE> E; E.ldc = 0; E.o0 = nullptr; E.o1 = nullptr; E.f0 = nullptr; E.i0 = nullptr; E.i1 = nullptr; E.c0 = nullptr; E.c1 = nullptr; E.ws = C.ws; return E; }

__global__ void __launch_bounds__(512, 2) mega_fwd(Params P) {
    extern __shared__ __attribute__((aligned(16))) unsigned char lds_raw[];
    Ctx C;
    C.in = P.in;
    C.out = P.out; C.ws = P.ws; C.lds = (LAS unsigned char*)lds_raw;
    C.tid = threadIdx.x; C.lane = C.tid & 63; C.wid = __builtin_amdgcn_readfirstlane(C.tid >> 6); C.G = gridDim.x; C.bid = blockIdx.x;
    volatile LAS unsigned* bst = (volatile LAS unsigned*)(C.lds + pg8::STAGE_BYTES);
    if (C.tid < 4) bst[C.tid] = 0u;
    __syncthreads();
    XcdBarrier bar = xcd_barrier_post((unsigned*)(C.ws + WS_CTL), bst);
#define ON(k) (P.ph_lo <= (k) && (k) < P.ph_hi)
#define STEP(k, ...) if (ON(k)) { __VA_ARGS__ }
#define BAR(k) do { if (ON(k) && (k) + 1 < P.ph_hi) xcd_barrier(bar); } while (0)
    STEP(0, phase_prologue(C);)
    BAR(0);
    STEP(1, { auto E = mk_epi<EM_IN0>(C); E.o0 = WSP(bf16_t, WS_PZ); E.o1 = WSP(bf16_t, WS_U5);
        run_gemm(C, E, WSP(const bf16_t, WS_XN), 1024, WSP(const bf16_t, WS_WIN0), 1024, 2048, 1024, 0, 0); })
    BAR(1);
    STEP(2, { phase_conv_gates(C); s5_fill_t0(C); })
    BAR(2);
    STEP(3, { auto E = mk_epi<EM_PLAIN>(C); E.o0 = WSP(bf16_t, WS_QK); E.ldc = 1024;
        run_gemm(C, E, WSP(const bf16_t, WS_XC), 512, WSP(const bf16_t, WS_WQK), 512, 1024, 256, 0, 0, 256); })
    STEP(4, { auto E = mk_epi<EM_PLAIN>(C); E.o0 = WSP(bf16_t, WS_VTMP); E.ldc = 512;
        run_gemm(C, E, WSP(const bf16_t, WS_PZ) + 512, 1536, WSP(const bf16_t, WS_WV), 512, 512, 256, 0, 0, 256); })
    STEP(5, { auto E = mk_epi<EM_S5A>(C); E.o0 = WSP(bf16_t, WS_YLOC); E.f0 = WSP(float, WS_XLOC);
        run_gemm(C, E, WSP(const bf16_t, WS_U5), 512, WSP(const bf16_t, WS_BT5A), 512, 768, 512, 2, (size_t)768 * 512 * 2); })
    STEP(6, phase_cumsum(C);)
    BAR(6);
    STEP(7, {
        { pg8::StaticOrder S_; S_.init(NT, 512, C.G, C.bid); pg8::Unit u_; for (int i_ = 0; S_.next(i_, u_); ++i_) s5_scan_panel(C, u_.pm); }
        { auto E = mk_epi<EM_S5B>(C); E.o0 = WSP(bf16_t, WS_G5); E.i0 = WSP(const bf16_t, WS_YLOC); E.i1 = WSP(const bf16_t, WS_U5); E.c0 = C.in[11];
          run_gemm(C, E, WSP(const bf16_t, WS_XST), 256, WSP(const bf16_t, WS_BT5B), 256, 512, 256, 2, (size_t)512 * 256 * 2); }
        phase_mlstm_state(C, C.G, C.bid);
        })
    BAR(7);
    STEP(8, phase_mlstm_blk(C);)
    STEP(9, { auto E = mk_epi<EM_GLU>(C); E.o0 = WSP(bf16_t, WS_AB); E.i0 = WSP(const bf16_t, WS_G5); E.i1 = WSP(const bf16_t, WS_PZ); E.c0 = C.in[13];
        run_gemm(C, E, WSP(const bf16_t, WS_G5), 512, WSP(const bf16_t, WS_GLU), 512, 512, 512, 0, 0, 0, 1); })
    BAR(9);
    STEP(10, { auto E = mk_epi<EM_OUT>(C); E.o0 = WSP(bf16_t, WS_Y0); E.f0 = WSP(float, WS_SS0);
        run_gemm(C, E, WSP(const bf16_t, WS_AB), 1024, WSP(const bf16_t, WS_WOUT0), 1024, 1024, 1024, 0, 0); })
    BAR(10);
    STEP(11, rows_pass(C, 1);)
    BAR(11);
    STEP(12, { auto E = mk_epi<EM_IN1>(C); E.c0 = WSP(const float, WS_ROPE_C); E.c1 = WSP(const float, WS_ROPE_S);
        run_gemm(C, E, WSP(const bf16_t, WS_XN1), 1024, WSP(const bf16_t, WS_WIN1), 1024, 4096, 1024, 0, 0); })
    BAR(12);
    STEP(13, { phase_diff_blk(C); phase_dil23(C); })
    BAR(13);
    STEP(14, phase_dil1(C);)
    BAR(14);
    STEP(15, { auto E = mk_epi<EM_OUT>(C); E.o0 = WSP(bf16_t, WS_Y1); E.f0 = WSP(float, WS_SS1);
        run_gemm(C, E, WSP(const bf16_t, WS_CD), 1024, WSP(const bf16_t, WS_WOUT1), 1024, 1024, 1024, 0, 0); })
    BAR(15);
    STEP(16, rows_pass(C, 2);)
#undef ON
#undef BAR
}

#ifndef MK_SPLIT
#define MK_SPLIT 0
#endif
extern "C" void kernel_launch(void* const* d_in, const int* in_sizes, int n_in, void* d_out, int out_size, void* d_ws, size_t ws_size, hipStream_t stream) {
    static int grid = 0;
    if (grid == 0) {
        int dev = 0, cus = 0, per_cu = 0;
        (void)hipGetDevice(&dev);
        (void)hipDeviceGetAttribute(&cus, hipDeviceAttributeMultiprocessorCount, dev);
        (void)hipFuncSetAttribute((const void*)mega_fwd, hipFuncAttributeMaxDynamicSharedMemorySize, LDS_BYTES);
        (void)hipOccupancyMaxActiveBlocksPerMultiprocessor(&per_cu, (const void*)mega_fwd, 512, LDS_BYTES);
        if (per_cu < 1) per_cu = 1;
        if (per_cu > 1) per_cu = 1;
        grid = cus * per_cu;
        if (n_in != 31 || ws_size < WS_END) { fprintf(stderr, "kernel_launch: unexpected n_in %d or ws_size %zu (< %zu)\n", n_in, ws_size, (size_t)WS_END); }
        (void)hipGetLastError();
    }
    (void)hipMemsetAsync((char*)d_ws + WS_CTL, 0, 16384, stream);
    Params p{};
    for (int i = 0; i < 31; ++i) p.in[i] = (const float*)d_in[i];
    p.out = (float*)d_out; p.ws = (unsigned char*)d_ws;
#if MK_SPLIT
    for (int st = 0; st < N_STEPS; ++st) {
        p.ph_lo = st; p.ph_hi = st + 1;
        hipLaunchKernelGGL(mega_fwd, dim3(grid), dim3(512), LDS_BYTES, stream, p);
    }
#else
    p.ph_lo = 0; p.ph_hi = N_STEPS;
    void* args[] = {&p};
    hipError_t e = hipLaunchCooperativeKernel((const void*)mega_fwd, dim3(grid), dim3(512), args, LDS_BYTES, stream);
    if (e != hipSuccess) fprintf(stderr, "cooperative launch failed: %s (grid %d)\n", hipGetErrorString(e), grid);
#endif
}
```
